# Optimizing an MI355X kernel written in HIP

```python
import jax, jax.numpy as jnp
from jax import lax
import numpy as np

D_MODEL = 1024
BATCH = 16
SEQ = 2048
DEPTH = 4
DEC_BATCH = 32
DEC_SEQ = 2048
PAST_LEN = 128

HEAD_DIM = 64
A_HEADS = 8
A_KV_HEADS = 2
A_RADIUS = 128
A_BLOCK = 128
B_GROUPS = ((128, 1), (512, 4), (2048, 16))
B_HPG = 4
B_HEADS = B_HPG * len(B_GROUPS)
C_HEADS = 4
C_HEAD_DIM = 128
N_MEM = 256
ROPE_THETA = 500000.0
ROPE_DIMS = HEAD_DIM // 4
FFN_HIDDEN = ((8 * D_MODEL + 3 * 256 - 1) // (3 * 256)) * 256
N_BRANCH = 3
A_Q_W = A_HEADS * HEAD_DIM
A_KV_W = A_KV_HEADS * HEAD_DIM
B_W = B_HEADS * HEAD_DIM
C_Q_W = C_HEADS * C_HEAD_DIM
GATE_W = N_BRANCH * D_MODEL
IN_W = A_Q_W + 2 * A_KV_W + 3 * B_W + C_Q_W + GATE_W
EPS = 1e-6
NEG_INF = -1e30

kernel_name = "hybrid_gated_window_dilated_memory_encoder"


def _rmsnorm(x, g):
    xf = x.astype(jnp.float32)
    y = xf * lax.rsqrt(jnp.mean(xf * xf, axis=-1, keepdims=True) + EPS)
    return (y * g.astype(jnp.float32)).astype(x.dtype)


def _rope_tables(seq):
    inv_freq = ROPE_THETA ** (-jnp.arange(0, ROPE_DIMS, 2, dtype=jnp.float32) / ROPE_DIMS)
    ang = jnp.arange(seq, dtype=jnp.float32)[:, None] * inv_freq[None, :]
    return jnp.cos(ang), jnp.sin(ang)


def _rope(x, cos, sin):
    half = ROPE_DIMS // 2
    xf = x.astype(jnp.float32)
    x1, x2 = xf[..., :half], xf[..., half:ROPE_DIMS]
    c, s = cos[None, :, None, :], sin[None, :, None, :]
    out = jnp.concatenate([x1 * c - x2 * s, x2 * c + x1 * s, xf[..., ROPE_DIMS:]], axis=-1)
    return out.astype(x.dtype)


def _banded_attention(q, k, v, radius, block, sink=None):
    b, L, g, r, dh = q.shape
    nb = -(-L // block)
    lp = nb * block
    pad = lp - L
    q = jnp.pad(q, ((0, 0), (0, pad), (0, 0), (0, 0), (0, 0)))

    def kv_blocks(t):
        t = jnp.pad(t, ((0, 0), (block, block + pad), (0, 0), (0, 0)))
        t = t.reshape(b, nb + 2, block, g, dh)
        return jnp.concatenate([t[:, :-2], t[:, 1:-1], t[:, 2:]], axis=2)

    kb, vb = kv_blocks(k), kv_blocks(v)
    qb = q.reshape(b, nb, block, g, r, dh)
    s = jnp.einsum('bnqgrd,bnkgd->bngrqk', qb, kb).astype(jnp.float32) * (dh ** -0.5)
    n_idx = jnp.arange(nb)[:, None, None]
    q_pos = n_idx * block + jnp.arange(block)[None, :, None]
    k_pos = (n_idx - 1) * block + jnp.arange(3 * block)[None, None, :]
    mask = (jnp.abs(q_pos - k_pos) <= radius) & (k_pos >= 0) & (k_pos < L)
    s = jnp.where(mask[None, :, None, None], s, NEG_INF)
    m = jnp.max(s, axis=-1)
    if sink is not None:
        sk = sink.astype(jnp.float32)[None, None, :, :, None]
        m = jnp.maximum(m, sk)
    p = jnp.exp(s - m[..., None])
    denom = jnp.sum(p, axis=-1)
    if sink is not None:
        denom = denom + jnp.exp(sk - m)
    o = jnp.einsum('bngrqk,bnkgd->bnqgrd', p.astype(v.dtype), vb).astype(jnp.float32)
    o = o / jnp.moveaxis(denom, -1, 2)[..., None]
    o = o.reshape(b, lp, g, r, dh)[:, :L].astype(q.dtype)
    lse = jnp.moveaxis(m + jnp.log(denom), -1, 2).reshape(b, lp, g, r)[:, :L]
    return o, lse


def _windowed_gqa(q, k, v, sink):
    b, S = q.shape[0], q.shape[1]
    rep = A_HEADS // A_KV_HEADS
    qg = q.reshape(b, S, A_KV_HEADS, rep, HEAD_DIM)
    o, _ = _banded_attention(qg, k, v, A_RADIUS, A_BLOCK, sink.reshape(A_KV_HEADS, rep))
    return o.reshape(b, S, A_Q_W)


def _dilated_attention(q, k, v):
    b, S = q.shape[0], q.shape[1]
    outs, lses = [], []
    for gi, (window, dil) in enumerate(B_GROUPS):
        lo, hi = gi * B_HPG, (gi + 1) * B_HPG
        L = S // dil
        radius = window // (2 * dil)

        def gather(t):
            return (t[:, :, lo:hi].reshape(b, L, dil, B_HPG, HEAD_DIM)
                    .transpose(0, 2, 1, 3, 4).reshape(b * dil, L, B_HPG, HEAD_DIM))

        o, lse = _banded_attention(gather(q)[:, :, :, None], gather(k), gather(v), radius, radius)
        o = o.reshape(b, dil, L, B_HPG, HEAD_DIM).transpose(0, 2, 1, 3, 4).reshape(b, S, B_HPG, HEAD_DIM)
        lse = lse.reshape(b, dil, L, B_HPG).transpose(0, 2, 1, 3).reshape(b, S, B_HPG)
        outs.append(o)
        lses.append(lse)
    alpha = jax.nn.softmax(jnp.stack(lses, axis=0), axis=0)
    o = jnp.sum(alpha[..., None] * jnp.stack(outs, axis=0).astype(jnp.float32), axis=0)
    return o.reshape(b, S, B_HPG * HEAD_DIM).astype(q.dtype)


def _memory_attention(q, mem_n, w_mem_kv):
    b, S = q.shape[0], q.shape[1]
    kv = mem_n @ w_mem_kv
    mk, mv = jnp.split(kv, 2, axis=-1)
    mk = mk.reshape(b, N_MEM, C_HEADS, C_HEAD_DIM)
    mv = mv.reshape(b, N_MEM, C_HEADS, C_HEAD_DIM)
    s = jnp.einsum('bshd,bmhd->bhsm', q, mk).astype(jnp.float32) * (C_HEAD_DIM ** -0.5)
    p = jax.nn.softmax(s, axis=-1)
    o = jnp.einsum('bhsm,bmhd->bshd', p.astype(mv.dtype), mv)
    return o.reshape(b, S, C_Q_W)


def _layer(x, mem, cos, sin, g_mix_pre, g_mix_post, g_mem, w_in, sink_a, w_mem_kv,
           w_o_a, w_o_b, w_o_c, w_out, g_ffn_pre, g_ffn_post, w_ffn_in, w_ffn_out):
    b, S, _ = x.shape
    h = _rmsnorm(x, g_mix_pre)
    proj = h @ w_in
    cuts = [A_Q_W, A_KV_W, A_KV_W, B_W, B_W, B_W, C_Q_W]
    idx, off = [], 0
    for c in cuts:
        off += c
        idx.append(off)
    qa, ka, va, qb, kb, vb, qc, gates = jnp.split(proj, idx, axis=-1)
    qa = _rope(qa.reshape(b, S, A_HEADS, HEAD_DIM), cos, sin)
    ka = _rope(ka.reshape(b, S, A_KV_HEADS, HEAD_DIM), cos, sin)
    va = va.reshape(b, S, A_KV_HEADS, HEAD_DIM)
    qb = _rope(qb.reshape(b, S, B_HEADS, HEAD_DIM), cos, sin)
    kb = _rope(kb.reshape(b, S, B_HEADS, HEAD_DIM), cos, sin)
    vb = vb.reshape(b, S, B_HEADS, HEAD_DIM)
    qc = qc.reshape(b, S, C_HEADS, C_HEAD_DIM)

    o_a = _windowed_gqa(qa, ka, va, sink_a) @ w_o_a
    o_b = _dilated_attention(qb, kb, vb) @ w_o_b
    o_c = _memory_attention(qc, _rmsnorm(mem, g_mem), w_mem_kv) @ w_o_c

    gate = jax.nn.sigmoid(gates.reshape(b, S, N_BRANCH, D_MODEL))
    merged = gate[:, :, 0] * o_a + gate[:, :, 1] * o_b + gate[:, :, 2] * o_c
    x = x + _rmsnorm(merged @ w_out, g_mix_post)
    h = _rmsnorm(x, g_ffn_pre)
    gu = h @ w_ffn_in
    g_, u_ = jnp.split(gu, 2, axis=-1)
    y = (jax.nn.silu(g_) * u_) @ w_ffn_out
    return x + _rmsnorm(y, g_ffn_post)


def _trunk(x, mem, weights):
    cos, sin = _rope_tables(x.shape[1])
    for l in range(DEPTH):
        x = _layer(x, mem, cos, sin, *[w[l] for w in weights])
    return x


def setup_inputs(seed: int = 0) -> dict:
    key = jax.random.key(seed)
    ks = jax.random.split(key, 20)
    f32 = jnp.float32

    def dense(k, fan_in, fan_out):
        return jax.random.normal(k, (DEPTH, fan_in, fan_out), f32) * (fan_in ** -0.5)

    def gain(k):
        return 1.0 + 0.05 * jax.random.normal(k, (DEPTH, D_MODEL), f32)

    return {
        "x_prompt": jax.random.normal(ks[0], (BATCH, SEQ, D_MODEL), f32),
        "x_sample": jax.random.normal(ks[1], (DEC_BATCH, DEC_SEQ, D_MODEL), f32),
        "mem_prompt": jax.random.normal(ks[2], (BATCH, N_MEM, D_MODEL), f32),
        "mem_sample": jax.random.normal(ks[3], (DEC_BATCH, N_MEM, D_MODEL), f32),
        "norm_mix_pre": gain(ks[4]),
        "norm_mix_post": gain(ks[5]),
        "norm_mem": gain(ks[6]),
        "w_in": dense(ks[7], D_MODEL, IN_W),
        "sink_a": 0.5 * jax.random.normal(ks[8], (DEPTH, A_HEADS), f32),
        "w_mem_kv": dense(ks[9], D_MODEL, 2 * C_Q_W),
        "w_o_a": dense(ks[10], A_Q_W, D_MODEL),
        "w_o_b": dense(ks[11], B_HPG * HEAD_DIM, D_MODEL),
        "w_o_c": dense(ks[12], C_Q_W, D_MODEL),
        "w_out": dense(ks[13], D_MODEL, D_MODEL),
        "norm_ffn_pre": gain(ks[14]),
        "norm_ffn_post": gain(ks[15]),
        "w_ffn_in": dense(ks[16], D_MODEL, 2 * FFN_HIDDEN),
        "w_ffn_out": dense(ks[17], FFN_HIDDEN, D_MODEL),
    }


def reference(x_prompt, x_sample, mem_prompt, mem_sample, norm_mix_pre, norm_mix_post, norm_mem,
              w_in, sink_a, w_mem_kv, w_o_a, w_o_b, w_o_c, w_out, norm_ffn_pre, norm_ffn_post,
              w_ffn_in, w_ffn_out):
    weights = (norm_mix_pre, norm_mix_post, norm_mem, w_in, sink_a, w_mem_kv, w_o_a, w_o_b,
               w_o_c, w_out, norm_ffn_pre, norm_ffn_post, w_ffn_in, w_ffn_out)
    y_prompt = _trunk(x_prompt, mem_prompt, weights)
    y_sample = _trunk(x_sample, mem_sample, weights)
    return (y_prompt, y_sample)
```

```cpp
#include <hip/hip_runtime.h>
#include <hip/hip_cooperative_groups.h>
#include <cstdio>
#include <cstdint>
#include <cmath>
namespace cg = cooperative_groups;
#ifndef MK_MULTI_LAUNCH
#define MK_MULTI_LAUNCH 0
#endif
namespace pg8 {
#define PG8_LAS __attribute__((address_space(3)))
typedef unsigned short bf16_t;
typedef short bf16x8 __attribute__((ext_vector_type(8)));
typedef float f32x4 __attribute__((ext_vector_type(4)));
typedef unsigned u32x4 __attribute__((ext_vector_type(4)));
constexpr int BM = 256, BK = 64, HALF = 128, HTB = HALF * BK * 2  , STAGE_BYTES = 8 * HTB, NXCD = 8, WGM = 8;

__host__ __device__ __forceinline__ int lds_byte(int r, int c) { const int st = (r >> 4) * 2 + (c >> 5), rr = r & 15, cc = c & 31, ob = rr * 64 + cc * 2; return st * 1024 + (ob ^ (((ob >> 9) & 1) << 5)); }
__host__ __device__ __forceinline__ void stage_rc(int b, int& R, int& C) { const int st = b / 1024, sb = b % 1024, swz = sb ^ (((sb >> 9) & 1) << 5); R = (st >> 1) * 16 + swz / 64; C = (st & 1) * 32 + (swz % 64) / 2; }
__host__ __device__ __forceinline__ int perm32(int rho) { const int n = rho >> 4, i = rho & 15; return 8 * (i >> 2) + 4 * n + (i & 3); }

struct Unit { int pm, pn; };
struct Gemm { const bf16_t* A; const bf16_t* Bt; int M, N, K; };

struct StaticOrder {
    int nM, nN, nwg, G, c;
    __host__ __device__ void init(int M, int N, int G_, int c_) { nM = M / BM; nN = N / BM; nwg = nM * nN; G = G_; c = c_; }
    __host__ __device__ bool next(int i, Unit& u) const {
        const long L = (long)i * G + c; if (L >= nwg) return false;
        int wgid = (int)L; { const int q = nwg / NXCD, r = nwg % NXCD, xcd = wgid % NXCD, off = wgid / NXCD; wgid = (xcd < r ? xcd * (q + 1) : r * (q + 1) + (xcd - r) * q) + off; }
        const int nig = WGM * nN, gid = wgid / nig, fm = gid * WGM, gsz = (nM - fm) < WGM ? (nM - fm) : WGM;
        u.pm = fm + ((wgid % nig) % gsz); u.pn = (wgid % nig) / gsz; return true;
    }
    __device__ __forceinline__ void a_ready(const Unit&) const {}
    __device__ __forceinline__ void done(const Unit&) const {}
};
__device__ __forceinline__ unsigned cvt_pk_bf16(float lo, float hi) { unsigned r; asm volatile("v_cvt_pk_bf16_f32 %0, %1, %2" : "=v"(r) : "v"(lo), "v"(hi)); return r; }
typedef float f32x2 __attribute__((ext_vector_type(2)));
template <class Epi, class Sched, bool ALIGN_EPI = false, bool SP2 = false>
__device__ __forceinline__ void gemm_phase(PG8_LAS unsigned char* lds, const Gemm g, const Sched& S, const Epi& E) {
    int tid_ = threadIdx.x; asm volatile("" : "+v"(tid_)); const int tid = tid_, wid = __builtin_amdgcn_readfirstlane(tid >> 6), lane = tid & 63, wr = wid >> 2, wc = wid & 3, fr = lane & 15, fq = lane >> 4;
    const int K = g.K, nt = K / BK;
    unsigned voffA[2], voffB[2];
#pragma unroll
    for (int i = 0; i < 2; ++i) { int R, C; stage_rc(tid * 16 + i * 8192, R, C); const int Rb = Epi::PERM ? ((R & ~31) + perm32(R & 31)) : R;
        voffA[i] = (unsigned)(R * K + C) * 2u; voffB[i] = (unsigned)(Rb * K + C) * 2u; }
    const size_t kstep = (size_t)(BK * 2);
    const size_t hstep = (size_t)HALF * K * 2;
    const size_t tstep = 2 * hstep;
    const unsigned ldsw = (unsigned)wid * 1024u;
    const int aoff = lds_byte(wr * 64 + fr, fq * 8), boff = lds_byte(wc * 32 + fr, fq * 8);
#define PG8_SA(b, h) (((b) * 2 + (h)) * HTB)
#define PG8_SB(b, h) ((4 + (b) * 2 + (h)) * HTB)
#define PG8_STAGE(bufoff, gbase, voff) do { _Pragma("unroll") for (int _i = 0; _i < 2; ++_i) \
        __builtin_amdgcn_global_load_lds((const unsigned*)((const char*)(gbase) + (voff)[_i]), (PG8_LAS unsigned*)(lds + (bufoff) + ldsw + _i * 8192), 16, 0, 0); } while (0)
#define PG8_LDA(dst, b, h) do { _Pragma("unroll") for (int m = 0; m < 4; ++m) _Pragma("unroll") for (int k = 0; k < 2; ++k) dst[m][k] = *(const PG8_LAS bf16x8*)(lds + PG8_SA(b, h) + aoff + m * 2048 + k * 1024); } while (0)
#define PG8_LDB(dst, b, h) do { _Pragma("unroll") for (int n = 0; n < 2; ++n) _Pragma("unroll") for (int k = 0; k < 2; ++k) dst[n][k] = *(const PG8_LAS bf16x8*)(lds + PG8_SB(b, h) + boff + n * 2048 + k * 1024); } while (0)
#define PG8_MMA(ai, bj, At, Bt) do { __builtin_amdgcn_s_setprio(1); _Pragma("unroll") for (int m = 0; m < 4; ++m) _Pragma("unroll") for (int n = 0; n < 2; ++n) _Pragma("unroll") for (int k = 0; k < 2; ++k) \
        acc[ai][bj][m][n] = __builtin_amdgcn_mfma_f32_16x16x32_bf16(Bt[n][k], At[m][k], acc[ai][bj][m][n], 0, 0, 0); __builtin_amdgcn_s_setprio(0); } while (0)
#define PG8_WAIT_V(n) asm volatile("s_waitcnt vmcnt(" #n ")" ::: "memory")
#define PG8_WAIT_L(n) asm volatile("s_waitcnt lgkmcnt(" #n ")" ::: "memory")
#define PG8_BAR __builtin_amdgcn_s_barrier()
#define PG8_SCHED __builtin_amdgcn_sched_barrier(0)
    Unit cur, nxt; int ui = 0;
    if (!S.next(0, cur)) return;
    f32x4 acc[2][2][4][2];
#pragma unroll
    for (int a = 0; a < 2; ++a)
#pragma unroll
        for (int b = 0; b < 2; ++b)
#pragma unroll
            for (int m = 0; m < 4; ++m)
#pragma unroll
                for (int n = 0; n < 2; ++n) acc[a][b][m][n] = (f32x4){0.f, 0.f, 0.f, 0.f};
    bf16x8 At[4][2], B0[2][2], B1[2][2];
    const char* cA = (const char*)g.A + (size_t)cur.pm * tstep; const char* cB = (const char*)g.Bt + (size_t)cur.pn * tstep;
    S.a_ready(cur);
    if constexpr (SP2) {
        PG8_STAGE(PG8_SB(0, 0), cB, voffB); PG8_STAGE(PG8_SB(0, 1), cB + hstep, voffB); PG8_STAGE(PG8_SA(0, 0), cA, voffA); PG8_STAGE(PG8_SA(0, 1), cA + hstep, voffA);
        if (wr == 1) PG8_BAR;
        PG8_WAIT_V(2); PG8_BAR;
        PG8_STAGE(PG8_SB(1, 0), cB + kstep, voffB); PG8_STAGE(PG8_SA(1, 0), cA + kstep, voffA); PG8_STAGE(PG8_SB(1, 1), cB + hstep + kstep, voffB);
        PG8_WAIT_V(6); PG8_BAR;
    } else {
        PG8_STAGE(PG8_SB(0, 0), cB, voffB); PG8_STAGE(PG8_SA(0, 0), cA, voffA); PG8_STAGE(PG8_SB(0, 1), cB + hstep, voffB); PG8_STAGE(PG8_SA(0, 1), cA + hstep, voffA);
        if (wr == 1) PG8_BAR;
        PG8_WAIT_V(4); PG8_BAR;
        PG8_STAGE(PG8_SB(1, 0), cB + kstep, voffB); PG8_STAGE(PG8_SA(1, 0), cA + kstep, voffA); PG8_STAGE(PG8_SB(1, 1), cB + hstep + kstep, voffB);
        PG8_WAIT_V(6); PG8_BAR;
    }
    for (;;) {
        const bool has_next = S.next(ui + 1, nxt);
        const char* nA = has_next ? (const char*)g.A + (size_t)nxt.pm * tstep : cA; const char* nB = has_next ? (const char*)g.Bt + (size_t)nxt.pn * tstep : cB;
        for (int t = 0; t < nt; t += 2) {
            const bool last = (t == nt - 2);
            const char* a1 = cA + (size_t)(t + 1) * kstep;
            const char* a2 = last ? nA : cA + (size_t)(t + 2) * kstep; const char* b2 = last ? nB : cB + (size_t)(t + 2) * kstep;
            const char* a3 = a2 + kstep; const char* b3 = b2 + kstep;
            if (last && has_next) S.a_ready(nxt);
            if constexpr (SP2) {
            PG8_LDB(B0, 0, 0); PG8_LDB(B1, 0, 1); PG8_SCHED; PG8_LDA(At, 0, 0); PG8_STAGE(PG8_SA(1, 1), a1 + hstep, voffA);
            PG8_WAIT_V(8); PG8_WAIT_L(0); PG8_BAR; PG8_MMA(0, 0, At, B0); PG8_MMA(0, 1, At, B1); PG8_BAR; PG8_SCHED;
            PG8_LDA(At, 0, 1); PG8_STAGE(PG8_SB(0, 0), b2, voffB); PG8_STAGE(PG8_SB(0, 1), b2 + hstep, voffB); PG8_STAGE(PG8_SA(0, 0), a2, voffA);
            PG8_WAIT_V(8); PG8_WAIT_L(0); PG8_BAR; PG8_MMA(1, 0, At, B0); PG8_MMA(1, 1, At, B1); PG8_BAR; PG8_SCHED;
            PG8_LDB(B0, 1, 0); PG8_LDB(B1, 1, 1); PG8_SCHED; PG8_LDA(At, 1, 0); PG8_STAGE(PG8_SA(0, 1), a2 + hstep, voffA);
            PG8_WAIT_V(8); PG8_WAIT_L(0); PG8_BAR; PG8_MMA(0, 0, At, B0); PG8_MMA(0, 1, At, B1); PG8_BAR; PG8_SCHED;
            PG8_LDA(At, 1, 1); PG8_STAGE(PG8_SB(1, 0), b3, voffB); PG8_STAGE(PG8_SB(1, 1), b3 + hstep, voffB); PG8_STAGE(PG8_SA(1, 0), a3, voffA);
            PG8_WAIT_V(8); PG8_WAIT_L(0); PG8_BAR; PG8_MMA(1, 0, At, B0); PG8_MMA(1, 1, At, B1); PG8_BAR; PG8_SCHED;
            } else {
            PG8_LDB(B0, 0, 0); PG8_SCHED; PG8_LDA(At, 0, 0); PG8_STAGE(PG8_SA(1, 1), a1 + hstep, voffA);
            PG8_WAIT_L(8); PG8_BAR; PG8_WAIT_L(0); PG8_MMA(0, 0, At, B0); PG8_BAR; PG8_SCHED;
            PG8_LDB(B1, 0, 1); PG8_STAGE(PG8_SB(0, 0), b2, voffB);
            PG8_BAR; PG8_WAIT_L(0); PG8_MMA(0, 1, At, B1); PG8_BAR;
            PG8_LDA(At, 0, 1); PG8_STAGE(PG8_SA(0, 0), a2, voffA);
            PG8_BAR; PG8_WAIT_L(0); PG8_MMA(1, 0, At, B0); PG8_BAR; PG8_SCHED;
            PG8_STAGE(PG8_SB(0, 1), b2 + hstep, voffB);
            PG8_WAIT_V(6); PG8_BAR; PG8_MMA(1, 1, At, B1); PG8_BAR;
            PG8_LDB(B0, 1, 0); PG8_SCHED; PG8_LDA(At, 1, 0); PG8_STAGE(PG8_SA(0, 1), a2 + hstep, voffA);
            PG8_WAIT_L(8); PG8_BAR; PG8_WAIT_L(0); PG8_MMA(0, 0, At, B0); PG8_BAR; PG8_SCHED;
            PG8_LDB(B1, 1, 1); PG8_STAGE(PG8_SB(1, 0), b3, voffB);
            PG8_BAR; PG8_WAIT_L(0); PG8_MMA(0, 1, At, B1); PG8_BAR;
            PG8_LDA(At, 1, 1); PG8_STAGE(PG8_SA(1, 0), a3, voffA);
            PG8_BAR; PG8_WAIT_L(0); PG8_MMA(1, 0, At, B0); PG8_BAR; PG8_SCHED;
            PG8_STAGE(PG8_SB(1, 1), b3 + hstep, voffB);
            PG8_WAIT_V(6); PG8_BAR; PG8_MMA(1, 1, At, B1); PG8_BAR;
            }
        }
        if constexpr (ALIGN_EPI) { if (wr == 0) PG8_BAR; }
        if constexpr (!Epi::AFTER_DRAIN) { E(acc, cur, wr, wc, fr, fq); S.done(cur); }
        if (!has_next) break;
#pragma unroll
        for (int a = 0; a < 2; ++a)
#pragma unroll
            for (int b = 0; b < 2; ++b)
#pragma unroll
                for (int m = 0; m < 4; ++m)
#pragma unroll
                    for (int n = 0; n < 2; ++n) acc[a][b][m][n] = (f32x4){0.f, 0.f, 0.f, 0.f};
        cur = nxt; cA = nA; cB = nB; ++ui;
        if constexpr (ALIGN_EPI) { if (wr == 1) PG8_BAR; }
    }
    PG8_WAIT_V(0);
    if constexpr (!ALIGN_EPI) { if (wr == 0) PG8_BAR; }
    PG8_BAR;
    if constexpr (Epi::AFTER_DRAIN) { E.fused(acc, cur, wr, wc, fr, fq, lds, wid, lane); S.done(cur); }
#undef PG8_SA
#undef PG8_SB
#undef PG8_STAGE
#undef PG8_LDA
#undef PG8_LDB
#undef PG8_MMA
#undef PG8_WAIT_V
#undef PG8_WAIT_L
#undef PG8_BAR
#undef PG8_SCHED
}
}

using pg8::bf16_t; using pg8::bf16x8; using pg8::f32x4; using pg8::u32x4;
typedef float f32x16 __attribute__((ext_vector_type(16)));
typedef unsigned u32x2 __attribute__((ext_vector_type(2)));
#define LAS __attribute__((address_space(3)))
constexpr int NTHREADS = 512, NWAVES = 8, LDS_BYTES = pg8::STAGE_BYTES;
constexpr int DM = 1024, SEQ = 2048, NBATCH = 48, DEPTH = 4, NMEM = 256, INW = 6656, FFH = 2816;
constexpr int CB = 16, MC = CB * SEQ, NCHUNK = NBATCH / CB;
constexpr float EPS = 1e-6f, LOG2E = 1.4426950408889634f, LN2 = 0.6931471805599453f;
constexpr size_t WO_IN = 0, WO_MKV = WO_IN + (size_t)INW * DM, WO_OA = WO_MKV + (size_t)1024 * DM, WO_OB = WO_OA + (size_t)1024 * 512, WO_OC = WO_OB + (size_t)1024 * 256,
                 WO_OUT = WO_OC + (size_t)1024 * 512, WO_FIN = WO_OUT + (size_t)1024 * 1024, WO_FOUT = WO_FIN + (size_t)2 * FFH * DM, WL = WO_FOUT + (size_t)DM * FFH;
constexpr size_t al256(size_t x) { return (x + 255) & ~(size_t)255; }
constexpr size_t WS_WT = 0;
constexpr size_t WS_ROPE = al256(WS_WT + WL * DEPTH * 2);
constexpr size_t WS_MEMK = al256(WS_ROPE + (size_t)SEQ * 8 * 8);
constexpr size_t WS_MEMVT = al256(WS_MEMK + (size_t)DEPTH * NBATCH * NMEM * 512 * 2);
constexpr size_t WS_H = al256(WS_MEMVT + (size_t)DEPTH * NBATCH * NMEM * 512 * 2);
constexpr size_t WS_PROJ = al256(WS_H + (size_t)MC * DM * 2);
constexpr size_t WS_VTA = al256(WS_PROJ + (size_t)MC * INW * 2);
constexpr size_t WS_VTB = al256(WS_VTA + (size_t)CB * 2 * 64 * SEQ * 2);
constexpr size_t WS_OA = al256(WS_VTB + (size_t)CB * 12 * 64 * SEQ * 2);
constexpr size_t WS_OB = al256(WS_OA + (size_t)MC * 512 * 2);
constexpr size_t WS_OC = al256(WS_OB + (size_t)MC * 256 * 2);
constexpr size_t WS_MRG = al256(WS_OC + (size_t)MC * 512 * 2);
constexpr size_t WS_KBA = al256(WS_MRG + (size_t)MC * DM * 2);
constexpr size_t WS_KBB = al256(WS_KBA + (size_t)CB * 2 * 64 * SEQ * 2);
constexpr size_t WS_BAR = al256(WS_KBB + (size_t)CB * 12 * 64 * SEQ * 2);
constexpr size_t WS_END = al256(WS_BAR + 16384);
constexpr size_t WS_MEMN = WS_PROJ;
constexpr size_t WS_Y = WS_PROJ;
constexpr size_t WS_ACT = WS_PROJ + (size_t)MC * DM * 4;
constexpr size_t WS_OG = WS_MRG;
constexpr size_t WS_LSE = WS_MRG + (size_t)3 * MC * 256 * 2;
static_assert((size_t)DEPTH * NBATCH * NMEM * DM * 2 <= (size_t)MC * INW * 2, "memn overlay");
static_assert((size_t)MC * DM * 4 + (size_t)MC * FFH * 2 <= (size_t)MC * INW * 2, "y/act overlay");
static_assert((size_t)3 * MC * 256 * 2 + (size_t)3 * MC * 4 * 4 <= (size_t)MC * DM * 2, "og overlay");

struct Params {
    const float *x_prompt, *x_sample, *mem_prompt, *mem_sample, *g_mix_pre, *g_mix_post, *g_mem, *w_in, *sink_a, *w_mem_kv, *w_o_a, *w_o_b, *w_o_c, *w_out,
                *g_ffn_pre, *g_ffn_post, *w_ffn_in, *w_ffn_out;
    float* out; unsigned char* ws;
    float inv_freq[8];
    int s_lo, s_hi;
};

typedef const __attribute__((address_space(4))) Params* PP;
#define OPAQUE_V(x) asm volatile("" : "+v"(x))
#define OPAQUE_S(x) asm volatile("" : "+s"(x))
__device__ __forceinline__ float bf2f(unsigned b) { return __uint_as_float(b << 16); }
typedef __bf16 bf16x2v __attribute__((ext_vector_type(2)));
typedef float f32x2v __attribute__((ext_vector_type(2)));
__device__ __forceinline__ unsigned pk2(float lo, float hi) { const f32x2v v = {lo, hi}; return __builtin_bit_cast(unsigned, __builtin_convertvector(v, bf16x2v)); }
__device__ __forceinline__ float wave_sum(float v) {
#pragma unroll
    for (int o = 32; o > 0; o >>= 1) v += __shfl_xor(v, o);
    return v;
}
__device__ __forceinline__ float fexp2(float x) { return __builtin_amdgcn_exp2f(x); }
__device__ __forceinline__ float frcp(float x) { return __builtin_amdgcn_rcpf(x); }
__device__ __forceinline__ float sigmoidf_(float x) { return frcp(1.f + fexp2(-x * LOG2E)); }
#define LDS_WAIT() asm volatile("s_waitcnt lgkmcnt(0)" ::: "memory")

__device__ __forceinline__ int src_col_in(int n) {
    const bool qk = (n < 640) || (n >= 768 && n < 2304);
    const int p = n & 63;
    return (qk && p < 16) ? (n - p) + (p >> 1) + 8 * (p & 1) : n;
}
__device__ __forceinline__ int src_col_ffin(int n) { const int q = n >> 3, e = n & 7; return e < 4 ? 4 * q + e : FFH + 4 * q + (e - 4); }

template <int PERMT>
__device__ __forceinline__ void transpose_item(const float* W, int K, int N, bf16_t* WT, LAS float* scr, int item, int lane) {
    const int nblk = N / 32, kb = item / nblk, nb = item % nblk, k0 = 64 * kb, n0 = 32 * nb;
    const int nd = n0 + (lane & 31);
    const int ns = PERMT == 1 ? src_col_in(nd) : (PERMT == 2 ? src_col_ffin(nd) : nd);
#pragma unroll 8
    for (int i = 0; i < 32; ++i) { const int kk = 2 * i + (lane >> 5); scr[kk * 33 + (lane & 31)] = __builtin_nontemporal_load(W + (size_t)(k0 + kk) * N + ns); }
    LDS_WAIT();
    const int c = lane & 7;
#pragma unroll
    for (int j = 0; j < 4; ++j) { const int n = (lane >> 3) + 8 * j; const LAS float* s = scr + (8 * c) * 33 + n;
        u32x4 o; o.x = pk2(s[0 * 33], s[1 * 33]); o.y = pk2(s[2 * 33], s[3 * 33]); o.z = pk2(s[4 * 33], s[5 * 33]); o.w = pk2(s[6 * 33], s[7 * 33]);
        *(u32x4*)(WT + (size_t)(n0 + n) * K + k0 + 8 * c) = o; }
    LDS_WAIT();
}

__device__ __forceinline__ void phase_prologue_a(PP p, LAS unsigned char* lds) {
    int tid_ = threadIdx.x; OPAQUE_V(tid_); const int tid = tid_, lane = tid & 63, wave = __builtin_amdgcn_readfirstlane(tid >> 6);
    const int gw = blockIdx.x * NWAVES + wave, NGW = gridDim.x * NWAVES;
    LAS float* scr = (LAS float*)(lds + wave * 16384);
    bf16_t* WT = (bf16_t*)(p->ws + WS_WT);
    constexpr int I_IN = 16 * (INW / 32), I_MKV = 16 * 32, I_OA = 8 * 32, I_OB = 4 * 32, I_OC = 8 * 32, I_OUT = 16 * 32, I_FIN = 16 * (2 * FFH / 32), I_FOUT = (FFH / 64) * 32;
    constexpr int I_L = I_IN + I_MKV + I_OA + I_OB + I_OC + I_OUT + I_FIN + I_FOUT;
    for (int it = gw; it < I_L * DEPTH; it += NGW) {
        const int l = it / I_L; int r = it % I_L;
        bf16_t* wl = WT + (size_t)l * WL;
        if (r < I_IN) { transpose_item<1>(p->w_in + (size_t)l * DM * INW, DM, INW, wl + WO_IN, scr, r, lane); continue; } r -= I_IN;
        if (r < I_MKV) { transpose_item<0>(p->w_mem_kv + (size_t)l * DM * 1024, DM, 1024, wl + WO_MKV, scr, r, lane); continue; } r -= I_MKV;
        if (r < I_OA) { transpose_item<0>(p->w_o_a + (size_t)l * 512 * DM, 512, DM, wl + WO_OA, scr, r, lane); continue; } r -= I_OA;
        if (r < I_OB) { transpose_item<0>(p->w_o_b + (size_t)l * 256 * DM, 256, DM, wl + WO_OB, scr, r, lane); continue; } r -= I_OB;
        if (r < I_OC) { transpose_item<0>(p->w_o_c + (size_t)l * 512 * DM, 512, DM, wl + WO_OC, scr, r, lane); continue; } r -= I_OC;
        if (r < I_OUT) { transpose_item<0>(p->w_out + (size_t)l * DM * DM, DM, DM, wl + WO_OUT, scr, r, lane); continue; } r -= I_OUT;
        if (r < I_FIN) { transpose_item<2>(p->w_ffn_in + (size_t)l * DM * 2 * FFH, DM, 2 * FFH, wl + WO_FIN, scr, r, lane); continue; } r -= I_FIN;
        transpose_item<0>(p->w_ffn_out + (size_t)l * FFH * DM, FFH, DM, wl + WO_FOUT, scr, r, lane);
    }
    float2* rope = (float2*)(p->ws + WS_ROPE);
    for (int i = blockIdx.x * NTHREADS + tid; i < SEQ * 8; i += gridDim.x * NTHREADS) {
        const int pos = i >> 3, j = i & 7;
        const float ang = (float)pos * p->inv_freq[j];
        const double rev = (double)ang * 0.15915494309189535;
        const float fr = (float)(rev - rint(rev));
        rope[i] = make_float2(__builtin_amdgcn_cosf(fr), __builtin_amdgcn_sinf(fr));
    }
    bf16_t* memn = (bf16_t*)(p->ws + WS_MEMN);
    for (int R = gw; R < NBATCH * NMEM; R += NGW) {
        const float* src = (R < 16 * NMEM) ? p->mem_prompt + (size_t)R * DM : p->mem_sample + (size_t)(R - 16 * NMEM) * DM;
        f32x4 v[4]; float ss = 0.f;
#pragma unroll
        for (int j = 0; j < 4; ++j) { v[j] = *(const f32x4*)(src + 4 * (lane + 64 * j)); ss += v[j].x * v[j].x + v[j].y * v[j].y + v[j].z * v[j].z + v[j].w * v[j].w; }
        const float rstd = 1.f / sqrtf(wave_sum(ss) * (1.f / DM) + EPS);
#pragma unroll
        for (int l = 0; l < DEPTH; ++l)
#pragma unroll
            for (int j = 0; j < 4; ++j) { const f32x4 g = *(const f32x4*)(p->g_mem + l * DM + 4 * (lane + 64 * j));
                u32x2 o; o.x = pk2(v[j].x * rstd * g.x, v[j].y * rstd * g.y); o.y = pk2(v[j].z * rstd * g.z, v[j].w * rstd * g.w);
                *(u32x2*)(memn + ((size_t)l * NBATCH * NMEM + R) * DM + 4 * (lane + 64 * j)) = o; }
    }
}

__device__ __forceinline__ const float* x_in_row(PP p, int GR) { return GR < 16 * SEQ ? p->x_prompt + (size_t)GR * DM : p->x_sample + (size_t)(GR - 16 * SEQ) * DM; }

__device__ __forceinline__ void phase_rows_first(PP p, int chunk) {
    int tid_ = threadIdx.x; OPAQUE_V(tid_); const int lane = tid_ & 63, wave = __builtin_amdgcn_readfirstlane(tid_ >> 6);
    bf16_t* H = (bf16_t*)(p->ws + WS_H);
    for (int r = blockIdx.x * NWAVES + wave; r < MC; r += gridDim.x * NWAVES) {
        const float* src = x_in_row(p, chunk * MC + r);
        f32x4 v[4]; float ss = 0.f;
#pragma unroll
        for (int j = 0; j < 4; ++j) { v[j] = *(const f32x4*)(src + 4 * (lane + 64 * j)); ss += v[j].x * v[j].x + v[j].y * v[j].y + v[j].z * v[j].z + v[j].w * v[j].w; }
        const float rstd = 1.f / sqrtf(wave_sum(ss) * (1.f / DM) + EPS);
#pragma unroll
        for (int j = 0; j < 4; ++j) { const f32x4 g = *(const f32x4*)(p->g_mix_pre + 4 * (lane + 64 * j));
            u32x2 o; o.x = pk2(v[j].x * rstd * g.x, v[j].y * rstd * g.y); o.y = pk2(v[j].z * rstd * g.z, v[j].w * rstd * g.w);
            *(u32x2*)(H + (size_t)r * DM + 4 * (lane + 64 * j)) = o; }
    }
}
struct RowBuf { f32x4 x[4]; u32x2 y[4]; };
__device__ __forceinline__ void row_load(RowBuf& b, const bf16_t* yrow, const float* xrow, int lane) {
#pragma unroll
    for (int j = 0; j < 4; ++j) { b.y[j] = __builtin_nontemporal_load((const u32x2*)(yrow + 4 * (lane + 64 * j))); b.x[j] = __builtin_nontemporal_load((const f32x4*)(xrow + 4 * (lane + 64 * j))); }
}
__device__ __forceinline__ void row_process(RowBuf& b, float* dst, bf16_t* hrow, const float* g_post, const float* g_next, bool write_h, int lane) {
    f32x4 y[4]; float ss = 0.f;
#pragma unroll
    for (int j = 0; j < 4; ++j) { y[j].x = bf2f(b.y[j].x & 0xffffu); y[j].y = bf2f(b.y[j].x >> 16); y[j].z = bf2f(b.y[j].y & 0xffffu); y[j].w = bf2f(b.y[j].y >> 16);
        ss += y[j].x * y[j].x + y[j].y * y[j].y + y[j].z * y[j].z + y[j].w * y[j].w; }
    const float ry = 1.f / sqrtf(wave_sum(ss) * (1.f / DM) + EPS);
    float sx = 0.f;
#pragma unroll
    for (int j = 0; j < 4; ++j) { const f32x4 g = *(const f32x4*)(g_post + 4 * (lane + 64 * j)); f32x4 x = b.x[j];
        x.x += y[j].x * ry * g.x; x.y += y[j].y * ry * g.y; x.z += y[j].z * ry * g.z; x.w += y[j].w * ry * g.w;
        __builtin_nontemporal_store(x, (f32x4*)(dst + 4 * (lane + 64 * j))); b.x[j] = x;
        sx += x.x * x.x + x.y * x.y + x.z * x.z + x.w * x.w; }
    if (write_h) {
        const float rx = 1.f / sqrtf(wave_sum(sx) * (1.f / DM) + EPS);
#pragma unroll
        for (int j = 0; j < 4; ++j) { const f32x4 g = *(const f32x4*)(g_next + 4 * (lane + 64 * j)); const f32x4 x = b.x[j];
            u32x2 o; o.x = pk2(x.x * rx * g.x, x.y * rx * g.y); o.y = pk2(x.z * rx * g.z, x.w * rx * g.w);
            *(u32x2*)(hrow + 4 * (lane + 64 * j)) = o; }
    }
}
__device__ __forceinline__ void phase_rows_resid(PP p, int chunk, bool src_is_input, const float* g_post, const float* g_next, bool write_h) {
    int tid_ = threadIdx.x; OPAQUE_V(tid_); const int lane = tid_ & 63, wave = __builtin_amdgcn_readfirstlane(tid_ >> 6);
    bf16_t* H = (bf16_t*)(p->ws + WS_H);
    const bf16_t* Y = (const bf16_t*)(p->ws + WS_Y);
    float* out = p->out;
    const int stride = gridDim.x * NWAVES;
    int r = blockIdx.x * NWAVES + wave;
    if (r >= MC) return;
    RowBuf A, B;
#define ROW_SRC(rr) (src_is_input ? x_in_row(p, chunk * MC + (rr)) : out + (size_t)(chunk * MC + (rr)) * DM)
    row_load(A, Y + (size_t)r * DM, ROW_SRC(r), lane);
    for (;;) {
        const int r1 = r + stride;
        if (r1 < MC) row_load(B, Y + (size_t)r1 * DM, ROW_SRC(r1), lane);
        row_process(A, out + (size_t)(chunk * MC + r) * DM, H + (size_t)r * DM, g_post, g_next, write_h, lane);
        if (r1 >= MC) break;
        const int r2 = r1 + stride;
        if (r2 < MC) row_load(A, Y + (size_t)r2 * DM, ROW_SRC(r2), lane);
        row_process(B, out + (size_t)(chunk * MC + r1) * DM, H + (size_t)r1 * DM, g_post, g_next, write_h, lane);
        if (r2 >= MC) break;
        r = r2;
    }
#undef ROW_SRC
}

__device__ __forceinline__ int pi32(int r) { return (r & 0x13) | ((r & 4) << 1) | ((r & 8) >> 1); }
template <int D> __device__ __forceinline__ size_t kblk_off(int p, int c8) { const int kt = p >> 5, r = pi32(p & 31); return ((size_t)(kt * (D / 16) + (c8 >> 1)) * 64 + (c8 & 1) * 32 + r) * 8; }
template <int D> __device__ __forceinline__ size_t vblk_off(int p, int d) { const int kt = p >> 5, w = p & 31; return ((((size_t)kt * (D / 32) + (d >> 5)) * 2 + (w >> 4)) * 64 + ((w >> 3) & 1) * 32 + (d & 31)) * 8 + (w & 7); }
template <int D> __device__ __forceinline__ void store8_vblk(bf16_t* img, int p, int d0, const f32x4& a, const f32x4& b) {
    const unsigned o0 = pk2(a.x, a.y), o1 = pk2(a.z, a.w), o2 = pk2(b.x, b.y), o3 = pk2(b.z, b.w);
    bf16_t* base = img + vblk_off<D>(p, d0);
    base[0] = (bf16_t)(o0 & 0xffffu); base[8] = (bf16_t)(o0 >> 16); base[16] = (bf16_t)(o1 & 0xffffu); base[24] = (bf16_t)(o1 >> 16);
    base[32] = (bf16_t)(o2 & 0xffffu); base[40] = (bf16_t)(o2 >> 16); base[48] = (bf16_t)(o3 & 0xffffu); base[56] = (bf16_t)(o3 >> 16);
}
__device__ __forceinline__ u32x4 pack8(const f32x4& a, const f32x4& b) { u32x4 o; o.x = pk2(a.x, a.y); o.y = pk2(a.z, a.w); o.z = pk2(b.x, b.y); o.w = pk2(b.z, b.w); return o; }
__device__ __forceinline__ void store8_strided(bf16_t* base, size_t stride, const f32x4& a, const f32x4& b) {
    const u32x4 o = pack8(a, b);
    base[0 * stride] = (bf16_t)(o.x & 0xffffu); base[1 * stride] = (bf16_t)(o.x >> 16); base[2 * stride] = (bf16_t)(o.y & 0xffffu); base[3 * stride] = (bf16_t)(o.y >> 16);
    base[4 * stride] = (bf16_t)(o.z & 0xffffu); base[5 * stride] = (bf16_t)(o.z >> 16); base[6 * stride] = (bf16_t)(o.w & 0xffffu); base[7 * stride] = (bf16_t)(o.w >> 16);
}
struct EpiIn {
    static constexpr bool PERM = true, AFTER_DRAIN = false;
    bf16_t* proj; bf16_t* vta; bf16_t* vtb; bf16_t* kba; bf16_t* kbb; const float* rope;
    __device__ __forceinline__ void operator()(const f32x4 (&acc)[2][2][4][2], const pg8::Unit& u, int wr, int wc, int fr, int fq) const {
        const int row0 = u.pm * 256 + wr * 64 + fr;
#pragma unroll
        for (int bj = 0; bj < 2; ++bj) {
            const int c128 = u.pn * 256 + bj * 128, cb = c128 + wc * 32 + 8 * fq;
            if (c128 >= 3584) {
#pragma unroll
                for (int ai = 0; ai < 2; ++ai)
#pragma unroll
                    for (int m = 0; m < 4; ++m) { const int row = row0 + ai * 128 + m * 16; f32x4 a = acc[ai][bj][m][0], b = acc[ai][bj][m][1];
                        a.x = sigmoidf_(a.x); a.y = sigmoidf_(a.y); a.z = sigmoidf_(a.z); a.w = sigmoidf_(a.w); b.x = sigmoidf_(b.x); b.y = sigmoidf_(b.y); b.z = sigmoidf_(b.z); b.w = sigmoidf_(b.w);
                        __builtin_nontemporal_store(pack8(a, b), (u32x4*)(proj + (size_t)row * INW + cb)); }
            } else if (c128 >= 3072) {
#pragma unroll
                for (int ai = 0; ai < 2; ++ai)
#pragma unroll
                    for (int m = 0; m < 4; ++m) { const int row = row0 + ai * 128 + m * 16; *(u32x4*)(proj + (size_t)row * INW + cb) = pack8(acc[ai][bj][m][0], acc[ai][bj][m][1]); }
            } else if (c128 == 640) {
                const int kvh = (cb - 640) >> 6, d0 = (cb - 640) & 63;
#pragma unroll
                for (int ai = 0; ai < 2; ++ai)
#pragma unroll
                    for (int m = 0; m < 4; ++m) { const int row = row0 + ai * 128 + m * 16, bl = row >> 11, pos = row & 2047;
                        store8_vblk<64>(vta + (size_t)(bl * 2 + kvh) * 64 * SEQ, pos, d0, acc[ai][bj][m][0], acc[ai][bj][m][1]); }
            } else if (c128 >= 2304) {
                const int hb = (cb - 2304) >> 6, d0 = (cb - 2304) & 63, sh = 2 * (hb >> 2);
#pragma unroll
                for (int ai = 0; ai < 2; ++ai)
#pragma unroll
                    for (int m = 0; m < 4; ++m) { const int row = row0 + ai * 128 + m * 16, bl = row >> 11, pos = row & 2047;
                        const int pg = (pos & ((1 << sh) - 1)) * (SEQ >> sh) + (pos >> sh);
                        store8_vblk<64>(vtb + (size_t)(bl * 12 + hb) * 64 * SEQ, pg, d0, acc[ai][bj][m][0], acc[ai][bj][m][1]); }
            } else {
                const bool rp = ((wc & 1) == 0) && (fq < 2);
#pragma unroll
                for (int ai = 0; ai < 2; ++ai)
#pragma unroll
                    for (int m = 0; m < 4; ++m) { const int row = row0 + ai * 128 + m * 16; f32x4 a = acc[ai][bj][m][0], b = acc[ai][bj][m][1];
                        if (rp) { const int pos = row & 2047; const f32x4* t = (const f32x4*)(rope + (size_t)pos * 16 + 8 * fq); const f32x4 t0 = t[0], t1 = t[1];
                            f32x4 a2, b2;
                            a2.x = a.x * t0.x - a.y * t0.y; a2.y = a.y * t0.x + a.x * t0.y; a2.z = a.z * t0.z - a.w * t0.w; a2.w = a.w * t0.z + a.z * t0.w;
                            b2.x = b.x * t1.x - b.y * t1.y; b2.y = b.y * t1.x + b.x * t1.y; b2.z = b.z * t1.z - b.w * t1.w; b2.w = b.w * t1.z + b.z * t1.w;
                            a = a2; b = b2; }
                        if (c128 == 512) {
                            const int bl = row >> 11, pos = row & 2047, kvh = (cb - 512) >> 6, c8 = ((cb - 512) & 63) >> 3;
                            *(u32x4*)(kba + (size_t)(bl * 2 + kvh) * 64 * SEQ + kblk_off<64>(pos, c8)) = pack8(a, b);
                        } else if (c128 >= 1536) {
                            const int bl = row >> 11, pos = row & 2047, hb = (cb - 1536) >> 6, c8 = ((cb - 1536) & 63) >> 3, sh = 2 * (hb >> 2);
                            const int pg = (pos & ((1 << sh) - 1)) * (SEQ >> sh) + (pos >> sh);
                            *(u32x4*)(kbb + (size_t)(bl * 12 + hb) * 64 * SEQ + kblk_off<64>(pg, c8)) = pack8(a, b);
                        } else *(u32x4*)(proj + (size_t)row * INW + cb) = pack8(a, b); }
            }
        }
    }
};
struct EpiMemKV {
    static constexpr bool PERM = true, AFTER_DRAIN = false;
    bf16_t* mk; bf16_t* mvt;
    __device__ __forceinline__ void operator()(const f32x4 (&acc)[2][2][4][2], const pg8::Unit& u, int wr, int wc, int fr, int fq) const {
        const int row0 = u.pm * 256 + wr * 64 + fr;
#pragma unroll
        for (int bj = 0; bj < 2; ++bj) {
            const int c128 = u.pn * 256 + bj * 128, cb = c128 + wc * 32 + 8 * fq;
            if (c128 < 512) {
#pragma unroll
                for (int ai = 0; ai < 2; ++ai)
#pragma unroll
                    for (int m = 0; m < 4; ++m) { const int row = row0 + ai * 128 + m * 16, b = row >> 8, j = row & 255, hc = cb >> 7, c8 = (cb & 127) >> 3;
                        *(u32x4*)(mk + (size_t)(b * 4 + hc) * 128 * NMEM + kblk_off<128>(j, c8)) = pack8(acc[ai][bj][m][0], acc[ai][bj][m][1]); }
            } else {
                const int hc = (cb - 512) >> 7, d0 = (cb - 512) & 127;
#pragma unroll
                for (int ai = 0; ai < 2; ++ai)
#pragma unroll
                    for (int m = 0; m < 4; ++m) { const int row = row0 + ai * 128 + m * 16, b = row >> 8, j = row & 255;
                        store8_vblk<128>(mvt + (size_t)(b * 4 + hc) * 128 * NMEM, j, d0, acc[ai][bj][m][0], acc[ai][bj][m][1]); }
            }
        }
    }
};
struct EpiGate {
    static constexpr bool PERM = true, AFTER_DRAIN = false;
    const bf16_t* gate; bf16_t* mrg; int accum;
    __device__ __forceinline__ void operator()(const f32x4 (&acc)[2][2][4][2], const pg8::Unit& u, int wr, int wc, int fr, int fq) const {
        const int row0 = u.pm * 256 + wr * 64 + fr, cb0 = u.pn * 256 + wc * 32 + 8 * fq;
#pragma unroll
        for (int ai = 0; ai < 2; ++ai) {
            u32x4 g[4][2], o[4][2];
#pragma unroll
            for (int m = 0; m < 4; ++m)
#pragma unroll
                for (int bj = 0; bj < 2; ++bj) g[m][bj] = __builtin_nontemporal_load((const u32x4*)(gate + (size_t)(row0 + ai * 128 + m * 16) * INW + cb0 + bj * 128));
            if (accum) {
#pragma unroll
                for (int m = 0; m < 4; ++m)
#pragma unroll
                    for (int bj = 0; bj < 2; ++bj) o[m][bj] = *(const u32x4*)(mrg + (size_t)(row0 + ai * 128 + m * 16) * DM + cb0 + bj * 128);
            }
#pragma unroll
            for (int m = 0; m < 4; ++m)
#pragma unroll
                for (int bj = 0; bj < 2; ++bj) {
                    const u32x4 gg = g[m][bj];
                    f32x4 a = acc[ai][bj][m][0], b = acc[ai][bj][m][1];
                    a.x *= bf2f(gg.x & 0xffffu); a.y *= bf2f(gg.x >> 16); a.z *= bf2f(gg.y & 0xffffu); a.w *= bf2f(gg.y >> 16);
                    b.x *= bf2f(gg.z & 0xffffu); b.y *= bf2f(gg.z >> 16); b.z *= bf2f(gg.w & 0xffffu); b.w *= bf2f(gg.w >> 16);
                    if (accum) { const u32x4 oo = o[m][bj];
                        a.x += bf2f(oo.x & 0xffffu); a.y += bf2f(oo.x >> 16); a.z += bf2f(oo.y & 0xffffu); a.w += bf2f(oo.y >> 16);
                        b.x += bf2f(oo.z & 0xffffu); b.y += bf2f(oo.z >> 16); b.z += bf2f(oo.w & 0xffffu); b.w += bf2f(oo.w >> 16); }
                    *(u32x4*)(mrg + (size_t)(row0 + ai * 128 + m * 16) * DM + cb0 + bj * 128) = pack8(a, b);
                }
        }
    }
};
struct EpiY {
    static constexpr bool PERM = true, AFTER_DRAIN = false;
    bf16_t* Y;
    __device__ __forceinline__ void operator()(const f32x4 (&acc)[2][2][4][2], const pg8::Unit& u, int wr, int wc, int fr, int fq) const {
        const int row0 = u.pm * 256 + wr * 64 + fr;
#pragma unroll
        for (int ai = 0; ai < 2; ++ai)
#pragma unroll
            for (int m = 0; m < 4; ++m)
#pragma unroll
                for (int bj = 0; bj < 2; ++bj)
                    *(u32x4*)(Y + (size_t)(row0 + ai * 128 + m * 16) * DM + u.pn * 256 + bj * 128 + wc * 32 + 8 * fq) = pack8(acc[ai][bj][m][0], acc[ai][bj][m][1]);
    }
};
struct EpiSwiGLU {
    static constexpr bool PERM = true, AFTER_DRAIN = false;
    bf16_t* act;
    __device__ __forceinline__ void operator()(const f32x4 (&acc)[2][2][4][2], const pg8::Unit& u, int wr, int wc, int fr, int fq) const {
        const int row0 = u.pm * 256 + wr * 64 + fr;
#pragma unroll
        for (int ai = 0; ai < 2; ++ai)
#pragma unroll
            for (int m = 0; m < 4; ++m)
#pragma unroll
                for (int bj = 0; bj < 2; ++bj) { const int cb = u.pn * 256 + bj * 128 + wc * 32 + 8 * fq; const f32x4 g = acc[ai][bj][m][0], v = acc[ai][bj][m][1];
                    u32x2 o; o.x = pk2(g.x * sigmoidf_(g.x) * v.x, g.y * sigmoidf_(g.y) * v.y); o.y = pk2(g.z * sigmoidf_(g.z) * v.z, g.w * sigmoidf_(g.w) * v.w);
                    *(u32x2*)(act + (size_t)(row0 + ai * 128 + m * 16) * FFH + (cb >> 1)) = o; }
    }
};
#ifndef GATE_FAST
#define GATE_FAST true
#endif
template <class Epi, bool FAST = true>
__device__ __forceinline__ void run_gemm(LAS unsigned char* lds, const bf16_t* A, const bf16_t* Bt, int M, int N, int K, const Epi& E, int crot) {
    pg8::Gemm g; g.A = A; g.Bt = Bt; g.M = M; g.N = N; g.K = K;
    pg8::StaticOrder S; S.init(M, N, (int)gridDim.x, (int)((blockIdx.x + crot) % gridDim.x));
    pg8::gemm_phase<Epi, pg8::StaticOrder, FAST, FAST>(lds, g, S, E);
}

struct AttnTask {
    const bf16_t* q; long qstride;
    const bf16_t* kb; const bf16_t* vb;
    bf16_t* o; long ostride;
    float* lse; long lsestride;
    int m0, L, W;
    float m_init, l_init, scale2;
};
template <int D>
__device__ __forceinline__ void attn_load_k(bf16x8 (&kf)[D / 16], const AttnTask& t, int k0, int lane) {
    const bf16_t* kp = t.kb + ((size_t)(k0 >> 5) * (D / 16) * 64 + lane) * 8;
#pragma unroll
    for (int kk = 0; kk < D / 16; ++kk) kf[kk] = *(const bf16x8*)(kp + kk * 512);
}
template <int D>
__device__ __forceinline__ void attn_load_v(bf16x8 (&vf)[D / 32][2], const AttnTask& t, int k0, int lane) {
    const bf16_t* vp = t.vb + ((size_t)(k0 >> 5) * (D / 32) * 128 + lane) * 8;
#pragma unroll
    for (int db = 0; db < D / 32; ++db)
#pragma unroll
        for (int s = 0; s < 2; ++s) vf[db][s] = *(const bf16x8*)(vp + (db * 2 + s) * 512);
}
__device__ __forceinline__ float xhalf_max(float v) { const auto r = __builtin_amdgcn_permlane32_swap(__float_as_uint(v), __float_as_uint(v), false, false); return fmaxf(__uint_as_float(r[0]), __uint_as_float(r[1])); }
__device__ __forceinline__ float xhalf_sum(float v) { const auto r = __builtin_amdgcn_permlane32_swap(__float_as_uint(v), __float_as_uint(v), false, false); return __uint_as_float(r[0]) + __uint_as_float(r[1]); }
template <int D, bool MASK>
__device__ __forceinline__ void attn_tile(const bf16x8 (&qf)[D / 16], const bf16x8 (&kf)[D / 16], const bf16x8 (&vf)[D / 32][2], f32x16 (&o)[D / 32], float& mrun, float& lrun,
                                          const AttnTask& t, int k0, int mq, int qi, int h) {
    f32x16 sc;
#pragma unroll
    for (int i = 0; i < 16; ++i) sc[i] = 0.f;
#pragma unroll
    for (int kk = 0; kk < D / 16; ++kk) sc = __builtin_amdgcn_mfma_f32_32x32x16_bf16(kf[kk], qf[kk], sc, 0, 0, 0);
    if (MASK) {
        if (k0 == mq - t.W || k0 == mq + t.W) {
#pragma unroll
            for (int i = 0; i < 16; ++i) { const int dlt = k0 + 16 * (i >> 3) + 8 * h + (i & 7) - qi; sc[i] = (dlt <= t.W && dlt >= -t.W) ? sc[i] : -1e30f; }
        }
    }
    float mt = sc[0];
#pragma unroll
    for (int i = 1; i < 16; ++i) mt = fmaxf(mt, sc[i]);
    mt = xhalf_max(mt) * t.scale2;
    const float mn = fmaxf(mrun, mt), alpha = fexp2(mrun - mn);
    float ps = 0.f;
#pragma unroll
    for (int i = 0; i < 16; ++i) { sc[i] = fexp2(__builtin_fmaf(sc[i], t.scale2, -mn)); ps += sc[i]; }
    ps = xhalf_sum(ps);
    lrun = lrun * alpha + ps; mrun = mn;
#pragma unroll
    for (int db = 0; db < D / 32; ++db)
#pragma unroll
        for (int i = 0; i < 16; ++i) o[db][i] *= alpha;
    bf16x8 pf[2];
#pragma unroll
    for (int s = 0; s < 2; ++s) { u32x4 w; w.x = pk2(sc[8 * s + 0], sc[8 * s + 1]); w.y = pk2(sc[8 * s + 2], sc[8 * s + 3]); w.z = pk2(sc[8 * s + 4], sc[8 * s + 5]); w.w = pk2(sc[8 * s + 6], sc[8 * s + 7]);
        pf[s] = __builtin_bit_cast(bf16x8, w); }
#pragma unroll
    for (int db = 0; db < D / 32; ++db)
#pragma unroll
        for (int s = 0; s < 2; ++s) o[db] = __builtin_amdgcn_mfma_f32_32x32x16_bf16(vf[db][s], pf[s], o[db], 0, 0, 0);
}
template <int D, bool MASK, bool PFV, int NQ>
__device__ __forceinline__ void attn_wave(const AttnTask& t, int lane) {
    const int r = lane & 31, h = lane >> 5;
    bf16x8 qf[NQ][D / 16];
#pragma unroll
    for (int q = 0; q < NQ; ++q) { const bf16_t* qp = t.q + (long)(t.m0 + 32 * q + r) * t.qstride + 8 * h;
#pragma unroll
        for (int kk = 0; kk < D / 16; ++kk) qf[q][kk] = *(const bf16x8*)(qp + 16 * kk); }
    f32x16 o[NQ][D / 32];
    float mrun[NQ], lrun[NQ];
#pragma unroll
    for (int q = 0; q < NQ; ++q) { mrun[q] = t.m_init; lrun[q] = t.l_init;
#pragma unroll
        for (int db = 0; db < D / 32; ++db)
#pragma unroll
            for (int i = 0; i < 16; ++i) o[q][db][i] = 0.f; }
    int klo = 0, khi = t.L;
    if (MASK) { klo = t.m0 - t.W; if (klo < 0) klo = 0; khi = t.m0 + 32 * NQ + t.W; if (khi > t.L) khi = t.L; }
    bf16x8 ka[D / 16], kb[D / 16], va[D / 32][2], vb[D / 32][2];
    attn_load_k<D>(ka, t, klo, lane);
    attn_load_v<D>(va, t, klo, lane);
#define ATT_TILES(KF, VF, K0) do { _Pragma("unroll") for (int q = 0; q < NQ; ++q) { const int mq = t.m0 + 32 * q; \
        if (!MASK || NQ == 1 || ((K0) >= mq - t.W && (K0) <= mq + t.W)) attn_tile<D, MASK>(qf[q], KF, VF, o[q], mrun[q], lrun[q], t, (K0), mq, mq + r, h); } } while (0)
    for (int k0 = klo; k0 < khi; k0 += 64) {
        const int k1 = k0 + 32, k2 = (k0 + 64 < khi) ? k0 + 64 : klo;
        const bool has1 = k1 < khi;
        attn_load_k<D>(kb, t, has1 ? k1 : klo, lane);
        if (PFV) attn_load_v<D>(vb, t, has1 ? k1 : klo, lane);
        __builtin_amdgcn_sched_barrier(0);
        ATT_TILES(ka, va, k0);
        __builtin_amdgcn_sched_barrier(0);
        if (!has1) break;
        if (!PFV) attn_load_v<D>(vb, t, k1, lane);
        attn_load_k<D>(ka, t, k2, lane);
        if (PFV) attn_load_v<D>(va, t, k2, lane);
        __builtin_amdgcn_sched_barrier(0);
        ATT_TILES(kb, vb, k1);
        __builtin_amdgcn_sched_barrier(0);
        if (!PFV) attn_load_v<D>(va, t, k2, lane);
    }
#undef ATT_TILES
#pragma unroll
    for (int q = 0; q < NQ; ++q) {
        const int qi = t.m0 + 32 * q + r;
        const float inv = 1.f / lrun[q];
        bf16_t* op = t.o + (long)qi * t.ostride + 4 * h;
#pragma unroll
        for (int db = 0; db < D / 32; ++db)
#pragma unroll
            for (int g = 0; g < 4; ++g) { u32x2 w; w.x = pk2(o[q][db][4 * g + 0] * inv, o[q][db][4 * g + 1] * inv); w.y = pk2(o[q][db][4 * g + 2] * inv, o[q][db][4 * g + 3] * inv);
                *(u32x2*)(op + 32 * db + 8 * g) = w; }
        if (t.lse != nullptr && h == 0) t.lse[(long)qi * t.lsestride] = (mrun[q] + __builtin_amdgcn_logf(lrun[q])) * LN2;
    }
}

__device__ __forceinline__ void attn_wave_mem_lds(const AttnTask& t, LAS unsigned char* lds, int lane) {
    constexpr int D = 128;
    const int r = lane & 31, h = lane >> 5;
    bf16x8 qf[D / 16];
    const bf16_t* qp = t.q + (long)(t.m0 + r) * t.qstride + 8 * h;
#pragma unroll
    for (int kk = 0; kk < D / 16; ++kk) qf[kk] = *(const bf16x8*)(qp + 16 * kk);
    f32x16 o[D / 32];
#pragma unroll
    for (int db = 0; db < D / 32; ++db)
#pragma unroll
        for (int i = 0; i < 16; ++i) o[db][i] = 0.f;
    float mrun = t.m_init, lrun = t.l_init;
    const int qi = t.m0 + r;
    for (int kt = 0; kt < NMEM / 32; ++kt) {
        bf16x8 kf[D / 16], vf[D / 32][2];
#pragma unroll
        for (int kk = 0; kk < D / 16; ++kk) kf[kk] = *(const LAS bf16x8*)(lds + ((kt * (D / 16) + kk) * 64 + lane) * 16);
#pragma unroll
        for (int db = 0; db < D / 32; ++db)
#pragma unroll
            for (int s = 0; s < 2; ++s) vf[db][s] = *(const LAS bf16x8*)(lds + 65536 + (((kt * (D / 32) + db) * 2 + s) * 64 + lane) * 16);
        attn_tile<D, false>(qf, kf, vf, o, mrun, lrun, t, kt * 32, t.m0, qi, h);
    }
    const float inv = 1.f / lrun;
    bf16_t* op = t.o + (long)qi * t.ostride + 4 * h;
#pragma unroll
    for (int db = 0; db < D / 32; ++db)
#pragma unroll
        for (int g = 0; g < 4; ++g) { u32x2 w; w.x = pk2(o[db][4 * g + 0] * inv, o[db][4 * g + 1] * inv); w.y = pk2(o[db][4 * g + 2] * inv, o[db][4 * g + 3] * inv);
            *(u32x2*)(op + 32 * db + 8 * g) = w; }
}

__device__ __forceinline__ void attn_wave_win_lds(const AttnTask& t, LAS unsigned char* lds, int kt0, int lane) {
    constexpr int D = 64;
    const int r = lane & 31, h = lane >> 5;
    bf16x8 qf[D / 16];
    const bf16_t* qp = t.q + (long)(t.m0 + r) * t.qstride + 8 * h;
#pragma unroll
    for (int kk = 0; kk < D / 16; ++kk) qf[kk] = *(const bf16x8*)(qp + 16 * kk);
    f32x16 o[D / 32];
#pragma unroll
    for (int db = 0; db < D / 32; ++db)
#pragma unroll
        for (int i = 0; i < 16; ++i) o[db][i] = 0.f;
    float mrun = t.m_init, lrun = t.l_init;
    const int qi = t.m0 + r;
    int kta = (t.m0 - t.W) >> 5, ktb = (t.m0 + t.W) >> 5;
    if (kta < 0) kta = 0;
    if (ktb > t.L / 32 - 1) ktb = t.L / 32 - 1;
    for (int kt = kta; kt <= ktb; ++kt) {
        const int slot = kt - kt0;
        bf16x8 kf[D / 16], vf[D / 32][2];
#pragma unroll
        for (int kk = 0; kk < D / 16; ++kk) kf[kk] = *(const LAS bf16x8*)(lds + ((slot * (D / 16) + kk) * 64 + lane) * 16);
#pragma unroll
        for (int db = 0; db < D / 32; ++db)
#pragma unroll
            for (int s = 0; s < 2; ++s) vf[db][s] = *(const LAS bf16x8*)(lds + 65536 + (((slot * (D / 32) + db) * 2 + s) * 64 + lane) * 16);
        attn_tile<D, true>(qf, kf, vf, o, mrun, lrun, t, kt * 32, t.m0, qi, h);
    }
    const float inv = 1.f / lrun;
    bf16_t* op = t.o + (long)qi * t.ostride + 4 * h;
#pragma unroll
    for (int db = 0; db < D / 32; ++db)
#pragma unroll
        for (int g = 0; g < 4; ++g) { u32x2 w; w.x = pk2(o[db][4 * g + 0] * inv, o[db][4 * g + 1] * inv); w.y = pk2(o[db][4 * g + 2] * inv, o[db][4 * g + 3] * inv);
            *(u32x2*)(op + 32 * db + 8 * g) = w; }
}

__device__ __forceinline__ void phase_attention(PP p, LAS unsigned char* lds, int chunk, int layer) {
    int tid_ = threadIdx.x; OPAQUE_V(tid_); const int tid = tid_, lane = tid & 63, wave = __builtin_amdgcn_readfirstlane(tid >> 6);
    const bf16_t* proj = (const bf16_t*)(p->ws + WS_PROJ);
    const bf16_t* vta = (const bf16_t*)(p->ws + WS_VTA);
    const bf16_t* vtb = (const bf16_t*)(p->ws + WS_VTB);
    const bf16_t* kba = (const bf16_t*)(p->ws + WS_KBA); const bf16_t* kbb = (const bf16_t*)(p->ws + WS_KBB);
    bf16_t* oa = (bf16_t*)(p->ws + WS_OA); bf16_t* ob = (bf16_t*)(p->ws + WS_OB); bf16_t* oc = (bf16_t*)(p->ws + WS_OC);
    bf16_t* og = (bf16_t*)(p->ws + WS_OG); float* lseb = (float*)(p->ws + WS_LSE);
    const bf16_t* memk = (const bf16_t*)(p->ws + WS_MEMK) + (size_t)layer * NBATCH * NMEM * 512;
    const bf16_t* memvt = (const bf16_t*)(p->ws + WS_MEMVT) + (size_t)layer * NBATCH * NMEM * 512;
    constexpr int NT_B = CB * 4 * 4, NT_A = CB * 8 * 8, NT_C = CB * 4 * 8;
    for (int task = blockIdx.x; task < NT_B + NT_A + NT_C; task += gridDim.x) {
        if (task < NT_B) {
            const int bl = task >> 4, hh = (task >> 2) & 3, sp = task & 3;
            for (int wt = wave; wt < 32; wt += NWAVES) {
                const int g = wt < 8 ? 0 : (wt < 16 ? 1 : 2), tq = wt < 16 ? (wt & 7) : (wt - 16), sh = 2 * g, dil = 1 << sh, L = SEQ >> sh, hb = 4 * g + hh;
                int c, m0;
                if (g == 0) { c = 0; m0 = sp * 512 + 64 * tq; } else if (g == 1) { c = tq >> 1; m0 = sp * 128 + 64 * (tq & 1); } else { c = tq; m0 = sp * 32; }
                AttnTask t;
                const size_t rowb = (size_t)bl * SEQ + c;
                t.q = proj + rowb * INW + 768 + hb * 64; t.qstride = (long)dil * INW;
                t.kb = kbb + (size_t)(bl * 12 + hb) * 64 * SEQ + (size_t)c * L * 64; t.vb = vtb + (size_t)(bl * 12 + hb) * 64 * SEQ + (size_t)c * L * 64;
                t.o = og + (size_t)g * MC * 256 + rowb * 256 + hh * 64; t.ostride = (long)dil * 256;
                t.lse = lseb + (size_t)g * MC * 4 + rowb * 4 + hh; t.lsestride = (long)dil * 4;
                t.m0 = m0; t.L = L; t.W = 64; t.m_init = -1e30f; t.l_init = 0.f; t.scale2 = 0.125f * LOG2E;
                if (g == 2) attn_wave<64, true, true, 1>(t, lane); else attn_wave<64, true, true, 2>(t, lane);
            }
            __syncthreads();
            {
                const size_t row = (size_t)bl * SEQ + sp * 512 + tid;
                const float l0 = lseb[row * 4 + hh], l1 = lseb[(size_t)MC * 4 + row * 4 + hh], l2 = lseb[(size_t)2 * MC * 4 + row * 4 + hh];
                const float mx = fmaxf(l0, fmaxf(l1, l2));
                float a0 = fexp2((l0 - mx) * LOG2E), a1 = fexp2((l1 - mx) * LOG2E), a2 = fexp2((l2 - mx) * LOG2E);
                const float is = 1.f / (a0 + a1 + a2); a0 *= is; a1 *= is; a2 *= is;
                const bf16_t* s0 = og + row * 256 + hh * 64; const bf16_t* s1 = s0 + (size_t)MC * 256; const bf16_t* s2 = s1 + (size_t)MC * 256;
                bf16_t* dp = ob + row * 256 + hh * 64;
#pragma unroll
                for (int j = 0; j < 8; ++j) { const u32x4 x0 = *(const u32x4*)(s0 + 8 * j), x1 = *(const u32x4*)(s1 + 8 * j), x2 = *(const u32x4*)(s2 + 8 * j);
                    u32x4 w;
                    w.x = pk2(a0 * bf2f(x0.x & 0xffffu) + a1 * bf2f(x1.x & 0xffffu) + a2 * bf2f(x2.x & 0xffffu), a0 * bf2f(x0.x >> 16) + a1 * bf2f(x1.x >> 16) + a2 * bf2f(x2.x >> 16));
                    w.y = pk2(a0 * bf2f(x0.y & 0xffffu) + a1 * bf2f(x1.y & 0xffffu) + a2 * bf2f(x2.y & 0xffffu), a0 * bf2f(x0.y >> 16) + a1 * bf2f(x1.y >> 16) + a2 * bf2f(x2.y >> 16));
                    w.z = pk2(a0 * bf2f(x0.z & 0xffffu) + a1 * bf2f(x1.z & 0xffffu) + a2 * bf2f(x2.z & 0xffffu), a0 * bf2f(x0.z >> 16) + a1 * bf2f(x1.z >> 16) + a2 * bf2f(x2.z >> 16));
                    w.w = pk2(a0 * bf2f(x0.w & 0xffffu) + a1 * bf2f(x1.w & 0xffffu) + a2 * bf2f(x2.w & 0xffffu), a0 * bf2f(x0.w >> 16) + a1 * bf2f(x1.w >> 16) + a2 * bf2f(x2.w >> 16));
                    *(u32x4*)(dp + 8 * j) = w; }
            }
            __syncthreads();
        } else
        if (task < NT_B + NT_A) {
            const int ta = task - NT_B, bl = ta >> 6, ha = (ta >> 3) & 7, sp = ta & 7;
            AttnTask t;
            const size_t rowb = (size_t)bl * SEQ;
            t.q = proj + rowb * INW + ha * 64; t.qstride = INW;
            t.kb = kba + (size_t)(bl * 2 + (ha >> 2)) * 64 * SEQ; t.vb = vta + (size_t)(bl * 2 + (ha >> 2)) * 64 * SEQ;
            t.o = oa + rowb * 512 + ha * 64; t.ostride = 512; t.lse = nullptr; t.lsestride = 0;
            t.m0 = sp * 256 + 32 * wave; t.L = SEQ; t.W = 128; t.m_init = p->sink_a[layer * 8 + ha] * LOG2E; t.l_init = 1.f; t.scale2 = 0.125f * LOG2E;
            const int kt0 = 8 * sp - 4;
            {
                const char* ks = (const char*)t.kb + (long)kt0 * 4096; const char* vs = (const char*)t.vb + (long)kt0 * 4096;
                u32x4 tmp[16];
#pragma unroll
                for (int i = 0; i < 8; ++i) { const int c = tid + 512 * i, kt = kt0 + (c >> 8); const bool ok = kt >= 0 && kt < SEQ / 32;
                    tmp[i] = ok ? *(const u32x4*)(ks + (long)c * 16) : (u32x4){0u, 0u, 0u, 0u}; tmp[8 + i] = ok ? *(const u32x4*)(vs + (long)c * 16) : (u32x4){0u, 0u, 0u, 0u}; }
#pragma unroll
                for (int i = 0; i < 8; ++i) { *(LAS u32x4*)(lds + (tid + 512 * i) * 16) = tmp[i]; *(LAS u32x4*)(lds + 65536 + (tid + 512 * i) * 16) = tmp[8 + i]; }
            }
            __syncthreads();
            attn_wave_win_lds(t, lds, kt0, lane);
            __syncthreads();
        } else {
            const int tc = task - NT_B - NT_A, bl = tc >> 5, hc = (tc >> 3) & 3, sp = tc & 7, bg = chunk * CB + bl;
            AttnTask t;
            const size_t rowb = (size_t)bl * SEQ;
            t.q = proj + rowb * INW + 3072 + hc * 128; t.qstride = INW;
            t.kb = memk + (size_t)(bg * 4 + hc) * 128 * NMEM; t.vb = memvt + (size_t)(bg * 4 + hc) * 128 * NMEM;
            t.o = oc + rowb * 512 + hc * 128; t.ostride = 512; t.lse = nullptr; t.lsestride = 0;
            t.m0 = sp * 256 + 32 * wave; t.L = NMEM; t.W = 0; t.m_init = -1e30f; t.l_init = 0.f; t.scale2 = 0.08838834764831845f * LOG2E;
            {
                const u32x4* ks = (const u32x4*)t.kb; const u32x4* vs = (const u32x4*)t.vb;
                u32x4 tmp[16];
#pragma unroll
                for (int i = 0; i < 8; ++i) { tmp[i] = ks[tid + 512 * i]; tmp[8 + i] = vs[tid + 512 * i]; }
#pragma unroll
                for (int i = 0; i < 8; ++i) { *(LAS u32x4*)(lds + (tid + 512 * i) * 16) = tmp[i]; *(LAS u32x4*)(lds + 65536 + (tid + 512 * i) * 16) = tmp[8 + i]; }
            }
            __syncthreads();
            attn_wave_mem_lds(t, lds, lane);
            __syncthreads();
        }
    }
}

#define XB_TMO      128
#define XB_XCNT(j)  (256  + 64 * (j))
#define XB_XSUB(j)  (1280 + 64 * (j))
#define XB_XGEN(j)  (2304 + 64 * (j))
#define XB_TOP      3328
#define XB_TOPGEN   3392
#define XCD_BAR_WORDS 3456
#define XB_SPIN_CAP (1u << 18)

__device__ __forceinline__ unsigned xb_ld(unsigned* p)              { return __hip_atomic_load(p, __ATOMIC_RELAXED, __HIP_MEMORY_SCOPE_AGENT); }
__device__ __forceinline__ unsigned xb_add(unsigned* p, unsigned v) { return __hip_atomic_fetch_add(p, v, __ATOMIC_RELAXED, __HIP_MEMORY_SCOPE_AGENT); }
__device__ __forceinline__ unsigned xb_xcc_id() { return (unsigned)__builtin_amdgcn_s_getreg((3 << 11) | 20) & 0xFu; }
#define XB_SPIN(cond, bar) do { unsigned _sp = 0; while (cond) { __builtin_amdgcn_s_sleep(1); \
    if ((++_sp & 255u) == 0u) { if (xb_ld(&(bar)[XB_TMO])) break; if (_sp > XB_SPIN_CAP) { atomicAdd(&(bar)[XB_TMO], 1u); break; } } } } while (0)
struct XcdBarrier {
    unsigned* bar; unsigned x;
    volatile LAS unsigned* st;
};

__device__ __forceinline__ XcdBarrier xcd_barrier_post(unsigned* bar, volatile LAS unsigned* st) {
    XcdBarrier b; b.bar = bar; b.x = xb_xcc_id(); b.st = st;
    if (threadIdx.x == 0) (void)xb_add(&bar[XB_XCNT(b.x)], 1u);
    return b;
}
__device__ __forceinline__ void xcd_barrier_complete(unsigned* bar, unsigned x, unsigned& nloc, unsigned& nx) {
    const unsigned G = gridDim.x * gridDim.y * gridDim.z;
    unsigned sum, cnt, mine, sp = 0u;
    for (;;) {
        sum = 0u; cnt = 0u; mine = 0u;
#pragma unroll
        for (unsigned j = 0; j < 16; ++j) { const unsigned c = xb_ld(&bar[XB_XCNT(j)]); sum += c; cnt += (c > 0u) ? 1u : 0u; mine = (j == x) ? c : mine; }
        if (sum == G) break;
        __builtin_amdgcn_s_sleep(1);
        if ((++sp & 255u) == 0u) { if (xb_ld(&bar[XB_TMO])) break; if (sp > XB_SPIN_CAP) { atomicAdd(&bar[XB_TMO], 1u); break; } }
    }
    nloc = mine > 0u ? mine : 1u; nx = cnt > 0u ? cnt : 1u;
}

__device__ __forceinline__ void xcd_barrier(const XcdBarrier& b) {
    asm volatile("s_waitcnt vmcnt(0)" ::: "memory");
    __syncthreads();
    if (threadIdx.x == 0) {
        unsigned* bar = b.bar;
        __builtin_amdgcn_s_waitcnt(0);
        unsigned nloc = b.st[0], nx = b.st[1];
        if (nloc == 0u) { xcd_barrier_complete(bar, b.x, nloc, nx); b.st[0] = nloc; b.st[1] = nx; }
        const unsigned old = xb_add(&bar[XB_XSUB(b.x)], 1u);
        const unsigned gen = old / nloc;
        if (old + 1u == (gen + 1u) * nloc) {
            __builtin_amdgcn_fence(__ATOMIC_RELEASE, "agent");
            asm volatile("s_waitcnt vmcnt(0)" ::: "memory");
            const unsigned og = xb_add(&bar[XB_TOP], 1u);
            const unsigned tg = og / nx;
            if (og + 1u == (tg + 1u) * nx) xb_add(&bar[XB_TOPGEN], 1u);
            else XB_SPIN(xb_ld(&bar[XB_TOPGEN]) == tg, bar);
            __builtin_amdgcn_fence(__ATOMIC_ACQUIRE, "agent");
            xb_add(&bar[XB_XGEN(b.x)], 1u);
            asm volatile("s_waitcnt vmcnt(0)" ::: "memory");
        } else {
            XB_SPIN(xb_ld(&bar[XB_XGEN(b.x)]) == gen, bar);
            __builtin_amdgcn_fence(__ATOMIC_ACQUIRE, "agent");
            asm volatile("s_waitcnt vmcnt(0)" ::: "memory");
        }
    }
    __syncthreads();
}


constexpr int STEPS_PER_CHUNK = 1 + DEPTH * 8, N_STEPS = 2 + NCHUNK * STEPS_PER_CHUNK;
__device__ __forceinline__ void run_step(PP p, LAS unsigned char* lds, int s) {
    bf16_t* WT = (bf16_t*)(p->ws + WS_WT);
    if (s == 0) { phase_prologue_a(p, lds); return; }
    if (s == 1) {
        for (int l = 0; l < DEPTH; ++l) { EpiMemKV E; E.mk = (bf16_t*)(p->ws + WS_MEMK) + (size_t)l * NBATCH * NMEM * 512; E.mvt = (bf16_t*)(p->ws + WS_MEMVT) + (size_t)l * NBATCH * NMEM * 512;
            run_gemm(lds, (const bf16_t*)(p->ws + WS_MEMN) + (size_t)l * NBATCH * NMEM * DM, WT + (size_t)l * WL + WO_MKV, NBATCH * NMEM, 1024, DM, E, 64 * l); }
        return;
    }
    const int s2 = s - 2, chunk = s2 / STEPS_PER_CHUNK, r = s2 % STEPS_PER_CHUNK;
    if (r == 0) { phase_rows_first(p, chunk); return; }
    const int l = (r - 1) >> 3, ph = (r - 1) & 7;
    const bf16_t* wl = WT + (size_t)l * WL;
    bf16_t* H = (bf16_t*)(p->ws + WS_H); bf16_t* proj = (bf16_t*)(p->ws + WS_PROJ); bf16_t* mrg = (bf16_t*)(p->ws + WS_MRG);
    switch (ph) {
    case 0: { EpiIn E; E.proj = proj; E.vta = (bf16_t*)(p->ws + WS_VTA); E.vtb = (bf16_t*)(p->ws + WS_VTB); E.kba = (bf16_t*)(p->ws + WS_KBA); E.kbb = (bf16_t*)(p->ws + WS_KBB); E.rope = (const float*)(p->ws + WS_ROPE);
        run_gemm(lds, H, wl + WO_IN, MC, INW, DM, E, 0); } break;
    case 1: phase_attention(p, lds, chunk, l); break;
    case 2: {
        EpiGate E; E.mrg = mrg;
        E.gate = proj + 3584; E.accum = 0; run_gemm<EpiGate, GATE_FAST>(lds, (const bf16_t*)(p->ws + WS_OA), wl + WO_OA, MC, DM, 512, E, 0);
        E.gate = proj + 3584 + 1024; E.accum = 1; run_gemm<EpiGate, GATE_FAST>(lds, (const bf16_t*)(p->ws + WS_OB), wl + WO_OB, MC, DM, 256, E, 0);
        E.gate = proj + 3584 + 2048; E.accum = 1; run_gemm<EpiGate, GATE_FAST>(lds, (const bf16_t*)(p->ws + WS_OC), wl + WO_OC, MC, DM, 512, E, 0);
        } break;
    case 3: { EpiY E; E.Y = (bf16_t*)(p->ws + WS_Y); run_gemm(lds, mrg, wl + WO_OUT, MC, DM, DM, E, 0); } break;
    case 4: phase_rows_resid(p, chunk, l == 0, p->g_mix_post + l * DM, p->g_ffn_pre + l * DM, true); break;
    case 5: { EpiSwiGLU E; E.act = (bf16_t*)(p->ws + WS_ACT); run_gemm(lds, H, wl + WO_FIN, MC, 2 * FFH, DM, E, 0); } break;
    case 6: { EpiY E; E.Y = (bf16_t*)(p->ws + WS_Y); run_gemm(lds, (const bf16_t*)(p->ws + WS_ACT), wl + WO_FOUT, MC, DM, FFH, E, 0); } break;
    default: phase_rows_resid(p, chunk, false, p->g_ffn_post + l * DM, p->g_mix_pre + (l < DEPTH - 1 ? l + 1 : l) * DM, l < DEPTH - 1); break;
    }
}

__global__ void __launch_bounds__(NTHREADS, 2) fwd_megakernel(Params p) {
    extern __shared__ __attribute__((aligned(16))) unsigned char lds_raw[];
    LAS unsigned char* lds = (LAS unsigned char*)lds_raw;
    cg::grid_group grid = cg::this_grid();
    PP pp = (PP)__builtin_amdgcn_kernarg_segment_ptr();
    const int s_hi = pp->s_hi;
    __shared__ uint4 xb_words;
    if (threadIdx.x == 0) xb_words = make_uint4(0u, 0u, 0u, 0u);
    __syncthreads();
    const XcdBarrier xbar = xcd_barrier_post((unsigned*)(pp->ws + WS_BAR), (volatile LAS unsigned*)&xb_words);
    const int s_lo = pp->s_lo;
    for (int s = s_lo; s < s_hi; ++s) {
        PP q = pp; OPAQUE_S(q);
        run_step(q, lds, s);
        if (s + 1 < s_hi) { if (s == s_lo) grid.sync(); else xcd_barrier(xbar); }
    }
}

extern "C" void kernel_launch(void* const* d_in, const int* in_sizes, int n_in, void* d_out, int out_size, void* d_ws, size_t ws_size, hipStream_t stream) {
    static int grid_blocks = 0;
    if (grid_blocks == 0) {
        if (n_in != 18 || out_size != NBATCH * SEQ * DM || ws_size < WS_END) { fprintf(stderr, "kernel_launch: unexpected shapes / workspace (n_in %d out %d ws %zu need %zu)\n", n_in, out_size, ws_size, (size_t)WS_END); grid_blocks = -1; return; }
        int dev = 0, cus = 0, per_cu = 0;
        hipGetDevice(&dev);
        hipDeviceGetAttribute(&cus, hipDeviceAttributeMultiprocessorCount, dev);
        if (hipFuncSetAttribute((const void*)fwd_megakernel, hipFuncAttributeMaxDynamicSharedMemorySize, LDS_BYTES) != hipSuccess) { fprintf(stderr, "kernel_launch: hipFuncSetAttribute failed\n"); grid_blocks = -1; return; }
        hipOccupancyMaxActiveBlocksPerMultiprocessor(&per_cu, (const void*)fwd_megakernel, NTHREADS, LDS_BYTES);
        if (per_cu < 1) { fprintf(stderr, "kernel_launch: occupancy query says %d blocks per CU\n", per_cu); per_cu = 1; }
        (void)hipGetLastError();
        grid_blocks = cus * 1;
    }
    if (grid_blocks < 0) return;
    if (hipMemsetAsync((char*)d_ws + WS_BAR, 0, 16384, stream) != hipSuccess) { fprintf(stderr, "kernel_launch: hipMemsetAsync failed\n"); return; }
    Params p{};
    p.x_prompt = (const float*)d_in[0]; p.x_sample = (const float*)d_in[1]; p.mem_prompt = (const float*)d_in[2]; p.mem_sample = (const float*)d_in[3];
    p.g_mix_pre = (const float*)d_in[4]; p.g_mix_post = (const float*)d_in[5]; p.g_mem = (const float*)d_in[6]; p.w_in = (const float*)d_in[7];
    p.sink_a = (const float*)d_in[8]; p.w_mem_kv = (const float*)d_in[9]; p.w_o_a = (const float*)d_in[10]; p.w_o_b = (const float*)d_in[11];
    p.w_o_c = (const float*)d_in[12]; p.w_out = (const float*)d_in[13]; p.g_ffn_pre = (const float*)d_in[14]; p.g_ffn_post = (const float*)d_in[15];
    p.w_ffn_in = (const float*)d_in[16]; p.w_ffn_out = (const float*)d_in[17];
    p.out = (float*)d_out; p.ws = (unsigned char*)d_ws;
    for (int j = 0; j < 8; ++j) p.inv_freq[j] = powf(500000.0f, -(float)(2 * j) / 16.0f);
#if MK_MULTI_LAUNCH
    for (int s = 0; s < N_STEPS; ++s) {
        p.s_lo = s; p.s_hi = s + 1;
        hipLaunchKernelGGL(fwd_megakernel, dim3(grid_blocks), dim3(NTHREADS), LDS_BYTES, stream, p);
    }
#else
    p.s_lo = 0; p.s_hi = N_STEPS;
    void* args[] = {&p};
    hipError_t e = hipLaunchCooperativeKernel((const void*)fwd_megakernel, dim3(grid_blocks), dim3(NTHREADS), args, LDS_BYTES, stream);
    if (e != hipSuccess) fprintf(stderr, "kernel_launch: cooperative launch failed: %s (grid %d)\n", hipGetErrorString(e), grid_blocks);
#endif
}
```

```cpp
#include <hip/hip_runtime.h>
#include <hip/hip_cooperative_groups.h>
#include <cstdio>
#include <cstdint>
#include <cmath>
namespace cg = cooperative_groups;
#ifndef MK_MULTI_LAUNCH
#define MK_MULTI_LAUNCH 0
#endif
namespace pg8 {
#define PG8_LAS __attribute__((address_space(3)))
typedef unsigned short bf16_t;
typedef short bf16x8 __attribute__((ext_vector_type(8)));
typedef float f32x4 __attribute__((ext_vector_type(4)));
typedef unsigned u32x4 __attribute__((ext_vector_type(4)));
constexpr int BM = 256, BK = 64, HALF = 128, HTB = HALF * BK * 2  , STAGE_BYTES = 8 * HTB, NXCD = 8, WGM = 8;

__host__ __device__ __forceinline__ int lds_byte(int r, int c) { const int st = (r >> 4) * 2 + (c >> 5), rr = r & 15, cc = c & 31, ob = rr * 64 + cc * 2; return st * 1024 + (ob ^ (((ob >> 9) & 1) << 5)); }
__host__ __device__ __forceinline__ void stage_rc(int b, int& R, int& C) { const int st = b / 1024, sb = b % 1024, swz = sb ^ (((sb >> 9) & 1) << 5); R = (st >> 1) * 16 + swz / 64; C = (st & 1) * 32 + (swz % 64) / 2; }
__host__ __device__ __forceinline__ int perm32(int rho) { const int n = rho >> 4, i = rho & 15; return 8 * (i >> 2) + 4 * n + (i & 3); }

struct Unit { int pm, pn; };
struct Gemm { const bf16_t* A; const bf16_t* Bt; int M, N, K; };

struct StaticOrder {
    int nM, nN, nwg, G, c;
    __host__ __device__ void init(int M, int N, int G_, int c_) { nM = M / BM; nN = N / BM; nwg = nM * nN; G = G_; c = c_; }
    __host__ __device__ bool next(int i, Unit& u) const {
        const long L = (long)i * G + c; if (L >= nwg) return false;
        int wgid = (int)L; { const int q = nwg / NXCD, r = nwg % NXCD, xcd = wgid % NXCD, off = wgid / NXCD; wgid = (xcd < r ? xcd * (q + 1) : r * (q + 1) + (xcd - r) * q) + off; }
        const int nig = WGM * nN, gid = wgid / nig, fm = gid * WGM, gsz = (nM - fm) < WGM ? (nM - fm) : WGM;
        u.pm = fm + ((wgid % nig) % gsz); u.pn = (wgid % nig) / gsz; return true;
    }
    __device__ __forceinline__ void a_ready(const Unit&) const {}
    __device__ __forceinline__ void done(const Unit&) const {}
};
__device__ __forceinline__ unsigned cvt_pk_bf16(float lo, float hi) { unsigned r; asm volatile("v_cvt_pk_bf16_f32 %0, %1, %2" : "=v"(r) : "v"(lo), "v"(hi)); return r; }
typedef float f32x2 __attribute__((ext_vector_type(2)));
template <class Epi, class Sched, bool ALIGN_EPI = false, bool SP2 = false>
__device__ __forceinline__ void gemm_phase(PG8_LAS unsigned char* lds, const Gemm g, const Sched& S, const Epi& E) {
    int tid_ = threadIdx.x; asm volatile("" : "+v"(tid_)); const int tid = tid_, wid = __builtin_amdgcn_readfirstlane(tid >> 6), lane = tid & 63, wr = wid >> 2, wc = wid & 3, fr = lane & 15, fq = lane >> 4;
    const int K = g.K, nt = K / BK;
    unsigned voffA[2], voffB[2];
#pragma unroll
    for (int i = 0; i < 2; ++i) { int R, C; stage_rc(tid * 16 + i * 8192, R, C); const int Rb = Epi::PERM ? ((R & ~31) + perm32(R & 31)) : R;
        voffA[i] = (unsigned)(R * K + C) * 2u; voffB[i] = (unsigned)(Rb * K + C) * 2u; }
    const size_t kstep = (size_t)(BK * 2);
    const size_t hstep = (size_t)HALF * K * 2;
    const size_t tstep = 2 * hstep;
    const unsigned ldsw = (unsigned)wid * 1024u;
    const int aoff = lds_byte(wr * 64 + fr, fq * 8), boff = lds_byte(wc * 32 + fr, fq * 8);
#define PG8_SA(b, h) (((b) * 2 + (h)) * HTB)
#define PG8_SB(b, h) ((4 + (b) * 2 + (h)) * HTB)
#define PG8_STAGE(bufoff, gbase, voff) do { _Pragma("unroll") for (int _i = 0; _i < 2; ++_i) \
        __builtin_amdgcn_global_load_lds((const unsigned*)((const char*)(gbase) + (voff)[_i]), (PG8_LAS unsigned*)(lds + (bufoff) + ldsw + _i * 8192), 16, 0, 0); } while (0)
#define PG8_LDA(dst, b, h) do { _Pragma("unroll") for (int m = 0; m < 4; ++m) _Pragma("unroll") for (int k = 0; k < 2; ++k) dst[m][k] = *(const PG8_LAS bf16x8*)(lds + PG8_SA(b, h) + aoff + m * 2048 + k * 1024); } while (0)
#define PG8_LDB(dst, b, h) do { _Pragma("unroll") for (int n = 0; n < 2; ++n) _Pragma("unroll") for (int k = 0; k < 2; ++k) dst[n][k] = *(const PG8_LAS bf16x8*)(lds + PG8_SB(b, h) + boff + n * 2048 + k * 1024); } while (0)
#define PG8_MMA(ai, bj, At, Bt) do { __builtin_amdgcn_s_setprio(1); _Pragma("unroll") for (int m = 0; m < 4; ++m) _Pragma("unroll") for (int n = 0; n < 2; ++n) _Pragma("unroll") for (int k = 0; k < 2; ++k) \
        acc[ai][bj][m][n] = __builtin_amdgcn_mfma_f32_16x16x32_bf16(Bt[n][k], At[m][k], acc[ai][bj][m][n], 0, 0, 0); __builtin_amdgcn_s_setprio(0); } while (0)
#define PG8_WAIT_V(n) asm volatile("s_waitcnt vmcnt(" #n ")" ::: "memory")
#define PG8_WAIT_L(n) asm volatile("s_waitcnt lgkmcnt(" #n ")" ::: "memory")
#define PG8_BAR __builtin_amdgcn_s_barrier()
#define PG8_SCHED __builtin_amdgcn_sched_barrier(0)
    Unit cur, nxt; int ui = 0;
    if (!S.next(0, cur)) return;
    f32x4 acc[2][2][4][2];
#pragma unroll
    for (int a = 0; a < 2; ++a)
#pragma unroll
        for (int b = 0; b < 2; ++b)
#pragma unroll
            for (int m = 0; m < 4; ++m)
#pragma unroll
                for (int n = 0; n < 2; ++n) acc[a][b][m][n] = (f32x4){0.f, 0.f, 0.f, 0.f};
    bf16x8 At[4][2], B0[2][2], B1[2][2];
    const char* cA = (const char*)g.A + (size_t)cur.pm * tstep; const char* cB = (const char*)g.Bt + (size_t)cur.pn * tstep;
    S.a_ready(cur);
    if constexpr (SP2) {
        PG8_STAGE(PG8_SB(0, 0), cB, voffB); PG8_STAGE(PG8_SB(0, 1), cB + hstep, voffB); PG8_STAGE(PG8_SA(0, 0), cA, voffA); PG8_STAGE(PG8_SA(0, 1), cA + hstep, voffA);
        if (wr == 1) PG8_BAR;
        PG8_WAIT_V(2); PG8_BAR;
        PG8_STAGE(PG8_SB(1, 0), cB + kstep, voffB); PG8_STAGE(PG8_SA(1, 0), cA + kstep, voffA); PG8_STAGE(PG8_SB(1, 1), cB + hstep + kstep, voffB);
        PG8_WAIT_V(6); PG8_BAR;
    } else {
        PG8_STAGE(PG8_SB(0, 0), cB, voffB); PG8_STAGE(PG8_SA(0, 0), cA, voffA); PG8_STAGE(PG8_SB(0, 1), cB + hstep, voffB); PG8_STAGE(PG8_SA(0, 1), cA + hstep, voffA);
        if (wr == 1) PG8_BAR;
        PG8_WAIT_V(4); PG8_BAR;
        PG8_STAGE(PG8_SB(1, 0), cB + kstep, voffB); PG8_STAGE(PG8_SA(1, 0), cA + kstep, voffA); PG8_STAGE(PG8_SB(1, 1), cB + hstep + kstep, voffB);
        PG8_WAIT_V(6); PG8_BAR;
    }
    for (;;) {
        const bool has_next = S.next(ui + 1, nxt);
        const char* nA = has_next ? (const char*)g.A + (size_t)nxt.pm * tstep : cA; const char* nB = has_next ? (const char*)g.Bt + (size_t)nxt.pn * tstep : cB;
        for (int t = 0; t < nt; t += 2) {
            const bool last = (t == nt - 2);
            const char* a1 = cA + (size_t)(t + 1) * kstep;
            const char* a2 = last ? nA : cA + (size_t)(t + 2) * kstep; const char* b2 = last ? nB : cB + (size_t)(t + 2) * kstep;
            const char* a3 = a2 + kstep; const char* b3 = b2 + kstep;
            if (last && has_next) S.a_ready(nxt);
            if constexpr (SP2) {
            PG8_LDB(B0, 0, 0); PG8_LDB(B1, 0, 1); PG8_SCHED; PG8_LDA(At, 0, 0); PG8_STAGE(PG8_SA(1, 1), a1 + hstep, voffA);
            PG8_WAIT_V(8); PG8_WAIT_L(0); PG8_BAR; PG8_MMA(0, 0, At, B0); PG8_MMA(0, 1, At, B1); PG8_BAR; PG8_SCHED;
            PG8_LDA(At, 0, 1); PG8_STAGE(PG8_SB(0, 0), b2, voffB); PG8_STAGE(PG8_SB(0, 1), b2 + hstep, voffB); PG8_STAGE(PG8_SA(0, 0), a2, voffA);
            PG8_WAIT_V(8); PG8_WAIT_L(0); PG8_BAR; PG8_MMA(1, 0, At, B0); PG8_MMA(1, 1, At, B1); PG8_BAR; PG8_SCHED;
            PG8_LDB(B0, 1, 0); PG8_LDB(B1, 1, 1); PG8_SCHED; PG8_LDA(At, 1, 0); PG8_STAGE(PG8_SA(0, 1), a2 + hstep, voffA);
            PG8_WAIT_V(8); PG8_WAIT_L(0); PG8_BAR; PG8_MMA(0, 0, At, B0); PG8_MMA(0, 1, At, B1); PG8_BAR; PG8_SCHED;
            PG8_LDA(At, 1, 1); PG8_STAGE(PG8_SB(1, 0), b3, voffB); PG8_STAGE(PG8_SB(1, 1), b3 + hstep, voffB); PG8_STAGE(PG8_SA(1, 0), a3, voffA);
            PG8_WAIT_V(8); PG8_WAIT_L(0); PG8_BAR; PG8_MMA(1, 0, At, B0); PG8_MMA(1, 1, At, B1); PG8_BAR; PG8_SCHED;
            } else {
            PG8_LDB(B0, 0, 0); PG8_SCHED; PG8_LDA(At, 0, 0); PG8_STAGE(PG8_SA(1, 1), a1 + hstep, voffA);
            PG8_WAIT_L(8); PG8_BAR; PG8_WAIT_L(0); PG8_MMA(0, 0, At, B0); PG8_BAR; PG8_SCHED;
            PG8_LDB(B1, 0, 1); PG8_STAGE(PG8_SB(0, 0), b2, voffB);
            PG8_BAR; PG8_WAIT_L(0); PG8_MMA(0, 1, At, B1); PG8_BAR;
            PG8_LDA(At, 0, 1); PG8_STAGE(PG8_SA(0, 0), a2, voffA);
            PG8_BAR; PG8_WAIT_L(0); PG8_MMA(1, 0, At, B0); PG8_BAR; PG8_SCHED;
            PG8_STAGE(PG8_SB(0, 1), b2 + hstep, voffB);
            PG8_WAIT_V(6); PG8_BAR; PG8_MMA(1, 1, At, B1); PG8_BAR;
            PG8_LDB(B0, 1, 0); PG8_SCHED; PG8_LDA(At, 1, 0); PG8_STAGE(PG8_SA(0, 1), a2 + hstep, voffA);
            PG8_WAIT_L(8); PG8_BAR; PG8_WAIT_L(0); PG8_MMA(0, 0, At, B0); PG8_BAR; PG8_SCHED;
            PG8_LDB(B1, 1, 1); PG8_STAGE(PG8_SB(1, 0), b3, voffB);
            PG8_BAR; PG8_WAIT_L(0); PG8_MMA(0, 1, At, B1); PG8_BAR;
            PG8_LDA(At, 1, 1); PG8_STAGE(PG8_SA(1, 0), a3, voffA);
            PG8_BAR; PG8_WAIT_L(0); PG8_MMA(1, 0, At, B0); PG8_BAR; PG8_SCHED;
            PG8_STAGE(PG8_SB(1, 1), b3 + hstep, voffB);
            PG8_WAIT_V(6); PG8_BAR; PG8_MMA(1, 1, At, B1); PG8_BAR;
            }
        }
        if constexpr (ALIGN_EPI) { if (wr == 0) PG8_BAR; }
        if constexpr (!Epi::AFTER_DRAIN) { E(acc, cur, wr, wc, fr, fq); S.done(cur); }
        if (!has_next) break;
#pragma unroll
        for (int a = 0; a < 2; ++a)
#pragma unroll
            for (int b = 0; b < 2; ++b)
#pragma unroll
                for (int m = 0; m < 4; ++m)
#pragma unroll
                    for (int n = 0; n < 2; ++n) acc[a][b][m][n] = (f32x4){0.f, 0.f, 0.f, 0.f};
        cur = nxt; cA = nA; cB = nB; ++ui;
        if constexpr (ALIGN_EPI) { if (wr == 1) PG8_BAR; }
    }
    PG8_WAIT_V(0);
    if constexpr (!ALIGN_EPI) { if (wr == 0) PG8_BAR; }
    PG8_BAR;
    if constexpr (Epi::AFTER_DRAIN) { E.fused(acc, cur, wr, wc, fr, fq, lds, wid, lane); S.done(cur); }
#undef PG8_SA
#undef PG8_SB
#undef PG8_STAGE
#undef PG8_LDA
#undef PG8_LDB
#undef PG8_MMA
#undef PG8_WAIT_V
#undef PG8_WAIT_L
#undef PG8_BAR
#undef PG8_SCHED
}
}

using pg8::bf16_t; using pg8::bf16x8; using pg8::f32x4; using pg8::u32x4;
typedef float f32x16 __attribute__((ext_vector_type(16)));
typedef unsigned u32x2 __attribute__((ext_vector_type(2)));
#define LAS __attribute__((address_space(3)))
constexpr int NTHREADS = 512, NWAVES = 8, LDS_BYTES = pg8::STAGE_BYTES;
constexpr int DM = 1024, SEQ = 2048, NBATCH = 48, DEPTH = 4, NMEM = 256, INW = 6656, FFH = 2816;
constexpr int CB = 16, MC = CB * SEQ, NCHUNK = NBATCH / CB;
constexpr float EPS = 1e-6f, LOG2E = 1.4426950408889634f, LN2 = 0.6931471805599453f;
constexpr size_t WO_IN = 0, WO_MKV = WO_IN + (size_t)INW * DM, WO_OA = WO_MKV + (size_t)1024 * DM, WO_OB = WO_OA + (size_t)1024 * 512, WO_OC = WO_OB + (size_t)1024 * 256,
                 WO_OUT = WO_OC + (size_t)1024 * 512, WO_FIN = WO_OUT + (size_t)1024 * 1024, WO_FOUT = WO_FIN + (size_t)2 * FFH * DM, WL = WO_FOUT + (size_t)DM * FFH;
constexpr size_t al256(size_t x) { return (x + 255) & ~(size_t)255; }
constexpr size_t WS_WT = 0;
constexpr size_t WS_ROPE = al256(WS_WT + WL * DEPTH * 2);
constexpr size_t WS_MEMK = al256(WS_ROPE + (size_t)SEQ * 8 * 8);
constexpr size_t WS_MEMVT = al256(WS_MEMK + (size_t)DEPTH * NBATCH * NMEM * 512 * 2);
constexpr size_t WS_H = al256(WS_MEMVT + (size_t)DEPTH * NBATCH * NMEM * 512 * 2);
constexpr size_t WS_PROJ = al256(WS_H + (size_t)MC * DM * 2);
constexpr size_t WS_VTA = al256(WS_PROJ + (size_t)MC * INW * 2);
constexpr size_t WS_VTB = al256(WS_VTA + (size_t)CB * 2 * 64 * SEQ * 2);
constexpr size_t WS_OA = al256(WS_VTB + (size_t)CB * 12 * 64 * SEQ * 2);
constexpr size_t WS_OB = al256(WS_OA + (size_t)MC * 512 * 2);
constexpr size_t WS_OC = al256(WS_OB + (size_t)MC * 256 * 2);
constexpr size_t WS_MRG = al256(WS_OC + (size_t)MC * 512 * 2);
constexpr size_t WS_KBA = al256(WS_MRG + (size_t)MC * DM * 2);
constexpr size_t WS_KBB = al256(WS_KBA + (size_t)CB * 2 * 64 * SEQ * 2);
constexpr size_t WS_BAR = al256(WS_KBB + (size_t)CB * 12 * 64 * SEQ * 2);
constexpr size_t WS_END = al256(WS_BAR + 16384);
constexpr size_t WS_MEMN = WS_PROJ;
constexpr size_t WS_Y = WS_PROJ;
constexpr size_t WS_ACT = WS_PROJ + (size_t)MC * DM * 4;
constexpr size_t WS_OG = WS_MRG;
constexpr size_t WS_LSE = WS_MRG + (size_t)3 * MC * 256 * 2;
static_assert((size_t)DEPTH * NBATCH * NMEM * DM * 2 <= (size_t)MC * INW * 2, "memn overlay");
static_assert((size_t)MC * DM * 4 + (size_t)MC * FFH * 2 <= (size_t)MC * INW * 2, "y/act overlay");
static_assert((size_t)3 * MC * 256 * 2 + (size_t)3 * MC * 4 * 4 <= (size_t)MC * DM * 2, "og overlay");

struct Params {
    const float *x_prompt, *x_sample, *mem_prompt, *mem_sample, *g_mix_pre, *g_mix_post, *g_mem, *w_in, *sink_a, *w_mem_kv, *w_o_a, *w_o_b, *w_o_c, *w_out,
                *g_ffn_pre, *g_ffn_post, *w_ffn_in, *w_ffn_out;
    float* out; unsigned char* ws;
    float inv_freq[8];
    int s_lo, s_hi;
};

typedef const __attribute__((address_space(4))) Params* PP;
#define OPAQUE_V(x) asm volatile("" : "+v"(x))
#define OPAQUE_S(x) asm volatile("" : "+s"(x))
__device__ __forceinline__ float bf2f(unsigned b) { return __uint_as_float(b << 16); }
typedef __bf16 bf16x2v __attribute__((ext_vector_type(2)));
typedef float f32x2v __attribute__((ext_vector_type(2)));
__device__ __forceinline__ unsigned pk2(float lo, float hi) { const f32x2v v = {lo, hi}; return __builtin_bit_cast(unsigned, __builtin_convertvector(v, bf16x2v)); }
__device__ __forceinline__ float wave_sum(float v) {
#pragma unroll
    for (int o = 32; o > 0; o >>= 1) v += __shfl_xor(v, o);
    return v;
}
__device__ __forceinline__ float fexp2(float x) { return __builtin_amdgcn_exp2f(x); }
__device__ __forceinline__ float frcp(float x) { return __builtin_amdgcn_rcpf(x); }
__device__ __forceinline__ float sigmoidf_(float x) { return frcp(1.f + fexp2(-x * LOG2E)); }
#define LDS_WAIT() asm volatile("s_waitcnt lgkmcnt(0)" ::: "memory")

__device__ __forceinline__ int src_col_in(int n) {
    const bool qk = (n < 640) || (n >= 768 && n < 2304);
    const int p = n & 63;
    return (qk && p < 16) ? (n - p) + (p >> 1) + 8 * (p & 1) : n;
}
__device__ __forceinline__ int src_col_ffin(int n) { const int q = n >> 3, e = n & 7; return e < 4 ? 4 * q + e : FFH + 4 * q + (e - 4); }

template <int PERMT>
__device__ __forceinline__ void transpose_item(const float* W, int K, int N, bf16_t* WT, LAS float* scr, int item, int lane) {
    const int nblk = N / 32, kb = item / nblk, nb = item % nblk, k0 = 64 * kb, n0 = 32 * nb;
    const int nd = n0 + (lane & 31);
    const int ns = PERMT == 1 ? src_col_in(nd) : (PERMT == 2 ? src_col_ffin(nd) : nd);
#pragma unroll 8
    for (int i = 0; i < 32; ++i) { const int kk = 2 * i + (lane >> 5); scr[kk * 33 + (lane & 31)] = __builtin_nontemporal_load(W + (size_t)(k0 + kk) * N + ns); }
    LDS_WAIT();
    const int c = lane & 7;
#pragma unroll
    for (int j = 0; j < 4; ++j) { const int n = (lane >> 3) + 8 * j; const LAS float* s = scr + (8 * c) * 33 + n;
        u32x4 o; o.x = pk2(s[0 * 33], s[1 * 33]); o.y = pk2(s[2 * 33], s[3 * 33]); o.z = pk2(s[4 * 33], s[5 * 33]); o.w = pk2(s[6 * 33], s[7 * 33]);
        *(u32x4*)(WT + (size_t)(n0 + n) * K + k0 + 8 * c) = o; }
    LDS_WAIT();
}

__device__ __forceinline__ void phase_prologue_a(PP p, LAS unsigned char* lds) {
    int tid_ = threadIdx.x; OPAQUE_V(tid_); const int tid = tid_, lane = tid & 63, wave = __builtin_amdgcn_readfirstlane(tid >> 6);
    const int gw = blockIdx.x * NWAVES + wave, NGW = gridDim.x * NWAVES;
    LAS float* scr = (LAS float*)(lds + wave * 16384);
    bf16_t* WT = (bf16_t*)(p->ws + WS_WT);
    constexpr int I_IN = 16 * (INW / 32), I_MKV = 16 * 32, I_OA = 8 * 32, I_OB = 4 * 32, I_OC = 8 * 32, I_OUT = 16 * 32, I_FIN = 16 * (2 * FFH / 32), I_FOUT = (FFH / 64) * 32;
    constexpr int I_L = I_IN + I_MKV + I_OA + I_OB + I_OC + I_OUT + I_FIN + I_FOUT;
    for (int it = gw; it < I_L * DEPTH; it += NGW) {
        const int l = it / I_L; int r = it % I_L;
        bf16_t* wl = WT + (size_t)l * WL;
        if (r < I_IN) { transpose_item<1>(p->w_in + (size_t)l * DM * INW, DM, INW, wl + WO_IN, scr, r, lane); continue; } r -= I_IN;
        if (r < I_MKV) { transpose_item<0>(p->w_mem_kv + (size_t)l * DM * 1024, DM, 1024, wl + WO_MKV, scr, r, lane); continue; } r -= I_MKV;
        if (r < I_OA) { transpose_item<0>(p->w_o_a + (size_t)l * 512 * DM, 512, DM, wl + WO_OA, scr, r, lane); continue; } r -= I_OA;
        if (r < I_OB) { transpose_item<0>(p->w_o_b + (size_t)l * 256 * DM, 256, DM, wl + WO_OB, scr, r, lane); continue; } r -= I_OB;
        if (r < I_OC) { transpose_item<0>(p->w_o_c + (size_t)l * 512 * DM, 512, DM, wl + WO_OC, scr, r, lane); continue; } r -= I_OC;
        if (r < I_OUT) { transpose_item<0>(p->w_out + (size_t)l * DM * DM, DM, DM, wl + WO_OUT, scr, r, lane); continue; } r -= I_OUT;
        if (r < I_FIN) { transpose_item<2>(p->w_ffn_in + (size_t)l * DM * 2 * FFH, DM, 2 * FFH, wl + WO_FIN, scr, r, lane); continue; } r -= I_FIN;
        transpose_item<0>(p->w_ffn_out + (size_t)l * FFH * DM, FFH, DM, wl + WO_FOUT, scr, r, lane);
    }
    float2* rope = (float2*)(p->ws + WS_ROPE);
    for (int i = blockIdx.x * NTHREADS + tid; i < SEQ * 8; i += gridDim.x * NTHREADS) {
        const int pos = i >> 3, j = i & 7;
        const float ang = (float)pos * p->inv_freq[j];
        const double rev = (double)ang * 0.15915494309189535;
        const float fr = (float)(rev - rint(rev));
        rope[i] = make_float2(__builtin_amdgcn_cosf(fr), __builtin_amdgcn_sinf(fr));
    }
    bf16_t* memn = (bf16_t*)(p->ws + WS_MEMN);
    for (int R = gw; R < NBATCH * NMEM; R += NGW) {
        const float* src = (R < 16 * NMEM) ? p->mem_prompt + (size_t)R * DM : p->mem_sample + (size_t)(R - 16 * NMEM) * DM;
        f32x4 v[4]; float ss = 0.f;
#pragma unroll
        for (int j = 0; j < 4; ++j) { v[j] = *(const f32x4*)(src + 4 * (lane + 64 * j)); ss += v[j].x * v[j].x + v[j].y * v[j].y + v[j].z * v[j].z + v[j].w * v[j].w; }
        const float rstd = 1.f / sqrtf(wave_sum(ss) * (1.f / DM) + EPS);
#pragma unroll
        for (int l = 0; l < DEPTH; ++l)
#pragma unroll
            for (int j = 0; j < 4; ++j) { const f32x4 g = *(const f32x4*)(p->g_mem + l * DM + 4 * (lane + 64 * j));
                u32x2 o; o.x = pk2(v[j].x * rstd * g.x, v[j].y * rstd * g.y); o.y = pk2(v[j].z * rstd * g.z, v[j].w * rstd * g.w);
                *(u32x2*)(memn + ((size_t)l * NBATCH * NMEM + R) * DM + 4 * (lane + 64 * j)) = o; }
    }
}

__device__ __forceinline__ const float* x_in_row(PP p, int GR) { return GR < 16 * SEQ ? p->x_prompt + (size_t)GR * DM : p->x_sample + (size_t)(GR - 16 * SEQ) * DM; }

__device__ __forceinline__ void phase_rows_first(PP p, int chunk) {
    int tid_ = threadIdx.x; OPAQUE_V(tid_); const int lane = tid_ & 63, wave = __builtin_amdgcn_readfirstlane(tid_ >> 6);
    bf16_t* H = (bf16_t*)(p->ws + WS_H);
    for (int r = blockIdx.x * NWAVES + wave; r < MC; r += gridDim.x * NWAVES) {
        const float* src = x_in_row(p, chunk * MC + r);
        f32x4 v[4]; float ss = 0.f;
#pragma unroll
        for (int j = 0; j < 4; ++j) { v[j] = *(const f32x4*)(src + 4 * (lane + 64 * j)); ss += v[j].x * v[j].x + v[j].y * v[j].y + v[j].z * v[j].z + v[j].w * v[j].w; }
        const float rstd = 1.f / sqrtf(wave_sum(ss) * (1.f / DM) + EPS);
#pragma unroll
        for (int j = 0; j < 4; ++j) { const f32x4 g = *(const f32x4*)(p->g_mix_pre + 4 * (lane + 64 * j));
            u32x2 o; o.x = pk2(v[j].x * rstd * g.x, v[j].y * rstd * g.y); o.y = pk2(v[j].z * rstd * g.z, v[j].w * rstd * g.w);
            *(u32x2*)(H + (size_t)r * DM + 4 * (lane + 64 * j)) = o; }
    }
}
struct RowBuf { f32x4 x[4]; u32x2 y[4]; };
__device__ __forceinline__ void row_load(RowBuf& b, const bf16_t* yrow, const float* xrow, int lane) {
#pragma unroll
    for (int j = 0; j < 4; ++j) { b.y[j] = __builtin_nontemporal_load((const u32x2*)(yrow + 4 * (lane + 64 * j))); b.x[j] = __builtin_nontemporal_load((const f32x4*)(xrow + 4 * (lane + 64 * j))); }
}
__device__ __forceinline__ void row_process(RowBuf& b, float* dst, bf16_t* hrow, const float* g_post, const float* g_next, bool write_h, int lane) {
    f32x4 y[4]; float ss = 0.f;
#pragma unroll
    for (int j = 0; j < 4; ++j) { y[j].x = bf2f(b.y[j].x & 0xffffu); y[j].y = bf2f(b.y[j].x >> 16); y[j].z = bf2f(b.y[j].y & 0xffffu); y[j].w = bf2f(b.y[j].y >> 16);
        ss += y[j].x * y[j].x + y[j].y * y[j].y + y[j].z * y[j].z + y[j].w * y[j].w; }
    const float ry = 1.f / sqrtf(wave_sum(ss) * (1.f / DM) + EPS);
    float sx = 0.f;
#pragma unroll
    for (int j = 0; j < 4; ++j) { const f32x4 g = *(const f32x4*)(g_post + 4 * (lane + 64 * j)); f32x4 x = b.x[j];
        x.x += y[j].x * ry * g.x; x.y += y[j].y * ry * g.y; x.z += y[j].z * ry * g.z; x.w += y[j].w * ry * g.w;
        __builtin_nontemporal_store(x, (f32x4*)(dst + 4 * (lane + 64 * j))); b.x[j] = x;
        sx += x.x * x.x + x.y * x.y + x.z * x.z + x.w * x.w; }
    if (write_h) {
        const float rx = 1.f / sqrtf(wave_sum(sx) * (1.f / DM) + EPS);
#pragma unroll
        for (int j = 0; j < 4; ++j) { const f32x4 g = *(const f32x4*)(g_next + 4 * (lane + 64 * j)); const f32x4 x = b.x[j];
            u32x2 o; o.x = pk2(x.x * rx * g.x, x.y * rx * g.y); o.y = pk2(x.z * rx * g.z, x.w * rx * g.w);
            *(u32x2*)(hrow + 4 * (lane + 64 * j)) = o; }
    }
}
__device__ __forceinline__ void phase_rows_resid(PP p, int chunk, bool src_is_input, const float* g_post, const float* g_next, bool write_h) {
    int tid_ = threadIdx.x; OPAQUE_V(tid_); const int lane = tid_ & 63, wave = __builtin_amdgcn_readfirstlane(tid_ >> 6);
    bf16_t* H = (bf16_t*)(p->ws + WS_H);
    const bf16_t* Y = (const bf16_t*)(p->ws + WS_Y);
    float* out = p->out;
    const int stride = gridDim.x * NWAVES;
    int r = blockIdx.x * NWAVES + wave;
    if (r >= MC) return;
    RowBuf A, B;
#define ROW_SRC(rr) (src_is_input ? x_in_row(p, chunk * MC + (rr)) : out + (size_t)(chunk * MC + (rr)) * DM)
    row_load(A, Y + (size_t)r * DM, ROW_SRC(r), lane);
    for (;;) {
        const int r1 = r + stride;
        if (r1 < MC) row_load(B, Y + (size_t)r1 * DM, ROW_SRC(r1), lane);
        row_process(A, out + (size_t)(chunk * MC + r) * DM, H + (size_t)r * DM, g_post, g_next, write_h, lane);
        if (r1 >= MC) break;
        const int r2 = r1 + stride;
        if (r2 < MC) row_load(A, Y + (size_t)r2 * DM, ROW_SRC(r2), lane);
        row_process(B, out + (size_t)(chunk * MC + r1) * DM, H + (size_t)r1 * DM, g_post, g_next, write_h, lane);
        if (r2 >= MC) break;
        r = r2;
    }
#undef ROW_SRC
}

__device__ __forceinline__ int pi32(int r) { return (r & 0x13) | ((r & 4) << 1) | ((r & 8) >> 1); }
template <int D> __device__ __forceinline__ size_t kblk_off(int p, int c8) { const int kt = p >> 5, r = pi32(p & 31); return ((size_t)(kt * (D / 16) + (c8 >> 1)) * 64 + (c8 & 1) * 32 + r) * 8; }
template <int D> __device__ __forceinline__ size_t vblk_off(int p, int d) { const int kt = p >> 5, w = p & 31; return ((((size_t)kt * (D / 32) + (d >> 5)) * 2 + (w >> 4)) * 64 + ((w >> 3) & 1) * 32 + (d & 31)) * 8 + (w & 7); }
template <int D> __device__ __forceinline__ void store8_vblk(bf16_t* img, int p, int d0, const f32x4& a, const f32x4& b) {
    const unsigned o0 = pk2(a.x, a.y), o1 = pk2(a.z, a.w), o2 = pk2(b.x, b.y), o3 = pk2(b.z, b.w);
    bf16_t* base = img + vblk_off<D>(p, d0);
    base[0] = (bf16_t)(o0 & 0xffffu); base[8] = (bf16_t)(o0 >> 16); base[16] = (bf16_t)(o1 & 0xffffu); base[24] = (bf16_t)(o1 >> 16);
    base[32] = (bf16_t)(o2 & 0xffffu); base[40] = (bf16_t)(o2 >> 16); base[48] = (bf16_t)(o3 & 0xffffu); base[56] = (bf16_t)(o3 >> 16);
}
__device__ __forceinline__ u32x4 pack8(const f32x4& a, const f32x4& b) { u32x4 o; o.x = pk2(a.x, a.y); o.y = pk2(a.z, a.w); o.z = pk2(b.x, b.y); o.w = pk2(b.z, b.w); return o; }
__device__ __forceinline__ void store8_strided(bf16_t* base, size_t stride, const f32x4& a, const f32x4& b) {
    const u32x4 o = pack8(a, b);
    base[0 * stride] = (bf16_t)(o.x & 0xffffu); base[1 * stride] = (bf16_t)(o.x >> 16); base[2 * stride] = (bf16_t)(o.y & 0xffffu); base[3 * stride] = (bf16_t)(o.y >> 16);
    base[4 * stride] = (bf16_t)(o.z & 0xffffu); base[5 * stride] = (bf16_t)(o.z >> 16); base[6 * stride] = (bf16_t)(o.w & 0xffffu); base[7 * stride] = (bf16_t)(o.w >> 16);
}
struct EpiIn {
    static constexpr bool PERM = true, AFTER_DRAIN = false;
    bf16_t* proj; bf16_t* vta; bf16_t* vtb; bf16_t* kba; bf16_t* kbb; const float* rope;
    __device__ __forceinline__ void operator()(const f32x4 (&acc)[2][2][4][2], const pg8::Unit& u, int wr, int wc, int fr, int fq) const {
        const int row0 = u.pm * 256 + wr * 64 + fr;
#pragma unroll
        for (int bj = 0; bj < 2; ++bj) {
            const int c128 = u.pn * 256 + bj * 128, cb = c128 + wc * 32 + 8 * fq;
            if (c128 >= 3584) {
#pragma unroll
                for (int ai = 0; ai < 2; ++ai)
#pragma unroll
                    for (int m = 0; m < 4; ++m) { const int row = row0 + ai * 128 + m * 16; f32x4 a = acc[ai][bj][m][0], b = acc[ai][bj][m][1];
                        a.x = sigmoidf_(a.x); a.y = sigmoidf_(a.y); a.z = sigmoidf_(a.z); a.w = sigmoidf_(a.w); b.x = sigmoidf_(b.x); b.y = sigmoidf_(b.y); b.z = sigmoidf_(b.z); b.w = sigmoidf_(b.w);
                        __builtin_nontemporal_store(pack8(a, b), (u32x4*)(proj + (size_t)row * INW + cb)); }
            } else if (c128 >= 3072) {
#pragma unroll
                for (int ai = 0; ai < 2; ++ai)
#pragma unroll
                    for (int m = 0; m < 4; ++m) { const int row = row0 + ai * 128 + m * 16; __builtin_nontemporal_store(pack8(acc[ai][bj][m][0], acc[ai][bj][m][1]), (u32x4*)(proj + (size_t)row * INW + cb)); }
            } else if (c128 == 640) {
                const int kvh = (cb - 640) >> 6, d0 = (cb - 640) & 63;
#pragma unroll
                for (int ai = 0; ai < 2; ++ai)
#pragma unroll
                    for (int m = 0; m < 4; ++m) { const int row = row0 + ai * 128 + m * 16, bl = row >> 11, pos = row & 2047;
                        store8_vblk<64>(vta + (size_t)(bl * 2 + kvh) * 64 * SEQ, pos, d0, acc[ai][bj][m][0], acc[ai][bj][m][1]); }
            } else if (c128 >= 2304) {
                const int hb = (cb - 2304) >> 6, d0 = (cb - 2304) & 63, sh = 2 * (hb >> 2);
#pragma unroll
                for (int ai = 0; ai < 2; ++ai)
#pragma unroll
                    for (int m = 0; m < 4; ++m) { const int row = row0 + ai * 128 + m * 16, bl = row >> 11, pos = row & 2047;
                        const int pg = (pos & ((1 << sh) - 1)) * (SEQ >> sh) + (pos >> sh);
                        store8_vblk<64>(vtb + (size_t)(bl * 12 + hb) * 64 * SEQ, pg, d0, acc[ai][bj][m][0], acc[ai][bj][m][1]); }
            } else {
                const bool rp = ((wc & 1) == 0) && (fq < 2);
#pragma unroll
                for (int ai = 0; ai < 2; ++ai)
#pragma unroll
                    for (int m = 0; m < 4; ++m) { const int row = row0 + ai * 128 + m * 16; f32x4 a = acc[ai][bj][m][0], b = acc[ai][bj][m][1];
                        if (rp) { const int pos = row & 2047; const f32x4* t = (const f32x4*)(rope + (size_t)pos * 16 + 8 * fq); const f32x4 t0 = t[0], t1 = t[1];
                            f32x4 a2, b2;
                            a2.x = a.x * t0.x - a.y * t0.y; a2.y = a.y * t0.x + a.x * t0.y; a2.z = a.z * t0.z - a.w * t0.w; a2.w = a.w * t0.z + a.z * t0.w;
                            b2.x = b.x * t1.x - b.y * t1.y; b2.y = b.y * t1.x + b.x * t1.y; b2.z = b.z * t1.z - b.w * t1.w; b2.w = b.w * t1.z + b.z * t1.w;
                            a = a2; b = b2; }
                        if (c128 == 512) {
                            const int bl = row >> 11, pos = row & 2047, kvh = (cb - 512) >> 6, c8 = ((cb - 512) & 63) >> 3;
                            *(u32x4*)(kba + (size_t)(bl * 2 + kvh) * 64 * SEQ + kblk_off<64>(pos, c8)) = pack8(a, b);
                        } else if (c128 >= 1536) {
                            const int bl = row >> 11, pos = row & 2047, hb = (cb - 1536) >> 6, c8 = ((cb - 1536) & 63) >> 3, sh = 2 * (hb >> 2);
                            const int pg = (pos & ((1 << sh) - 1)) * (SEQ >> sh) + (pos >> sh);
                            *(u32x4*)(kbb + (size_t)(bl * 12 + hb) * 64 * SEQ + kblk_off<64>(pg, c8)) = pack8(a, b);
                        } else __builtin_nontemporal_store(pack8(a, b), (u32x4*)(proj + (size_t)row * INW + cb)); }
            }
        }
    }
};
struct EpiMemKV {
    static constexpr bool PERM = true, AFTER_DRAIN = false;
    bf16_t* mk; bf16_t* mvt;
    __device__ __forceinline__ void operator()(const f32x4 (&acc)[2][2][4][2], const pg8::Unit& u, int wr, int wc, int fr, int fq) const {
        const int row0 = u.pm * 256 + wr * 64 + fr;
#pragma unroll
        for (int bj = 0; bj < 2; ++bj) {
            const int c128 = u.pn * 256 + bj * 128, cb = c128 + wc * 32 + 8 * fq;
            if (c128 < 512) {
#pragma unroll
                for (int ai = 0; ai < 2; ++ai)
#pragma unroll
                    for (int m = 0; m < 4; ++m) { const int row = row0 + ai * 128 + m * 16, b = row >> 8, j = row & 255, hc = cb >> 7, c8 = (cb & 127) >> 3;
                        *(u32x4*)(mk + (size_t)(b * 4 + hc) * 128 * NMEM + kblk_off<128>(j, c8)) = pack8(acc[ai][bj][m][0], acc[ai][bj][m][1]); }
            } else {
                const int hc = (cb - 512) >> 7, d0 = (cb - 512) & 127;
#pragma unroll
                for (int ai = 0; ai < 2; ++ai)
#pragma unroll
                    for (int m = 0; m < 4; ++m) { const int row = row0 + ai * 128 + m * 16, b = row >> 8, j = row & 255;
                        store8_vblk<128>(mvt + (size_t)(b * 4 + hc) * 128 * NMEM, j, d0, acc[ai][bj][m][0], acc[ai][bj][m][1]); }
            }
        }
    }
};
struct EpiGate {
    static constexpr bool PERM = true, AFTER_DRAIN = false;
    const bf16_t* gate; bf16_t* mrg; int accum;
    __device__ __forceinline__ void operator()(const f32x4 (&acc)[2][2][4][2], const pg8::Unit& u, int wr, int wc, int fr, int fq) const {
        const int row0 = u.pm * 256 + wr * 64 + fr, cb0 = u.pn * 256 + wc * 32 + 8 * fq;
#pragma unroll
        for (int ai = 0; ai < 2; ++ai) {
            u32x4 g[4][2], o[4][2];
#pragma unroll
            for (int m = 0; m < 4; ++m)
#pragma unroll
                for (int bj = 0; bj < 2; ++bj) g[m][bj] = __builtin_nontemporal_load((const u32x4*)(gate + (size_t)(row0 + ai * 128 + m * 16) * INW + cb0 + bj * 128));
            if (accum) {
#pragma unroll
                for (int m = 0; m < 4; ++m)
#pragma unroll
                    for (int bj = 0; bj < 2; ++bj) o[m][bj] = *(const u32x4*)(mrg + (size_t)(row0 + ai * 128 + m * 16) * DM + cb0 + bj * 128);
            }
#pragma unroll
            for (int m = 0; m < 4; ++m)
#pragma unroll
                for (int bj = 0; bj < 2; ++bj) {
                    const u32x4 gg = g[m][bj];
                    f32x4 a = acc[ai][bj][m][0], b = acc[ai][bj][m][1];
                    a.x *= bf2f(gg.x & 0xffffu); a.y *= bf2f(gg.x >> 16); a.z *= bf2f(gg.y & 0xffffu); a.w *= bf2f(gg.y >> 16);
                    b.x *= bf2f(gg.z & 0xffffu); b.y *= bf2f(gg.z >> 16); b.z *= bf2f(gg.w & 0xffffu); b.w *= bf2f(gg.w >> 16);
                    if (accum) { const u32x4 oo = o[m][bj];
                        a.x += bf2f(oo.x & 0xffffu); a.y += bf2f(oo.x >> 16); a.z += bf2f(oo.y & 0xffffu); a.w += bf2f(oo.y >> 16);
                        b.x += bf2f(oo.z & 0xffffu); b.y += bf2f(oo.z >> 16); b.z += bf2f(oo.w & 0xffffu); b.w += bf2f(oo.w >> 16); }
                    *(u32x4*)(mrg + (size_t)(row0 + ai * 128 + m * 16) * DM + cb0 + bj * 128) = pack8(a, b);
                }
        }
    }
};
struct EpiY {
    static constexpr bool PERM = true, AFTER_DRAIN = false;
    bf16_t* Y;
    __device__ __forceinline__ void operator()(const f32x4 (&acc)[2][2][4][2], const pg8::Unit& u, int wr, int wc, int fr, int fq) const {
        const int row0 = u.pm * 256 + wr * 64 + fr;
#pragma unroll
        for (int ai = 0; ai < 2; ++ai)
#pragma unroll
            for (int m = 0; m < 4; ++m)
#pragma unroll
                for (int bj = 0; bj < 2; ++bj)
                    *(u32x4*)(Y + (size_t)(row0 + ai * 128 + m * 16) * DM + u.pn * 256 + bj * 128 + wc * 32 + 8 * fq) = pack8(acc[ai][bj][m][0], acc[ai][bj][m][1]);
    }
};
struct EpiSwiGLU {
    static constexpr bool PERM = true, AFTER_DRAIN = false;
    bf16_t* act;
    __device__ __forceinline__ void operator()(const f32x4 (&acc)[2][2][4][2], const pg8::Unit& u, int wr, int wc, int fr, int fq) const {
        const int row0 = u.pm * 256 + wr * 64 + fr;
#pragma unroll
        for (int ai = 0; ai < 2; ++ai)
#pragma unroll
            for (int m = 0; m < 4; ++m)
#pragma unroll
                for (int bj = 0; bj < 2; ++bj) { const int cb = u.pn * 256 + bj * 128 + wc * 32 + 8 * fq; const f32x4 g = acc[ai][bj][m][0], v = acc[ai][bj][m][1];
                    u32x2 o; o.x = pk2(g.x * sigmoidf_(g.x) * v.x, g.y * sigmoidf_(g.y) * v.y); o.y = pk2(g.z * sigmoidf_(g.z) * v.z, g.w * sigmoidf_(g.w) * v.w);
                    *(u32x2*)(act + (size_t)(row0 + ai * 128 + m * 16) * FFH + (cb >> 1)) = o; }
    }
};
#ifndef GATE_FAST
#define GATE_FAST true
#endif
template <class Epi, bool FAST = true>
__device__ __forceinline__ void run_gemm(LAS unsigned char* lds, const bf16_t* A, const bf16_t* Bt, int M, int N, int K, const Epi& E, int crot) {
    pg8::Gemm g; g.A = A; g.Bt = Bt; g.M = M; g.N = N; g.K = K;
    pg8::StaticOrder S; S.init(M, N, (int)gridDim.x, (int)((blockIdx.x + crot) % gridDim.x));
    pg8::gemm_phase<Epi, pg8::StaticOrder, FAST, FAST>(lds, g, S, E);
}

struct AttnTask {
    const bf16_t* q; long qstride;
    const bf16_t* kb; const bf16_t* vb;
    bf16_t* o; long ostride;
    float* lse; long lsestride;
    int m0, L, W;
    float m_init, l_init, scale2;
};
template <int D>
__device__ __forceinline__ void attn_load_k(bf16x8 (&kf)[D / 16], const AttnTask& t, int k0, int lane) {
    const bf16_t* kp = t.kb + ((size_t)(k0 >> 5) * (D / 16) * 64 + lane) * 8;
#pragma unroll
    for (int kk = 0; kk < D / 16; ++kk) kf[kk] = *(const bf16x8*)(kp + kk * 512);
}
template <int D>
__device__ __forceinline__ void attn_load_v(bf16x8 (&vf)[D / 32][2], const AttnTask& t, int k0, int lane) {
    const bf16_t* vp = t.vb + ((size_t)(k0 >> 5) * (D / 32) * 128 + lane) * 8;
#pragma unroll
    for (int db = 0; db < D / 32; ++db)
#pragma unroll
        for (int s = 0; s < 2; ++s) vf[db][s] = *(const bf16x8*)(vp + (db * 2 + s) * 512);
}
__device__ __forceinline__ float xhalf_max(float v) { const auto r = __builtin_amdgcn_permlane32_swap(__float_as_uint(v), __float_as_uint(v), false, false); return fmaxf(__uint_as_float(r[0]), __uint_as_float(r[1])); }
__device__ __forceinline__ float xhalf_sum(float v) { const auto r = __builtin_amdgcn_permlane32_swap(__float_as_uint(v), __float_as_uint(v), false, false); return __uint_as_float(r[0]) + __uint_as_float(r[1]); }
template <int D, bool MASK>
__device__ __forceinline__ void attn_tile(const bf16x8 (&qf)[D / 16], const bf16x8 (&kf)[D / 16], const bf16x8 (&vf)[D / 32][2], f32x16 (&o)[D / 32], float& mrun, float& lrun,
                                          const AttnTask& t, int k0, int mq, int qi, int h) {
    f32x16 sc;
#pragma unroll
    for (int i = 0; i < 16; ++i) sc[i] = 0.f;
#pragma unroll
    for (int kk = 0; kk < D / 16; ++kk) sc = __builtin_amdgcn_mfma_f32_32x32x16_bf16(kf[kk], qf[kk], sc, 0, 0, 0);
    if (MASK) {
        if (k0 == mq - t.W || k0 == mq + t.W) {
#pragma unroll
            for (int i = 0; i < 16; ++i) { const int dlt = k0 + 16 * (i >> 3) + 8 * h + (i & 7) - qi; sc[i] = (dlt <= t.W && dlt >= -t.W) ? sc[i] : -1e30f; }
        }
    }
    float mt = sc[0];
#pragma unroll
    for (int i = 1; i < 16; ++i) mt = fmaxf(mt, sc[i]);
    mt = xhalf_max(mt) * t.scale2;
    const float mn = fmaxf(mrun, mt), alpha = fexp2(mrun - mn);
    float ps = 0.f;
#pragma unroll
    for (int i = 0; i < 16; ++i) { sc[i] = fexp2(__builtin_fmaf(sc[i], t.scale2, -mn)); ps += sc[i]; }
    ps = xhalf_sum(ps);
    lrun = lrun * alpha + ps; mrun = mn;
#pragma unroll
    for (int db = 0; db < D / 32; ++db)
#pragma unroll
        for (int i = 0; i < 16; ++i) o[db][i] *= alpha;
    bf16x8 pf[2];
#pragma unroll
    for (int s = 0; s < 2; ++s) { u32x4 w; w.x = pk2(sc[8 * s + 0], sc[8 * s + 1]); w.y = pk2(sc[8 * s + 2], sc[8 * s + 3]); w.z = pk2(sc[8 * s + 4], sc[8 * s + 5]); w.w = pk2(sc[8 * s + 6], sc[8 * s + 7]);
        pf[s] = __builtin_bit_cast(bf16x8, w); }
#pragma unroll
    for (int db = 0; db < D / 32; ++db)
#pragma unroll
        for (int s = 0; s < 2; ++s) o[db] = __builtin_amdgcn_mfma_f32_32x32x16_bf16(vf[db][s], pf[s], o[db], 0, 0, 0);
}
template <int D, bool MASK, bool PFV, int NQ>
__device__ __forceinline__ void attn_wave(const AttnTask& t, int lane) {
    const int r = lane & 31, h = lane >> 5;
    bf16x8 qf[NQ][D / 16];
#pragma unroll
    for (int q = 0; q < NQ; ++q) { const bf16_t* qp = t.q + (long)(t.m0 + 32 * q + r) * t.qstride + 8 * h;
#pragma unroll
        for (int kk = 0; kk < D / 16; ++kk) qf[q][kk] = *(const bf16x8*)(qp + 16 * kk); }
    f32x16 o[NQ][D / 32];
    float mrun[NQ], lrun[NQ];
#pragma unroll
    for (int q = 0; q < NQ; ++q) { mrun[q] = t.m_init; lrun[q] = t.l_init;
#pragma unroll
        for (int db = 0; db < D / 32; ++db)
#pragma unroll
            for (int i = 0; i < 16; ++i) o[q][db][i] = 0.f; }
    int klo = 0, khi = t.L;
    if (MASK) { klo = t.m0 - t.W; if (klo < 0) klo = 0; khi = t.m0 + 32 * NQ + t.W; if (khi > t.L) khi = t.L; }
    bf16x8 ka[D / 16], kb[D / 16], va[D / 32][2], vb[D / 32][2];
    attn_load_k<D>(ka, t, klo, lane);
    attn_load_v<D>(va, t, klo, lane);
#define ATT_TILES(KF, VF, K0) do { _Pragma("unroll") for (int q = 0; q < NQ; ++q) { const int mq = t.m0 + 32 * q; \
        if (!MASK || NQ == 1 || ((K0) >= mq - t.W && (K0) <= mq + t.W)) attn_tile<D, MASK>(qf[q], KF, VF, o[q], mrun[q], lrun[q], t, (K0), mq, mq + r, h); } } while (0)
    for (int k0 = klo; k0 < khi; k0 += 64) {
        const int k1 = k0 + 32, k2 = (k0 + 64 < khi) ? k0 + 64 : klo;
        const bool has1 = k1 < khi;
        attn_load_k<D>(kb, t, has1 ? k1 : klo, lane);
        if (PFV) attn_load_v<D>(vb, t, has1 ? k1 : klo, lane);
        __builtin_amdgcn_sched_barrier(0);
        ATT_TILES(ka, va, k0);
        __builtin_amdgcn_sched_barrier(0);
        if (!has1) break;
        if (!PFV) attn_load_v<D>(vb, t, k1, lane);
        attn_load_k<D>(ka, t, k2, lane);
        if (PFV) attn_load_v<D>(va, t, k2, lane);
        __builtin_amdgcn_sched_barrier(0);
        ATT_TILES(kb, vb, k1);
        __builtin_amdgcn_sched_barrier(0);
        if (!PFV) attn_load_v<D>(va, t, k2, lane);
    }
#undef ATT_TILES
#pragma unroll
    for (int q = 0; q < NQ; ++q) {
        const int qi = t.m0 + 32 * q + r;
        const float inv = 1.f / lrun[q];
        bf16_t* op = t.o + (long)qi * t.ostride + 4 * h;
#pragma unroll
        for (int db = 0; db < D / 32; ++db)
#pragma unroll
            for (int g = 0; g < 4; ++g) { u32x2 w; w.x = pk2(o[q][db][4 * g + 0] * inv, o[q][db][4 * g + 1] * inv); w.y = pk2(o[q][db][4 * g + 2] * inv, o[q][db][4 * g + 3] * inv);
                *(u32x2*)(op + 32 * db + 8 * g) = w; }
        if (t.lse != nullptr && h == 0) t.lse[(long)qi * t.lsestride] = (mrun[q] + __builtin_amdgcn_logf(lrun[q])) * LN2;
    }
}

__device__ __forceinline__ void attn_wave_mem_lds(const AttnTask& t, LAS unsigned char* lds, int lane) {
    constexpr int D = 128;
    const int r = lane & 31, h = lane >> 5;
    bf16x8 qf[D / 16];
    const bf16_t* qp = t.q + (long)(t.m0 + r) * t.qstride + 8 * h;
#pragma unroll
    for (int kk = 0; kk < D / 16; ++kk) qf[kk] = *(const bf16x8*)(qp + 16 * kk);
    f32x16 o[D / 32];
#pragma unroll
    for (int db = 0; db < D / 32; ++db)
#pragma unroll
        for (int i = 0; i < 16; ++i) o[db][i] = 0.f;
    float mrun = t.m_init, lrun = t.l_init;
    const int qi = t.m0 + r;
    for (int kt = 0; kt < NMEM / 32; ++kt) {
        bf16x8 kf[D / 16], vf[D / 32][2];
#pragma unroll
        for (int kk = 0; kk < D / 16; ++kk) kf[kk] = *(const LAS bf16x8*)(lds + ((kt * (D / 16) + kk) * 64 + lane) * 16);
#pragma unroll
        for (int db = 0; db < D / 32; ++db)
#pragma unroll
            for (int s = 0; s < 2; ++s) vf[db][s] = *(const LAS bf16x8*)(lds + 65536 + (((kt * (D / 32) + db) * 2 + s) * 64 + lane) * 16);
        attn_tile<D, false>(qf, kf, vf, o, mrun, lrun, t, kt * 32, t.m0, qi, h);
    }
    const float inv = 1.f / lrun;
    bf16_t* op = t.o + (long)qi * t.ostride + 4 * h;
#pragma unroll
    for (int db = 0; db < D / 32; ++db)
#pragma unroll
        for (int g = 0; g < 4; ++g) { u32x2 w; w.x = pk2(o[db][4 * g + 0] * inv, o[db][4 * g + 1] * inv); w.y = pk2(o[db][4 * g + 2] * inv, o[db][4 * g + 3] * inv);
            *(u32x2*)(op + 32 * db + 8 * g) = w; }
}

__device__ __forceinline__ void attn_wave_win_lds(const AttnTask& t, LAS unsigned char* lds, int kt0, int lane) {
    constexpr int D = 64;
    const int r = lane & 31, h = lane >> 5;
    bf16x8 qf[D / 16];
    const bf16_t* qp = t.q + (long)(t.m0 + r) * t.qstride + 8 * h;
#pragma unroll
    for (int kk = 0; kk < D / 16; ++kk) qf[kk] = *(const bf16x8*)(qp + 16 * kk);
    f32x16 o[D / 32];
#pragma unroll
    for (int db = 0; db < D / 32; ++db)
#pragma unroll
        for (int i = 0; i < 16; ++i) o[db][i] = 0.f;
    float mrun = t.m_init, lrun = t.l_init;
    const int qi = t.m0 + r;
    int kta = (t.m0 - t.W) >> 5, ktb = (t.m0 + t.W) >> 5;
    if (kta < 0) kta = 0;
    if (ktb > t.L / 32 - 1) ktb = t.L / 32 - 1;
    for (int kt = kta; kt <= ktb; ++kt) {
        const int slot = kt - kt0;
        bf16x8 kf[D / 16], vf[D / 32][2];
#pragma unroll
        for (int kk = 0; kk < D / 16; ++kk) kf[kk] = *(const LAS bf16x8*)(lds + ((slot * (D / 16) + kk) * 64 + lane) * 16);
#pragma unroll
        for (int db = 0; db < D / 32; ++db)
#pragma unroll
            for (int s = 0; s < 2; ++s) vf[db][s] = *(const LAS bf16x8*)(lds + 65536 + (((slot * (D / 32) + db) * 2 + s) * 64 + lane) * 16);
        attn_tile<D, true>(qf, kf, vf, o, mrun, lrun, t, kt * 32, t.m0, qi, h);
    }
    const float inv = 1.f / lrun;
    bf16_t* op = t.o + (long)qi * t.ostride + 4 * h;
#pragma unroll
    for (int db = 0; db < D / 32; ++db)
#pragma unroll
        for (int g = 0; g < 4; ++g) { u32x2 w; w.x = pk2(o[db][4 * g + 0] * inv, o[db][4 * g + 1] * inv); w.y = pk2(o[db][4 * g + 2] * inv, o[db][4 * g + 3] * inv);
            *(u32x2*)(op + 32 * db + 8 * g) = w; }
}

__device__ __forceinline__ void phase_attention(PP p, LAS unsigned char* lds, int chunk, int layer) {
    int tid_ = threadIdx.x; OPAQUE_V(tid_); const int tid = tid_, lane = tid & 63, wave = __builtin_amdgcn_readfirstlane(tid >> 6);
    const bf16_t* proj = (const bf16_t*)(p->ws + WS_PROJ);
    const bf16_t* vta = (const bf16_t*)(p->ws + WS_VTA);
    const bf16_t* vtb = (const bf16_t*)(p->ws + WS_VTB);
    const bf16_t* kba = (const bf16_t*)(p->ws + WS_KBA); const bf16_t* kbb = (const bf16_t*)(p->ws + WS_KBB);
    bf16_t* oa = (bf16_t*)(p->ws + WS_OA); bf16_t* ob = (bf16_t*)(p->ws + WS_OB); bf16_t* oc = (bf16_t*)(p->ws + WS_OC);
    bf16_t* og = (bf16_t*)(p->ws + WS_OG); float* lseb = (float*)(p->ws + WS_LSE);
    const bf16_t* memk = (const bf16_t*)(p->ws + WS_MEMK) + (size_t)layer * NBATCH * NMEM * 512;
    const bf16_t* memvt = (const bf16_t*)(p->ws + WS_MEMVT) + (size_t)layer * NBATCH * NMEM * 512;
    constexpr int NT_B = CB * 4 * 4, NT_A = CB * 8 * 8, NT_C = CB * 4 * 8;
    for (int task = blockIdx.x; task < NT_B + NT_A + NT_C; task += gridDim.x) {
        if (task < NT_B) {
            const int bl = task >> 4, hh = (task >> 2) & 3, sp = task & 3;
            for (int wt = wave; wt < 32; wt += NWAVES) {
                const int g = wt < 8 ? 0 : (wt < 16 ? 1 : 2), tq = wt < 16 ? (wt & 7) : (wt - 16), sh = 2 * g, dil = 1 << sh, L = SEQ >> sh, hb = 4 * g + hh;
                int c, m0;
                if (g == 0) { c = 0; m0 = sp * 512 + 64 * tq; } else if (g == 1) { c = tq >> 1; m0 = sp * 128 + 64 * (tq & 1); } else { c = tq; m0 = sp * 32; }
                AttnTask t;
                const size_t rowb = (size_t)bl * SEQ + c;
                t.q = proj + rowb * INW + 768 + hb * 64; t.qstride = (long)dil * INW;
                t.kb = kbb + (size_t)(bl * 12 + hb) * 64 * SEQ + (size_t)c * L * 64; t.vb = vtb + (size_t)(bl * 12 + hb) * 64 * SEQ + (size_t)c * L * 64;
                t.o = og + (size_t)g * MC * 256 + rowb * 256 + hh * 64; t.ostride = (long)dil * 256;
                t.lse = lseb + (size_t)g * MC * 4 + rowb * 4 + hh; t.lsestride = (long)dil * 4;
                t.m0 = m0; t.L = L; t.W = 64; t.m_init = -1e30f; t.l_init = 0.f; t.scale2 = 0.125f * LOG2E;
                if (g == 2) attn_wave<64, true, true, 1>(t, lane); else attn_wave<64, true, true, 2>(t, lane);
            }
            __syncthreads();
            {
                const size_t row = (size_t)bl * SEQ + sp * 512 + tid;
                const float l0 = lseb[row * 4 + hh], l1 = lseb[(size_t)MC * 4 + row * 4 + hh], l2 = lseb[(size_t)2 * MC * 4 + row * 4 + hh];
                const float mx = fmaxf(l0, fmaxf(l1, l2));
                float a0 = fexp2((l0 - mx) * LOG2E), a1 = fexp2((l1 - mx) * LOG2E), a2 = fexp2((l2 - mx) * LOG2E);
                const float is = 1.f / (a0 + a1 + a2); a0 *= is; a1 *= is; a2 *= is;
                const bf16_t* s0 = og + row * 256 + hh * 64; const bf16_t* s1 = s0 + (size_t)MC * 256; const bf16_t* s2 = s1 + (size_t)MC * 256;
                bf16_t* dp = ob + row * 256 + hh * 64;
#pragma unroll
                for (int j = 0; j < 8; ++j) { const u32x4 x0 = *(const u32x4*)(s0 + 8 * j), x1 = *(const u32x4*)(s1 + 8 * j), x2 = *(const u32x4*)(s2 + 8 * j);
                    u32x4 w;
                    w.x = pk2(a0 * bf2f(x0.x & 0xffffu) + a1 * bf2f(x1.x & 0xffffu) + a2 * bf2f(x2.x & 0xffffu), a0 * bf2f(x0.x >> 16) + a1 * bf2f(x1.x >> 16) + a2 * bf2f(x2.x >> 16));
                    w.y = pk2(a0 * bf2f(x0.y & 0xffffu) + a1 * bf2f(x1.y & 0xffffu) + a2 * bf2f(x2.y & 0xffffu), a0 * bf2f(x0.y >> 16) + a1 * bf2f(x1.y >> 16) + a2 * bf2f(x2.y >> 16));
                    w.z = pk2(a0 * bf2f(x0.z & 0xffffu) + a1 * bf2f(x1.z & 0xffffu) + a2 * bf2f(x2.z & 0xffffu), a0 * bf2f(x0.z >> 16) + a1 * bf2f(x1.z >> 16) + a2 * bf2f(x2.z >> 16));
                    w.w = pk2(a0 * bf2f(x0.w & 0xffffu) + a1 * bf2f(x1.w & 0xffffu) + a2 * bf2f(x2.w & 0xffffu), a0 * bf2f(x0.w >> 16) + a1 * bf2f(x1.w >> 16) + a2 * bf2f(x2.w >> 16));
                    *(u32x4*)(dp + 8 * j) = w; }
            }
            __syncthreads();
        } else
        if (task < NT_B + NT_A) {
            const int ta = task - NT_B, bl = ta >> 6, ha = (ta >> 3) & 7, sp = ta & 7;
            AttnTask t;
            const size_t rowb = (size_t)bl * SEQ;
            t.q = proj + rowb * INW + ha * 64; t.qstride = INW;
            t.kb = kba + (size_t)(bl * 2 + (ha >> 2)) * 64 * SEQ; t.vb = vta + (size_t)(bl * 2 + (ha >> 2)) * 64 * SEQ;
            t.o = oa + rowb * 512 + ha * 64; t.ostride = 512; t.lse = nullptr; t.lsestride = 0;
            t.m0 = sp * 256 + 32 * wave; t.L = SEQ; t.W = 128; t.m_init = p->sink_a[layer * 8 + ha] * LOG2E; t.l_init = 1.f; t.scale2 = 0.125f * LOG2E;
            const int kt0 = 8 * sp - 4;
            {
                const char* ks = (const char*)t.kb + (long)kt0 * 4096; const char* vs = (const char*)t.vb + (long)kt0 * 4096;
                u32x4 tmp[16];
#pragma unroll
                for (int i = 0; i < 8; ++i) { const int c = tid + 512 * i, kt = kt0 + (c >> 8); const bool ok = kt >= 0 && kt < SEQ / 32;
                    tmp[i] = ok ? *(const u32x4*)(ks + (long)c * 16) : (u32x4){0u, 0u, 0u, 0u}; tmp[8 + i] = ok ? *(const u32x4*)(vs + (long)c * 16) : (u32x4){0u, 0u, 0u, 0u}; }
#pragma unroll
                for (int i = 0; i < 8; ++i) { *(LAS u32x4*)(lds + (tid + 512 * i) * 16) = tmp[i]; *(LAS u32x4*)(lds + 65536 + (tid + 512 * i) * 16) = tmp[8 + i]; }
            }
            __syncthreads();
            attn_wave_win_lds(t, lds, kt0, lane);
            __syncthreads();
        } else {
            const int tc = task - NT_B - NT_A, bl = tc >> 5, hc = (tc >> 3) & 3, sp = tc & 7, bg = chunk * CB + bl;
            AttnTask t;
            const size_t rowb = (size_t)bl * SEQ;
            t.q = proj + rowb * INW + 3072 + hc * 128; t.qstride = INW;
            t.kb = memk + (size_t)(bg * 4 + hc) * 128 * NMEM; t.vb = memvt + (size_t)(bg * 4 + hc) * 128 * NMEM;
            t.o = oc + rowb * 512 + hc * 128; t.ostride = 512; t.lse = nullptr; t.lsestride = 0;
            t.m0 = sp * 256 + 32 * wave; t.L = NMEM; t.W = 0; t.m_init = -1e30f; t.l_init = 0.f; t.scale2 = 0.08838834764831845f * LOG2E;
            {
                const u32x4* ks = (const u32x4*)t.kb; const u32x4* vs = (const u32x4*)t.vb;
                u32x4 tmp[16];
#pragma unroll
                for (int i = 0; i < 8; ++i) { tmp[i] = ks[tid + 512 * i]; tmp[8 + i] = vs[tid + 512 * i]; }
#pragma unroll
                for (int i = 0; i < 8; ++i) { *(LAS u32x4*)(lds + (tid + 512 * i) * 16) = tmp[i]; *(LAS u32x4*)(lds + 65536 + (tid + 512 * i) * 16) = tmp[8 + i]; }
            }
            __syncthreads();
            attn_wave_mem_lds(t, lds, lane);
            __syncthreads();
        }
    }
}

#define XB_TMO      128
#define XB_XCNT(j)  (256  + 64 * (j))
#define XB_XSUB(j)  (1280 + 64 * (j))
#define XB_XGEN(j)  (2304 + 64 * (j))
#define XB_TOP      3328
#define XB_TOPGEN   3392
#define XCD_BAR_WORDS 3456
#define XB_SPIN_CAP (1u << 18)

__device__ __forceinline__ unsigned xb_ld(unsigned* p)              { return __hip_atomic_load(p, __ATOMIC_RELAXED, __HIP_MEMORY_SCOPE_AGENT); }
__device__ __forceinline__ unsigned xb_add(unsigned* p, unsigned v) { return __hip_atomic_fetch_add(p, v, __ATOMIC_RELAXED, __HIP_MEMORY_SCOPE_AGENT); }
__device__ __forceinline__ unsigned xb_xcc_id() { return (unsigned)__builtin_amdgcn_s_getreg((3 << 11) | 20) & 0xFu; }
#define XB_SPIN(cond, bar) do { unsigned _sp = 0; while (cond) { __builtin_amdgcn_s_sleep(1); \
    if ((++_sp & 255u) == 0u) { if (xb_ld(&(bar)[XB_TMO])) break; if (_sp > XB_SPIN_CAP) { atomicAdd(&(bar)[XB_TMO], 1u); break; } } } } while (0)
struct XcdBarrier {
    unsigned* bar; unsigned x;
    volatile LAS unsigned* st;
};

__device__ __forceinline__ XcdBarrier xcd_barrier_post(unsigned* bar, volatile LAS unsigned* st) {
    XcdBarrier b; b.bar = bar; b.x = xb_xcc_id(); b.st = st;
    if (threadIdx.x == 0) (void)xb_add(&bar[XB_XCNT(b.x)], 1u);
    return b;
}
__device__ __forceinline__ void xcd_barrier_complete(unsigned* bar, unsigned x, unsigned& nloc, unsigned& nx) {
    const unsigned G = gridDim.x * gridDim.y * gridDim.z;
    unsigned sum, cnt, mine, sp = 0u;
    for (;;) {
        sum = 0u; cnt = 0u; mine = 0u;
#pragma unroll
        for (unsigned j = 0; j < 16; ++j) { const unsigned c = xb_ld(&bar[XB_XCNT(j)]); sum += c; cnt += (c > 0u) ? 1u : 0u; mine = (j == x) ? c : mine; }
        if (sum == G) break;
        __builtin_amdgcn_s_sleep(1);
        if ((++sp & 255u) == 0u) { if (xb_ld(&bar[XB_TMO])) break; if (sp > XB_SPIN_CAP) { atomicAdd(&bar[XB_TMO], 1u); break; } }
    }
    nloc = mine > 0u ? mine : 1u; nx = cnt > 0u ? cnt : 1u;
}

__device__ __forceinline__ void xcd_barrier(const XcdBarrier& b) {
    asm volatile("s_waitcnt vmcnt(0)" ::: "memory");
    __syncthreads();
    if (threadIdx.x == 0) {
        unsigned* bar = b.bar;
        __builtin_amdgcn_s_waitcnt(0);
        unsigned nloc = b.st[0], nx = b.st[1];
        if (nloc == 0u) { xcd_barrier_complete(bar, b.x, nloc, nx); b.st[0] = nloc; b.st[1] = nx; }
        const unsigned old = xb_add(&bar[XB_XSUB(b.x)], 1u);
        const unsigned gen = old / nloc;
        if (old + 1u == (gen + 1u) * nloc) {
            __builtin_amdgcn_fence(__ATOMIC_RELEASE, "agent");
            asm volatile("s_waitcnt vmcnt(0)" ::: "memory");
            const unsigned og = xb_add(&bar[XB_TOP], 1u);
            const unsigned tg = og / nx;
            if (og + 1u == (tg + 1u) * nx) xb_add(&bar[XB_TOPGEN], 1u);
            else XB_SPIN(xb_ld(&bar[XB_TOPGEN]) == tg, bar);
            __builtin_amdgcn_fence(__ATOMIC_ACQUIRE, "agent");
            xb_add(&bar[XB_XGEN(b.x)], 1u);
            asm volatile("s_waitcnt vmcnt(0)" ::: "memory");
        } else {
            XB_SPIN(xb_ld(&bar[XB_XGEN(b.x)]) == gen, bar);
            __builtin_amdgcn_fence(__ATOMIC_ACQUIRE, "agent");
            asm volatile("s_waitcnt vmcnt(0)" ::: "memory");
        }
    }
    __syncthreads();
}


constexpr int STEPS_PER_CHUNK = 1 + DEPTH * 8, N_STEPS = 2 + NCHUNK * STEPS_PER_CHUNK;
__device__ __forceinline__ void run_step(PP p, LAS unsigned char* lds, int s) {
    bf16_t* WT = (bf16_t*)(p->ws + WS_WT);
    if (s == 0) { phase_prologue_a(p, lds); return; }
    if (s == 1) {
        for (int l = 0; l < DEPTH; ++l) { EpiMemKV E; E.mk = (bf16_t*)(p->ws + WS_MEMK) + (size_t)l * NBATCH * NMEM * 512; E.mvt = (bf16_t*)(p->ws + WS_MEMVT) + (size_t)l * NBATCH * NMEM * 512;
            run_gemm(lds, (const bf16_t*)(p->ws + WS_MEMN) + (size_t)l * NBATCH * NMEM * DM, WT + (size_t)l * WL + WO_MKV, NBATCH * NMEM, 1024, DM, E, 64 * l); }
        return;
    }
    const int s2 = s - 2, chunk = s2 / STEPS_PER_CHUNK, r = s2 % STEPS_PER_CHUNK;
    if (r == 0) { phase_rows_first(p, chunk); return; }
    const int l = (r - 1) >> 3, ph = (r - 1) & 7;
    const bf16_t* wl = WT + (size_t)l * WL;
    bf16_t* H = (bf16_t*)(p->ws + WS_H); bf16_t* proj = (bf16_t*)(p->ws + WS_PROJ); bf16_t* mrg = (bf16_t*)(p->ws + WS_MRG);
    switch (ph) {
    case 0: { EpiIn E; E.proj = proj; E.vta = (bf16_t*)(p->ws + WS_VTA); E.vtb = (bf16_t*)(p->ws + WS_VTB); E.kba = (bf16_t*)(p->ws + WS_KBA); E.kbb = (bf16_t*)(p->ws + WS_KBB); E.rope = (const float*)(p->ws + WS_ROPE);
        run_gemm(lds, H, wl + WO_IN, MC, INW, DM, E, 0); } break;
    case 1: phase_attention(p, lds, chunk, l); break;
    case 2: {
        EpiGate E; E.mrg = mrg;
        E.gate = proj + 3584; E.accum = 0; run_gemm<EpiGate, GATE_FAST>(lds, (const bf16_t*)(p->ws + WS_OA), wl + WO_OA, MC, DM, 512, E, 0);
        E.gate = proj + 3584 + 1024; E.accum = 1; run_gemm<EpiGate, GATE_FAST>(lds, (const bf16_t*)(p->ws + WS_OB), wl + WO_OB, MC, DM, 256, E, 0);
        E.gate = proj + 3584 + 2048; E.accum = 1; run_gemm<EpiGate, GATE_FAST>(lds, (const bf16_t*)(p->ws + WS_OC), wl + WO_OC, MC, DM, 512, E, 0);
        } break;
    case 3: { EpiY E; E.Y = (bf16_t*)(p->ws + WS_Y); run_gemm(lds, mrg, wl + WO_OUT, MC, DM, DM, E, 0); } break;
    case 4: phase_rows_resid(p, chunk, l == 0, p->g_mix_post + l * DM, p->g_ffn_pre + l * DM, true); break;
    case 5: { EpiSwiGLU E; E.act = (bf16_t*)(p->ws + WS_ACT); run_gemm(lds, H, wl + WO_FIN, MC, 2 * FFH, DM, E, 0); } break;
    case 6: { EpiY E; E.Y = (bf16_t*)(p->ws + WS_Y); run_gemm(lds, (const bf16_t*)(p->ws + WS_ACT), wl + WO_FOUT, MC, DM, FFH, E, 0); } break;
    default: phase_rows_resid(p, chunk, false, p->g_ffn_post + l * DM, p->g_mix_pre + (l < DEPTH - 1 ? l + 1 : l) * DM, l < DEPTH - 1); break;
    }
}

__global__ void __launch_bounds__(NTHREADS, 2) fwd_megakernel(Params p) {
    extern __shared__ __attribute__((aligned(16))) unsigned char lds_raw[];
    LAS unsigned char* lds = (LAS unsigned char*)lds_raw;
    cg::grid_group grid = cg::this_grid();
    PP pp = (PP)__builtin_amdgcn_kernarg_segment_ptr();
    const int s_hi = pp->s_hi;
    __shared__ uint4 xb_words;
    if (threadIdx.x == 0) xb_words = make_uint4(0u, 0u, 0u, 0u);
    __syncthreads();
    const XcdBarrier xbar = xcd_barrier_post((unsigned*)(pp->ws + WS_BAR), (volatile LAS unsigned*)&xb_words);
    const int s_lo = pp->s_lo;
    for (int s = s_lo; s < s_hi; ++s) {
        PP q = pp; OPAQUE_S(q);
        run_step(q, lds, s);
        if (s + 1 < s_hi) { if (s == s_lo) grid.sync(); else xcd_barrier(xbar); }
    }
}

extern "C" void kernel_launch(void* const* d_in, const int* in_sizes, int n_in, void* d_out, int out_size, void* d_ws, size_t ws_size, hipStream_t stream) {
    static int grid_blocks = 0;
    if (grid_blocks == 0) {
        if (n_in != 18 || out_size != NBATCH * SEQ * DM || ws_size < WS_END) { fprintf(stderr, "kernel_launch: unexpected shapes / workspace (n_in %d out %d ws %zu need %zu)\n", n_in, out_size, ws_size, (size_t)WS_END); grid_blocks = -1; return; }
        int dev = 0, cus = 0, per_cu = 0;
        hipGetDevice(&dev);
        hipDeviceGetAttribute(&cus, hipDeviceAttributeMultiprocessorCount, dev);
        if (hipFuncSetAttribute((const void*)fwd_megakernel, hipFuncAttributeMaxDynamicSharedMemorySize, LDS_BYTES) != hipSuccess) { fprintf(stderr, "kernel_launch: hipFuncSetAttribute failed\n"); grid_blocks = -1; return; }
        hipOccupancyMaxActiveBlocksPerMultiprocessor(&per_cu, (const void*)fwd_megakernel, NTHREADS, LDS_BYTES);
        if (per_cu < 1) { fprintf(stderr, "kernel_launch: occupancy query says %d blocks per CU\n", per_cu); per_cu = 1; }
        (void)hipGetLastError();
        grid_blocks = cus * 1;
    }
    if (grid_blocks < 0) return;
    if (hipMemsetAsync((char*)d_ws + WS_BAR, 0, 16384, stream) != hipSuccess) { fprintf(stderr, "kernel_launch: hipMemsetAsync failed\n"); return; }
    Params p{};
    p.x_prompt = (const float*)d_in[0]; p.x_sample = (const float*)d_in[1]; p.mem_prompt = (const float*)d_in[2]; p.mem_sample = (const float*)d_in[3];
    p.g_mix_pre = (const float*)d_in[4]; p.g_mix_post = (const float*)d_in[5]; p.g_mem = (const float*)d_in[6]; p.w_in = (const float*)d_in[7];
    p.sink_a = (const float*)d_in[8]; p.w_mem_kv = (const float*)d_in[9]; p.w_o_a = (const float*)d_in[10]; p.w_o_b = (const float*)d_in[11];
    p.w_o_c = (const float*)d_in[12]; p.w_out = (const float*)d_in[13]; p.g_ffn_pre = (const float*)d_in[14]; p.g_ffn_post = (const float*)d_in[15];
    p.w_ffn_in = (const float*)d_in[16]; p.w_ffn_out = (const float*)d_in[17];
    p.out = (float*)d_out; p.ws = (unsigned char*)d_ws;
    for (int j = 0; j < 8; ++j) p.inv_freq[j] = powf(500000.0f, -(float)(2 * j) / 16.0f);
#if MK_MULTI_LAUNCH
    for (int s = 0; s < N_STEPS; ++s) {
        p.s_lo = s; p.s_hi = s + 1;
        hipLaunchKernelGGL(fwd_megakernel, dim3(grid_blocks), dim3(NTHREADS), LDS_BYTES, stream, p);
    }
#else
    p.s_lo = 0; p.s_hi = N_STEPS;
    void* args[] = {&p};
    hipError_t e = hipLaunchCooperativeKernel((const void*)fwd_megakernel, dim3(grid_blocks), dim3(NTHREADS), args, LDS_BYTES, stream);
    if (e != hipSuccess) fprintf(stderr, "kernel_launch: cooperative launch failed: %s (grid %d)\n", hipGetErrorString(e), grid_blocks);
#endif
}
```

```cpp
#include <hip/hip_runtime.h>
#include <hip/hip_cooperative_groups.h>
#include <cstdio>
#include <cstdint>
#include <cmath>
namespace cg = cooperative_groups;
#ifndef MK_MULTI_LAUNCH
#define MK_MULTI_LAUNCH 0
#endif
namespace pg8 {
#define PG8_LAS __attribute__((address_space(3)))
typedef unsigned short bf16_t;
typedef short bf16x8 __attribute__((ext_vector_type(8)));
typedef float f32x4 __attribute__((ext_vector_type(4)));
typedef unsigned u32x4 __attribute__((ext_vector_type(4)));
constexpr int BM = 256, BK = 64, HALF = 128, HTB = HALF * BK * 2  , STAGE_BYTES = 8 * HTB, NXCD = 8, WGM = 8;

__host__ __device__ __forceinline__ int lds_byte(int r, int c) { const int st = (r >> 4) * 2 + (c >> 5), rr = r & 15, cc = c & 31, ob = rr * 64 + cc * 2; return st * 1024 + (ob ^ (((ob >> 9) & 1) << 5)); }
__host__ __device__ __forceinline__ void stage_rc(int b, int& R, int& C) { const int st = b / 1024, sb = b % 1024, swz = sb ^ (((sb >> 9) & 1) << 5); R = (st >> 1) * 16 + swz / 64; C = (st & 1) * 32 + (swz % 64) / 2; }
__host__ __device__ __forceinline__ int perm32(int rho) { const int n = rho >> 4, i = rho & 15; return 8 * (i >> 2) + 4 * n + (i & 3); }

struct Unit { int pm, pn; };
struct Gemm { const bf16_t* A; const bf16_t* Bt; int M, N, K; };

struct StaticOrder {
    int nM, nN, nwg, G, c;
    __host__ __device__ void init(int M, int N, int G_, int c_) { nM = M / BM; nN = N / BM; nwg = nM * nN; G = G_; c = c_; }
    __host__ __device__ bool next(int i, Unit& u) const {
        const long L = (long)i * G + c; if (L >= nwg) return false;
        int wgid = (int)L; { const int q = nwg / NXCD, r = nwg % NXCD, xcd = wgid % NXCD, off = wgid / NXCD; wgid = (xcd < r ? xcd * (q + 1) : r * (q + 1) + (xcd - r) * q) + off; }
        const int nig = WGM * nN, gid = wgid / nig, fm = gid * WGM, gsz = (nM - fm) < WGM ? (nM - fm) : WGM;
        u.pm = fm + ((wgid % nig) % gsz); u.pn = (wgid % nig) / gsz; return true;
    }
    __device__ __forceinline__ void a_ready(const Unit&) const {}
    __device__ __forceinline__ void done(const Unit&) const {}
};
__device__ __forceinline__ unsigned cvt_pk_bf16(float lo, float hi) { unsigned r; asm volatile("v_cvt_pk_bf16_f32 %0, %1, %2" : "=v"(r) : "v"(lo), "v"(hi)); return r; }
typedef float f32x2 __attribute__((ext_vector_type(2)));
template <class Epi, class Sched, bool ALIGN_EPI = false, bool SP2 = false>
__device__ __forceinline__ void gemm_phase(PG8_LAS unsigned char* lds, const Gemm g, const Sched& S, const Epi& E) {
    int tid_ = threadIdx.x; asm volatile("" : "+v"(tid_)); const int tid = tid_, wid = __builtin_amdgcn_readfirstlane(tid >> 6), lane = tid & 63, wr = wid >> 2, wc = wid & 3, fr = lane & 15, fq = lane >> 4;
    const int K = g.K, nt = K / BK;
    unsigned voffA[2], voffB[2];
#pragma unroll
    for (int i = 0; i < 2; ++i) { int R, C; stage_rc(tid * 16 + i * 8192, R, C); const int Rb = Epi::PERM ? ((R & ~31) + perm32(R & 31)) : R;
        voffA[i] = (unsigned)(R * K + C) * 2u; voffB[i] = (unsigned)(Rb * K + C) * 2u; }
    const size_t kstep = (size_t)(BK * 2);
    const size_t hstep = (size_t)HALF * K * 2;
    const size_t tstep = 2 * hstep;
    const unsigned ldsw = (unsigned)wid * 1024u;
    const int aoff = lds_byte(wr * 64 + fr, fq * 8), boff = lds_byte(wc * 32 + fr, fq * 8);
#define PG8_SA(b, h) (((b) * 2 + (h)) * HTB)
#define PG8_SB(b, h) ((4 + (b) * 2 + (h)) * HTB)
#define PG8_STAGE(bufoff, gbase, voff) do { _Pragma("unroll") for (int _i = 0; _i < 2; ++_i) \
        __builtin_amdgcn_global_load_lds((const unsigned*)((const char*)(gbase) + (voff)[_i]), (PG8_LAS unsigned*)(lds + (bufoff) + ldsw + _i * 8192), 16, 0, 0); } while (0)
#define PG8_LDA(dst, b, h) do { _Pragma("unroll") for (int m = 0; m < 4; ++m) _Pragma("unroll") for (int k = 0; k < 2; ++k) dst[m][k] = *(const PG8_LAS bf16x8*)(lds + PG8_SA(b, h) + aoff + m * 2048 + k * 1024); } while (0)
#define PG8_LDB(dst, b, h) do { _Pragma("unroll") for (int n = 0; n < 2; ++n) _Pragma("unroll") for (int k = 0; k < 2; ++k) dst[n][k] = *(const PG8_LAS bf16x8*)(lds + PG8_SB(b, h) + boff + n * 2048 + k * 1024); } while (0)
#define PG8_MMA(ai, bj, At, Bt) do { __builtin_amdgcn_s_setprio(1); _Pragma("unroll") for (int m = 0; m < 4; ++m) _Pragma("unroll") for (int n = 0; n < 2; ++n) _Pragma("unroll") for (int k = 0; k < 2; ++k) \
        acc[ai][bj][m][n] = __builtin_amdgcn_mfma_f32_16x16x32_bf16(Bt[n][k], At[m][k], acc[ai][bj][m][n], 0, 0, 0); __builtin_amdgcn_s_setprio(0); } while (0)
#define PG8_WAIT_V(n) asm volatile("s_waitcnt vmcnt(" #n ")" ::: "memory")
#define PG8_WAIT_L(n) asm volatile("s_waitcnt lgkmcnt(" #n ")" ::: "memory")
#define PG8_BAR __builtin_amdgcn_s_barrier()
#define PG8_SCHED __builtin_amdgcn_sched_barrier(0)
    Unit cur, nxt; int ui = 0;
    if (!S.next(0, cur)) return;
    f32x4 acc[2][2][4][2];
#pragma unroll
    for (int a = 0; a < 2; ++a)
#pragma unroll
        for (int b = 0; b < 2; ++b)
#pragma unroll
            for (int m = 0; m < 4; ++m)
#pragma unroll
                for (int n = 0; n < 2; ++n) acc[a][b][m][n] = (f32x4){0.f, 0.f, 0.f, 0.f};
    bf16x8 At[4][2], B0[2][2], B1[2][2];
    const char* cA = (const char*)g.A + (size_t)cur.pm * tstep; const char* cB = (const char*)g.Bt + (size_t)cur.pn * tstep;
    S.a_ready(cur);
    if constexpr (SP2) {
        PG8_STAGE(PG8_SB(0, 0), cB, voffB); PG8_STAGE(PG8_SB(0, 1), cB + hstep, voffB); PG8_STAGE(PG8_SA(0, 0), cA, voffA); PG8_STAGE(PG8_SA(0, 1), cA + hstep, voffA);
        if (wr == 1) PG8_BAR;
        PG8_WAIT_V(2); PG8_BAR;
        PG8_STAGE(PG8_SB(1, 0), cB + kstep, voffB); PG8_STAGE(PG8_SA(1, 0), cA + kstep, voffA); PG8_STAGE(PG8_SB(1, 1), cB + hstep + kstep, voffB);
        PG8_WAIT_V(6); PG8_BAR;
    } else {
        PG8_STAGE(PG8_SB(0, 0), cB, voffB); PG8_STAGE(PG8_SA(0, 0), cA, voffA); PG8_STAGE(PG8_SB(0, 1), cB + hstep, voffB); PG8_STAGE(PG8_SA(0, 1), cA + hstep, voffA);
        if (wr == 1) PG8_BAR;
        PG8_WAIT_V(4); PG8_BAR;
        PG8_STAGE(PG8_SB(1, 0), cB + kstep, voffB); PG8_STAGE(PG8_SA(1, 0), cA + kstep, voffA); PG8_STAGE(PG8_SB(1, 1), cB + hstep + kstep, voffB);
        PG8_WAIT_V(6); PG8_BAR;
    }
    for (;;) {
        const bool has_next = S.next(ui + 1, nxt);
        const char* nA = has_next ? (const char*)g.A + (size_t)nxt.pm * tstep : cA; const char* nB = has_next ? (const char*)g.Bt + (size_t)nxt.pn * tstep : cB;
        for (int t = 0; t < nt; t += 2) {
            const bool last = (t == nt - 2);
            const char* a1 = cA + (size_t)(t + 1) * kstep;
            const char* a2 = last ? nA : cA + (size_t)(t + 2) * kstep; const char* b2 = last ? nB : cB + (size_t)(t + 2) * kstep;
            const char* a3 = a2 + kstep; const char* b3 = b2 + kstep;
            if (last && has_next) S.a_ready(nxt);
            if constexpr (SP2) {
            PG8_LDB(B0, 0, 0); PG8_LDB(B1, 0, 1); PG8_SCHED; PG8_LDA(At, 0, 0); PG8_STAGE(PG8_SA(1, 1), a1 + hstep, voffA);
            PG8_WAIT_V(8); PG8_WAIT_L(0); PG8_BAR; PG8_MMA(0, 0, At, B0); PG8_MMA(0, 1, At, B1); PG8_BAR; PG8_SCHED;
            PG8_LDA(At, 0, 1); PG8_STAGE(PG8_SB(0, 0), b2, voffB); PG8_STAGE(PG8_SB(0, 1), b2 + hstep, voffB); PG8_STAGE(PG8_SA(0, 0), a2, voffA);
            PG8_WAIT_V(8); PG8_WAIT_L(0); PG8_BAR; PG8_MMA(1, 0, At, B0); PG8_MMA(1, 1, At, B1); PG8_BAR; PG8_SCHED;
            PG8_LDB(B0, 1, 0); PG8_LDB(B1, 1, 1); PG8_SCHED; PG8_LDA(At, 1, 0); PG8_STAGE(PG8_SA(0, 1), a2 + hstep, voffA);
            PG8_WAIT_V(8); PG8_WAIT_L(0); PG8_BAR; PG8_MMA(0, 0, At, B0); PG8_MMA(0, 1, At, B1); PG8_BAR; PG8_SCHED;
            PG8_LDA(At, 1, 1); PG8_STAGE(PG8_SB(1, 0), b3, voffB); PG8_STAGE(PG8_SB(1, 1), b3 + hstep, voffB); PG8_STAGE(PG8_SA(1, 0), a3, voffA);
            PG8_WAIT_V(8); PG8_WAIT_L(0); PG8_BAR; PG8_MMA(1, 0, At, B0); PG8_MMA(1, 1, At, B1); PG8_BAR; PG8_SCHED;
            } else {
            PG8_LDB(B0, 0, 0); PG8_SCHED; PG8_LDA(At, 0, 0); PG8_STAGE(PG8_SA(1, 1), a1 + hstep, voffA);
            PG8_WAIT_L(8); PG8_BAR; PG8_WAIT_L(0); PG8_MMA(0, 0, At, B0); PG8_BAR; PG8_SCHED;
            PG8_LDB(B1, 0, 1); PG8_STAGE(PG8_SB(0, 0), b2, voffB);
            PG8_BAR; PG8_WAIT_L(0); PG8_MMA(0, 1, At, B1); PG8_BAR;
            PG8_LDA(At, 0, 1); PG8_STAGE(PG8_SA(0, 0), a2, voffA);
            PG8_BAR; PG8_WAIT_L(0); PG8_MMA(1, 0, At, B0); PG8_BAR; PG8_SCHED;
            PG8_STAGE(PG8_SB(0, 1), b2 + hstep, voffB);
            PG8_WAIT_V(6); PG8_BAR; PG8_MMA(1, 1, At, B1); PG8_BAR;
            PG8_LDB(B0, 1, 0); PG8_SCHED; PG8_LDA(At, 1, 0); PG8_STAGE(PG8_SA(0, 1), a2 + hstep, voffA);
            PG8_WAIT_L(8); PG8_BAR; PG8_WAIT_L(0); PG8_MMA(0, 0, At, B0); PG8_BAR; PG8_SCHED;
            PG8_LDB(B1, 1, 1); PG8_STAGE(PG8_SB(1, 0), b3, voffB);
            PG8_BAR; PG8_WAIT_L(0); PG8_MMA(0, 1, At, B1); PG8_BAR;
            PG8_LDA(At, 1, 1); PG8_STAGE(PG8_SA(1, 0), a3, voffA);
            PG8_BAR; PG8_WAIT_L(0); PG8_MMA(1, 0, At, B0); PG8_BAR; PG8_SCHED;
            PG8_STAGE(PG8_SB(1, 1), b3 + hstep, voffB);
            PG8_WAIT_V(6); PG8_BAR; PG8_MMA(1, 1, At, B1); PG8_BAR;
            }
        }
        if constexpr (ALIGN_EPI) { if (wr == 0) PG8_BAR; }
        if constexpr (!Epi::AFTER_DRAIN) { E(acc, cur, wr, wc, fr, fq); S.done(cur); }
        if (!has_next) break;
#pragma unroll
        for (int a = 0; a < 2; ++a)
#pragma unroll
            for (int b = 0; b < 2; ++b)
#pragma unroll
                for (int m = 0; m < 4; ++m)
#pragma unroll
                    for (int n = 0; n < 2; ++n) acc[a][b][m][n] = (f32x4){0.f, 0.f, 0.f, 0.f};
        cur = nxt; cA = nA; cB = nB; ++ui;
        if constexpr (ALIGN_EPI) { if (wr == 1) PG8_BAR; }
    }
    PG8_WAIT_V(0);
    if constexpr (!ALIGN_EPI) { if (wr == 0) PG8_BAR; }
    PG8_BAR;
    if constexpr (Epi::AFTER_DRAIN) { E.fused(acc, cur, wr, wc, fr, fq, lds, wid, lane); S.done(cur); }
#undef PG8_SA
#undef PG8_SB
#undef PG8_STAGE
#undef PG8_LDA
#undef PG8_LDB
#undef PG8_MMA
#undef PG8_WAIT_V
#undef PG8_WAIT_L
#undef PG8_BAR
#undef PG8_SCHED
}
}

using pg8::bf16_t; using pg8::bf16x8; using pg8::f32x4; using pg8::u32x4;
typedef float f32x16 __attribute__((ext_vector_type(16)));
typedef unsigned u32x2 __attribute__((ext_vector_type(2)));
#define LAS __attribute__((address_space(3)))
constexpr int NTHREADS = 512, NWAVES = 8, LDS_BYTES = pg8::STAGE_BYTES;
constexpr int DM = 1024, SEQ = 2048, NBATCH = 48, DEPTH = 4, NMEM = 256, INW = 6656, FFH = 2816;
constexpr int CB = 16, MC = CB * SEQ, NCHUNK = NBATCH / CB;
constexpr float EPS = 1e-6f, LOG2E = 1.4426950408889634f, LN2 = 0.6931471805599453f;
constexpr size_t WO_IN = 0, WO_MKV = WO_IN + (size_t)INW * DM, WO_OA = WO_MKV + (size_t)1024 * DM, WO_OB = WO_OA + (size_t)1024 * 512, WO_OC = WO_OB + (size_t)1024 * 256,
                 WO_OUT = WO_OC + (size_t)1024 * 512, WO_FIN = WO_OUT + (size_t)1024 * 1024, WO_FOUT = WO_FIN + (size_t)2 * FFH * DM, WL = WO_FOUT + (size_t)DM * FFH;
constexpr size_t al256(size_t x) { return (x + 255) & ~(size_t)255; }
constexpr size_t WS_WT = 0;
constexpr size_t WS_ROPE = al256(WS_WT + WL * DEPTH * 2);
constexpr size_t WS_MEMK = al256(WS_ROPE + (size_t)SEQ * 8 * 8);
constexpr size_t WS_MEMVT = al256(WS_MEMK + (size_t)DEPTH * NBATCH * NMEM * 512 * 2);
constexpr size_t WS_H = al256(WS_MEMVT + (size_t)DEPTH * NBATCH * NMEM * 512 * 2);
constexpr size_t WS_PROJ = al256(WS_H + (size_t)MC * DM * 2);
constexpr size_t WS_VTA = al256(WS_PROJ + (size_t)MC * INW * 2);
constexpr size_t WS_VTB = al256(WS_VTA + (size_t)CB * 2 * 64 * SEQ * 2);
constexpr size_t WS_OA = al256(WS_VTB + (size_t)CB * 12 * 64 * SEQ * 2);
constexpr size_t WS_OB = al256(WS_OA + (size_t)MC * 512 * 2);
constexpr size_t WS_OC = al256(WS_OB + (size_t)MC * 256 * 2);
constexpr size_t WS_MRG = al256(WS_OC + (size_t)MC * 512 * 2);
constexpr size_t WS_KBA = al256(WS_MRG + (size_t)MC * DM * 2);
constexpr size_t WS_KBB = al256(WS_KBA + (size_t)CB * 2 * 64 * SEQ * 2);
constexpr size_t WS_BAR = al256(WS_KBB + (size_t)CB * 12 * 64 * SEQ * 2);
constexpr size_t WS_END = al256(WS_BAR + 16384);
constexpr size_t WS_MEMN = WS_PROJ;
constexpr size_t WS_Y = WS_PROJ;
constexpr size_t WS_ACT = WS_PROJ + (size_t)MC * DM * 4;
constexpr size_t WS_OG = WS_MRG;
constexpr size_t WS_LSE = WS_MRG + (size_t)3 * MC * 256 * 2;
static_assert((size_t)DEPTH * NBATCH * NMEM * DM * 2 <= (size_t)MC * INW * 2, "memn overlay");
static_assert((size_t)MC * DM * 4 + (size_t)MC * FFH * 2 <= (size_t)MC * INW * 2, "y/act overlay");
static_assert((size_t)3 * MC * 256 * 2 + (size_t)3 * MC * 4 * 4 <= (size_t)MC * DM * 2, "og overlay");

struct Params {
    const float *x_prompt, *x_sample, *mem_prompt, *mem_sample, *g_mix_pre, *g_mix_post, *g_mem, *w_in, *sink_a, *w_mem_kv, *w_o_a, *w_o_b, *w_o_c, *w_out,
                *g_ffn_pre, *g_ffn_post, *w_ffn_in, *w_ffn_out;
    float* out; unsigned char* ws;
    float inv_freq[8];
    int s_lo, s_hi;
};

typedef const __attribute__((address_space(4))) Params* PP;
#define OPAQUE_V(x) asm volatile("" : "+v"(x))
#define OPAQUE_S(x) asm volatile("" : "+s"(x))
__device__ __forceinline__ float bf2f(unsigned b) { return __uint_as_float(b << 16); }
typedef __bf16 bf16x2v __attribute__((ext_vector_type(2)));
typedef float f32x2v __attribute__((ext_vector_type(2)));
__device__ __forceinline__ unsigned pk2(float lo, float hi) { const f32x2v v = {lo, hi}; return __builtin_bit_cast(unsigned, __builtin_convertvector(v, bf16x2v)); }
__device__ __forceinline__ float wave_sum(float v) {
#pragma unroll
    for (int o = 32; o > 0; o >>= 1) v += __shfl_xor(v, o);
    return v;
}
__device__ __forceinline__ float fexp2(float x) { return __builtin_amdgcn_exp2f(x); }
__device__ __forceinline__ float frcp(float x) { return __builtin_amdgcn_rcpf(x); }
__device__ __forceinline__ float sigmoidf_(float x) { return frcp(1.f + fexp2(-x * LOG2E)); }
#define LDS_WAIT() asm volatile("s_waitcnt lgkmcnt(0)" ::: "memory")

__device__ __forceinline__ int src_col_in(int n) {
    const bool qk = (n < 640) || (n >= 768 && n < 2304);
    const int p = n & 63;
    return (qk && p < 16) ? (n - p) + (p >> 1) + 8 * (p & 1) : n;
}
__device__ __forceinline__ int src_col_ffin(int n) { const int q = n >> 3, e = n & 7; return e < 4 ? 4 * q + e : FFH + 4 * q + (e - 4); }

template <int PERMT>
__device__ __forceinline__ void transpose_item(const float* W, int K, int N, bf16_t* WT, LAS float* scr, int item, int lane) {
    const int nblk = N / 32, kb = item / nblk, nb = item % nblk, k0 = 64 * kb, n0 = 32 * nb;
    const int nd = n0 + (lane & 31);
    const int ns = PERMT == 1 ? src_col_in(nd) : (PERMT == 2 ? src_col_ffin(nd) : nd);
#pragma unroll 8
    for (int i = 0; i < 32; ++i) { const int kk = 2 * i + (lane >> 5); scr[kk * 33 + (lane & 31)] = __builtin_nontemporal_load(W + (size_t)(k0 + kk) * N + ns); }
    LDS_WAIT();
    const int c = lane & 7;
#pragma unroll
    for (int j = 0; j < 4; ++j) { const int n = (lane >> 3) + 8 * j; const LAS float* s = scr + (8 * c) * 33 + n;
        u32x4 o; o.x = pk2(s[0 * 33], s[1 * 33]); o.y = pk2(s[2 * 33], s[3 * 33]); o.z = pk2(s[4 * 33], s[5 * 33]); o.w = pk2(s[6 * 33], s[7 * 33]);
        *(u32x4*)(WT + (size_t)(n0 + n) * K + k0 + 8 * c) = o; }
    LDS_WAIT();
}

__device__ __forceinline__ void phase_prologue_a(PP p, LAS unsigned char* lds) {
    int tid_ = threadIdx.x; OPAQUE_V(tid_); const int tid = tid_, lane = tid & 63, wave = __builtin_amdgcn_readfirstlane(tid >> 6);
    const int gw = blockIdx.x * NWAVES + wave, NGW = gridDim.x * NWAVES;
    LAS float* scr = (LAS float*)(lds + wave * 16384);
    bf16_t* WT = (bf16_t*)(p->ws + WS_WT);
    constexpr int I_IN = 16 * (INW / 32), I_MKV = 16 * 32, I_OA = 8 * 32, I_OB = 4 * 32, I_OC = 8 * 32, I_OUT = 16 * 32, I_FIN = 16 * (2 * FFH / 32), I_FOUT = (FFH / 64) * 32;
    constexpr int I_L = I_IN + I_MKV + I_OA + I_OB + I_OC + I_OUT + I_FIN + I_FOUT;
    for (int it = gw; it < I_L * DEPTH; it += NGW) {
        const int l = it / I_L; int r = it % I_L;
        bf16_t* wl = WT + (size_t)l * WL;
        if (r < I_IN) { transpose_item<1>(p->w_in + (size_t)l * DM * INW, DM, INW, wl + WO_IN, scr, r, lane); continue; } r -= I_IN;
        if (r < I_MKV) { transpose_item<0>(p->w_mem_kv + (size_t)l * DM * 1024, DM, 1024, wl + WO_MKV, scr, r, lane); continue; } r -= I_MKV;
        if (r < I_OA) { transpose_item<0>(p->w_o_a + (size_t)l * 512 * DM, 512, DM, wl + WO_OA, scr, r, lane); continue; } r -= I_OA;
        if (r < I_OB) { transpose_item<0>(p->w_o_b + (size_t)l * 256 * DM, 256, DM, wl + WO_OB, scr, r, lane); continue; } r -= I_OB;
        if (r < I_OC) { transpose_item<0>(p->w_o_c + (size_t)l * 512 * DM, 512, DM, wl + WO_OC, scr, r, lane); continue; } r -= I_OC;
        if (r < I_OUT) { transpose_item<0>(p->w_out + (size_t)l * DM * DM, DM, DM, wl + WO_OUT, scr, r, lane); continue; } r -= I_OUT;
        if (r < I_FIN) { transpose_item<2>(p->w_ffn_in + (size_t)l * DM * 2 * FFH, DM, 2 * FFH, wl + WO_FIN, scr, r, lane); continue; } r -= I_FIN;
        transpose_item<0>(p->w_ffn_out + (size_t)l * FFH * DM, FFH, DM, wl + WO_FOUT, scr, r, lane);
    }
    float2* rope = (float2*)(p->ws + WS_ROPE);
    for (int i = blockIdx.x * NTHREADS + tid; i < SEQ * 8; i += gridDim.x * NTHREADS) {
        const int pos = i >> 3, j = i & 7;
        const float ang = (float)pos * p->inv_freq[j];
        const double rev = (double)ang * 0.15915494309189535;
        const float fr = (float)(rev - rint(rev));
        rope[i] = make_float2(__builtin_amdgcn_cosf(fr), __builtin_amdgcn_sinf(fr));
    }
    bf16_t* memn = (bf16_t*)(p->ws + WS_MEMN);
    for (int R = gw; R < NBATCH * NMEM; R += NGW) {
        const float* src = (R < 16 * NMEM) ? p->mem_prompt + (size_t)R * DM : p->mem_sample + (size_t)(R - 16 * NMEM) * DM;
        f32x4 v[4]; float ss = 0.f;
#pragma unroll
        for (int j = 0; j < 4; ++j) { v[j] = *(const f32x4*)(src + 4 * (lane + 64 * j)); ss += v[j].x * v[j].x + v[j].y * v[j].y + v[j].z * v[j].z + v[j].w * v[j].w; }
        const float rstd = 1.f / sqrtf(wave_sum(ss) * (1.f / DM) + EPS);
#pragma unroll
        for (int l = 0; l < DEPTH; ++l)
#pragma unroll
            for (int j = 0; j < 4; ++j) { const f32x4 g = *(const f32x4*)(p->g_mem + l * DM + 4 * (lane + 64 * j));
                u32x2 o; o.x = pk2(v[j].x * rstd * g.x, v[j].y * rstd * g.y); o.y = pk2(v[j].z * rstd * g.z, v[j].w * rstd * g.w);
                *(u32x2*)(memn + ((size_t)l * NBATCH * NMEM + R) * DM + 4 * (lane + 64 * j)) = o; }
    }
}

__device__ __forceinline__ const float* x_in_row(PP p, int GR) { return GR < 16 * SEQ ? p->x_prompt + (size_t)GR * DM : p->x_sample + (size_t)(GR - 16 * SEQ) * DM; }

__device__ __forceinline__ void phase_rows_first(PP p, int chunk) {
    int tid_ = threadIdx.x; OPAQUE_V(tid_); const int lane = tid_ & 63, wave = __builtin_amdgcn_readfirstlane(tid_ >> 6);
    bf16_t* H = (bf16_t*)(p->ws + WS_H);
    for (int r = blockIdx.x * NWAVES + wave; r < MC; r += gridDim.x * NWAVES) {
        const float* src = x_in_row(p, chunk * MC + r);
        f32x4 v[4]; float ss = 0.f;
#pragma unroll
        for (int j = 0; j < 4; ++j) { v[j] = *(const f32x4*)(src + 4 * (lane + 64 * j)); ss += v[j].x * v[j].x + v[j].y * v[j].y + v[j].z * v[j].z + v[j].w * v[j].w; }
        const float rstd = 1.f / sqrtf(wave_sum(ss) * (1.f / DM) + EPS);
#pragma unroll
        for (int j = 0; j < 4; ++j) { const f32x4 g = *(const f32x4*)(p->g_mix_pre + 4 * (lane + 64 * j));
            u32x2 o; o.x = pk2(v[j].x * rstd * g.x, v[j].y * rstd * g.y); o.y = pk2(v[j].z * rstd * g.z, v[j].w * rstd * g.w);
            *(u32x2*)(H + (size_t)r * DM + 4 * (lane + 64 * j)) = o; }
    }
}
struct RowBuf { f32x4 x[4]; u32x2 y[4]; };
__device__ __forceinline__ void row_load(RowBuf& b, const bf16_t* yrow, const float* xrow, int lane) {
#pragma unroll
    for (int j = 0; j < 4; ++j) { b.y[j] = __builtin_nontemporal_load((const u32x2*)(yrow + 4 * (lane + 64 * j))); b.x[j] = __builtin_nontemporal_load((const f32x4*)(xrow + 4 * (lane + 64 * j))); }
}
__device__ __forceinline__ void row_process(RowBuf& b, float* dst, bf16_t* hrow, const float* g_post, const float* g_next, bool write_h, int lane) {
    f32x4 y[4]; float ss = 0.f;
#pragma unroll
    for (int j = 0; j < 4; ++j) { y[j].x = bf2f(b.y[j].x & 0xffffu); y[j].y = bf2f(b.y[j].x >> 16); y[j].z = bf2f(b.y[j].y & 0xffffu); y[j].w = bf2f(b.y[j].y >> 16);
        ss += y[j].x * y[j].x + y[j].y * y[j].y + y[j].z * y[j].z + y[j].w * y[j].w; }
    const float ry = 1.f / sqrtf(wave_sum(ss) * (1.f / DM) + EPS);
    float sx = 0.f;
#pragma unroll
    for (int j = 0; j < 4; ++j) { const f32x4 g = *(const f32x4*)(g_post + 4 * (lane + 64 * j)); f32x4 x = b.x[j];
        x.x += y[j].x * ry * g.x; x.y += y[j].y * ry * g.y; x.z += y[j].z * ry * g.z; x.w += y[j].w * ry * g.w;
        __builtin_nontemporal_store(x, (f32x4*)(dst + 4 * (lane + 64 * j))); b.x[j] = x;
        sx += x.x * x.x + x.y * x.y + x.z * x.z + x.w * x.w; }
    if (write_h) {
        const float rx = 1.f / sqrtf(wave_sum(sx) * (1.f / DM) + EPS);
#pragma unroll
        for (int j = 0; j < 4; ++j) { const f32x4 g = *(const f32x4*)(g_next + 4 * (lane + 64 * j)); const f32x4 x = b.x[j];
            u32x2 o; o.x = pk2(x.x * rx * g.x, x.y * rx * g.y); o.y = pk2(x.z * rx * g.z, x.w * rx * g.w);
            *(u32x2*)(hrow + 4 * (lane + 64 * j)) = o; }
    }
}
__device__ __forceinline__ void phase_rows_resid(PP p, int chunk, bool src_is_input, const float* g_post, const float* g_next, bool write_h) {
    int tid_ = threadIdx.x; OPAQUE_V(tid_); const int lane = tid_ & 63, wave = __builtin_amdgcn_readfirstlane(tid_ >> 6);
    bf16_t* H = (bf16_t*)(p->ws + WS_H);
    const bf16_t* Y = (const bf16_t*)(p->ws + WS_Y);
    float* out = p->out;
    const int stride = gridDim.x * NWAVES;
    int r = blockIdx.x * NWAVES + wave;
    if (r >= MC) return;
    RowBuf A, B;
#define ROW_SRC(rr) (src_is_input ? x_in_row(p, chunk * MC + (rr)) : out + (size_t)(chunk * MC + (rr)) * DM)
    row_load(A, Y + (size_t)r * DM, ROW_SRC(r), lane);
    for (;;) {
        const int r1 = r + stride;
        if (r1 < MC) row_load(B, Y + (size_t)r1 * DM, ROW_SRC(r1), lane);
        row_process(A, out + (size_t)(chunk * MC + r) * DM, H + (size_t)r * DM, g_post, g_next, write_h, lane);
        if (r1 >= MC) break;
        const int r2 = r1 + stride;
        if (r2 < MC) row_load(A, Y + (size_t)r2 * DM, ROW_SRC(r2), lane);
        row_process(B, out + (size_t)(chunk * MC + r1) * DM, H + (size_t)r1 * DM, g_post, g_next, write_h, lane);
        if (r2 >= MC) break;
        r = r2;
    }
#undef ROW_SRC
}

__device__ __forceinline__ int pi32(int r) { return (r & 0x13) | ((r & 4) << 1) | ((r & 8) >> 1); }
template <int D> __device__ __forceinline__ size_t kblk_off(int p, int c8) { const int kt = p >> 5, r = pi32(p & 31); return ((size_t)(kt * (D / 16) + (c8 >> 1)) * 64 + (c8 & 1) * 32 + r) * 8; }
template <int D> __device__ __forceinline__ size_t vblk_off(int p, int d) { const int kt = p >> 5, w = p & 31; return ((((size_t)kt * (D / 32) + (d >> 5)) * 2 + (w >> 4)) * 64 + ((w >> 3) & 1) * 32 + (d & 31)) * 8 + (w & 7); }
template <int D> __device__ __forceinline__ void store8_vblk(bf16_t* img, int p, int d0, const f32x4& a, const f32x4& b) {
    const unsigned o0 = pk2(a.x, a.y), o1 = pk2(a.z, a.w), o2 = pk2(b.x, b.y), o3 = pk2(b.z, b.w);
    bf16_t* base = img + vblk_off<D>(p, d0);
    base[0] = (bf16_t)(o0 & 0xffffu); base[8] = (bf16_t)(o0 >> 16); base[16] = (bf16_t)(o1 & 0xffffu); base[24] = (bf16_t)(o1 >> 16);
    base[32] = (bf16_t)(o2 & 0xffffu); base[40] = (bf16_t)(o2 >> 16); base[48] = (bf16_t)(o3 & 0xffffu); base[56] = (bf16_t)(o3 >> 16);
}
__device__ __forceinline__ u32x4 pack8(const f32x4& a, const f32x4& b) { u32x4 o; o.x = pk2(a.x, a.y); o.y = pk2(a.z, a.w); o.z = pk2(b.x, b.y); o.w = pk2(b.z, b.w); return o; }
__device__ __forceinline__ void store8_strided(bf16_t* base, size_t stride, const f32x4& a, const f32x4& b) {
    const u32x4 o = pack8(a, b);
    base[0 * stride] = (bf16_t)(o.x & 0xffffu); base[1 * stride] = (bf16_t)(o.x >> 16); base[2 * stride] = (bf16_t)(o.y & 0xffffu); base[3 * stride] = (bf16_t)(o.y >> 16);
    base[4 * stride] = (bf16_t)(o.z & 0xffffu); base[5 * stride] = (bf16_t)(o.z >> 16); base[6 * stride] = (bf16_t)(o.w & 0xffffu); base[7 * stride] = (bf16_t)(o.w >> 16);
}
struct EpiIn {
    static constexpr bool PERM = true, AFTER_DRAIN = false;
    bf16_t* proj; bf16_t* vta; bf16_t* vtb; bf16_t* kba; bf16_t* kbb; const float* rope;
    __device__ __forceinline__ void operator()(const f32x4 (&acc)[2][2][4][2], const pg8::Unit& u, int wr, int wc, int fr, int fq) const {
        const int row0 = u.pm * 256 + wr * 64 + fr;
#pragma unroll
        for (int bj = 0; bj < 2; ++bj) {
            const int c128 = u.pn * 256 + bj * 128, cb = c128 + wc * 32 + 8 * fq;
            if (c128 >= 3584) {
#pragma unroll
                for (int ai = 0; ai < 2; ++ai)
#pragma unroll
                    for (int m = 0; m < 4; ++m) { const int row = row0 + ai * 128 + m * 16; f32x4 a = acc[ai][bj][m][0], b = acc[ai][bj][m][1];
                        a.x = sigmoidf_(a.x); a.y = sigmoidf_(a.y); a.z = sigmoidf_(a.z); a.w = sigmoidf_(a.w); b.x = sigmoidf_(b.x); b.y = sigmoidf_(b.y); b.z = sigmoidf_(b.z); b.w = sigmoidf_(b.w);
                        __builtin_nontemporal_store(pack8(a, b), (u32x4*)(proj + (size_t)row * INW + cb)); }
            } else if (c128 >= 3072) {
#pragma unroll
                for (int ai = 0; ai < 2; ++ai)
#pragma unroll
                    for (int m = 0; m < 4; ++m) { const int row = row0 + ai * 128 + m * 16; __builtin_nontemporal_store(pack8(acc[ai][bj][m][0], acc[ai][bj][m][1]), (u32x4*)(proj + (size_t)row * INW + cb)); }
            } else if (c128 == 640) {
                const int kvh = (cb - 640) >> 6, d0 = (cb - 640) & 63;
#pragma unroll
                for (int ai = 0; ai < 2; ++ai)
#pragma unroll
                    for (int m = 0; m < 4; ++m) { const int row = row0 + ai * 128 + m * 16, bl = row >> 11, pos = row & 2047;
                        store8_vblk<64>(vta + (size_t)(bl * 2 + kvh) * 64 * SEQ, pos, d0, acc[ai][bj][m][0], acc[ai][bj][m][1]); }
            } else if (c128 >= 2304) {
                const int hb = (cb - 2304) >> 6, d0 = (cb - 2304) & 63, sh = 2 * (hb >> 2);
#pragma unroll
                for (int ai = 0; ai < 2; ++ai)
#pragma unroll
                    for (int m = 0; m < 4; ++m) { const int row = row0 + ai * 128 + m * 16, bl = row >> 11, pos = row & 2047;
                        const int pg = (pos & ((1 << sh) - 1)) * (SEQ >> sh) + (pos >> sh);
                        store8_vblk<64>(vtb + (size_t)(bl * 12 + hb) * 64 * SEQ, pg, d0, acc[ai][bj][m][0], acc[ai][bj][m][1]); }
            } else {
                const bool rp = ((wc & 1) == 0) && (fq < 2);
#pragma unroll
                for (int ai = 0; ai < 2; ++ai)
#pragma unroll
                    for (int m = 0; m < 4; ++m) { const int row = row0 + ai * 128 + m * 16; f32x4 a = acc[ai][bj][m][0], b = acc[ai][bj][m][1];
                        if (rp) { const int pos = row & 2047; const f32x4* t = (const f32x4*)(rope + (size_t)pos * 16 + 8 * fq); const f32x4 t0 = t[0], t1 = t[1];
                            f32x4 a2, b2;
                            a2.x = a.x * t0.x - a.y * t0.y; a2.y = a.y * t0.x + a.x * t0.y; a2.z = a.z * t0.z - a.w * t0.w; a2.w = a.w * t0.z + a.z * t0.w;
                            b2.x = b.x * t1.x - b.y * t1.y; b2.y = b.y * t1.x + b.x * t1.y; b2.z = b.z * t1.z - b.w * t1.w; b2.w = b.w * t1.z + b.z * t1.w;
                            a = a2; b = b2; }
                        if (c128 == 512) {
                            const int bl = row >> 11, pos = row & 2047, kvh = (cb - 512) >> 6, c8 = ((cb - 512) & 63) >> 3;
                            *(u32x4*)(kba + (size_t)(bl * 2 + kvh) * 64 * SEQ + kblk_off<64>(pos, c8)) = pack8(a, b);
                        } else if (c128 >= 1536) {
                            const int bl = row >> 11, pos = row & 2047, hb = (cb - 1536) >> 6, c8 = ((cb - 1536) & 63) >> 3, sh = 2 * (hb >> 2);
                            const int pg = (pos & ((1 << sh) - 1)) * (SEQ >> sh) + (pos >> sh);
                            *(u32x4*)(kbb + (size_t)(bl * 12 + hb) * 64 * SEQ + kblk_off<64>(pg, c8)) = pack8(a, b);
                        } else __builtin_nontemporal_store(pack8(a, b), (u32x4*)(proj + (size_t)row * INW + cb)); }
            }
        }
    }
};
struct EpiMemKV {
    static constexpr bool PERM = true, AFTER_DRAIN = false;
    bf16_t* mk; bf16_t* mvt;
    __device__ __forceinline__ void operator()(const f32x4 (&acc)[2][2][4][2], const pg8::Unit& u, int wr, int wc, int fr, int fq) const {
        const int row0 = u.pm * 256 + wr * 64 + fr;
#pragma unroll
        for (int bj = 0; bj < 2; ++bj) {
            const int c128 = u.pn * 256 + bj * 128, cb = c128 + wc * 32 + 8 * fq;
            if (c128 < 512) {
#pragma unroll
                for (int ai = 0; ai < 2; ++ai)
#pragma unroll
                    for (int m = 0; m < 4; ++m) { const int row = row0 + ai * 128 + m * 16, b = row >> 8, j = row & 255, hc = cb >> 7, c8 = (cb & 127) >> 3;
                        *(u32x4*)(mk + (size_t)(b * 4 + hc) * 128 * NMEM + kblk_off<128>(j, c8)) = pack8(acc[ai][bj][m][0], acc[ai][bj][m][1]); }
            } else {
                const int hc = (cb - 512) >> 7, d0 = (cb - 512) & 127;
#pragma unroll
                for (int ai = 0; ai < 2; ++ai)
#pragma unroll
                    for (int m = 0; m < 4; ++m) { const int row = row0 + ai * 128 + m * 16, b = row >> 8, j = row & 255;
                        store8_vblk<128>(mvt + (size_t)(b * 4 + hc) * 128 * NMEM, j, d0, acc[ai][bj][m][0], acc[ai][bj][m][1]); }
            }
        }
    }
};
struct EpiGate {
    static constexpr bool PERM = true, AFTER_DRAIN = false;
    const bf16_t* gate; bf16_t* mrg; int accum;
    __device__ __forceinline__ void operator()(const f32x4 (&acc)[2][2][4][2], const pg8::Unit& u, int wr, int wc, int fr, int fq) const {
        const int row0 = u.pm * 256 + wr * 64 + fr, cb0 = u.pn * 256 + wc * 32 + 8 * fq;
#pragma unroll
        for (int ai = 0; ai < 2; ++ai) {
            u32x4 g[4][2], o[4][2];
#pragma unroll
            for (int m = 0; m < 4; ++m)
#pragma unroll
                for (int bj = 0; bj < 2; ++bj) g[m][bj] = __builtin_nontemporal_load((const u32x4*)(gate + (size_t)(row0 + ai * 128 + m * 16) * INW + cb0 + bj * 128));
            if (accum) {
#pragma unroll
                for (int m = 0; m < 4; ++m)
#pragma unroll
                    for (int bj = 0; bj < 2; ++bj) o[m][bj] = *(const u32x4*)(mrg + (size_t)(row0 + ai * 128 + m * 16) * DM + cb0 + bj * 128);
            }
#pragma unroll
            for (int m = 0; m < 4; ++m)
#pragma unroll
                for (int bj = 0; bj < 2; ++bj) {
                    const u32x4 gg = g[m][bj];
                    f32x4 a = acc[ai][bj][m][0], b = acc[ai][bj][m][1];
                    a.x *= bf2f(gg.x & 0xffffu); a.y *= bf2f(gg.x >> 16); a.z *= bf2f(gg.y & 0xffffu); a.w *= bf2f(gg.y >> 16);
                    b.x *= bf2f(gg.z & 0xffffu); b.y *= bf2f(gg.z >> 16); b.z *= bf2f(gg.w & 0xffffu); b.w *= bf2f(gg.w >> 16);
                    if (accum) { const u32x4 oo = o[m][bj];
                        a.x += bf2f(oo.x & 0xffffu); a.y += bf2f(oo.x >> 16); a.z += bf2f(oo.y & 0xffffu); a.w += bf2f(oo.y >> 16);
                        b.x += bf2f(oo.z & 0xffffu); b.y += bf2f(oo.z >> 16); b.z += bf2f(oo.w & 0xffffu); b.w += bf2f(oo.w >> 16); }
                    *(u32x4*)(mrg + (size_t)(row0 + ai * 128 + m * 16) * DM + cb0 + bj * 128) = pack8(a, b);
                }
        }
    }
};
struct EpiY {
    static constexpr bool PERM = true, AFTER_DRAIN = false;
    bf16_t* Y;
    __device__ __forceinline__ void operator()(const f32x4 (&acc)[2][2][4][2], const pg8::Unit& u, int wr, int wc, int fr, int fq) const {
        const int row0 = u.pm * 256 + wr * 64 + fr;
#pragma unroll
        for (int ai = 0; ai < 2; ++ai)
#pragma unroll
            for (int m = 0; m < 4; ++m)
#pragma unroll
                for (int bj = 0; bj < 2; ++bj)
                    *(u32x4*)(Y + (size_t)(row0 + ai * 128 + m * 16) * DM + u.pn * 256 + bj * 128 + wc * 32 + 8 * fq) = pack8(acc[ai][bj][m][0], acc[ai][bj][m][1]);
    }
};
struct EpiSwiGLU {
    static constexpr bool PERM = true, AFTER_DRAIN = false;
    bf16_t* act;
    __device__ __forceinline__ void operator()(const f32x4 (&acc)[2][2][4][2], const pg8::Unit& u, int wr, int wc, int fr, int fq) const {
        const int row0 = u.pm * 256 + wr * 64 + fr;
#pragma unroll
        for (int ai = 0; ai < 2; ++ai)
#pragma unroll
            for (int m = 0; m < 4; ++m)
#pragma unroll
                for (int bj = 0; bj < 2; ++bj) { const int cb = u.pn * 256 + bj * 128 + wc * 32 + 8 * fq; const f32x4 g = acc[ai][bj][m][0], v = acc[ai][bj][m][1];
                    u32x2 o; o.x = pk2(g.x * sigmoidf_(g.x) * v.x, g.y * sigmoidf_(g.y) * v.y); o.y = pk2(g.z * sigmoidf_(g.z) * v.z, g.w * sigmoidf_(g.w) * v.w);
                    *(u32x2*)(act + (size_t)(row0 + ai * 128 + m * 16) * FFH + (cb >> 1)) = o; }
    }
};
#ifndef GATE_FAST
#define GATE_FAST true
#endif
template <class Epi, bool FAST = true>
__device__ __forceinline__ void run_gemm(LAS unsigned char* lds, const bf16_t* A, const bf16_t* Bt, int M, int N, int K, const Epi& E, int crot) {
    pg8::Gemm g; g.A = A; g.Bt = Bt; g.M = M; g.N = N; g.K = K;
    pg8::StaticOrder S; S.init(M, N, (int)gridDim.x, (int)((blockIdx.x + crot) % gridDim.x));
    pg8::gemm_phase<Epi, pg8::StaticOrder, FAST, FAST>(lds, g, S, E);
}

struct AttnTask {
    const bf16_t* q; long qstride;
    const bf16_t* kb; const bf16_t* vb;
    bf16_t* o; long ostride;
    float* lse; long lsestride;
    int m0, L, W;
    float m_init, l_init, scale2;
};
template <int D>
__device__ __forceinline__ void attn_load_k(bf16x8 (&kf)[D / 16], const AttnTask& t, int k0, int lane) {
    const bf16_t* kp = t.kb + ((size_t)(k0 >> 5) * (D / 16) * 64 + lane) * 8;
#pragma unroll
    for (int kk = 0; kk < D / 16; ++kk) kf[kk] = *(const bf16x8*)(kp + kk * 512);
}
template <int D>
__device__ __forceinline__ void attn_load_v(bf16x8 (&vf)[D / 32][2], const AttnTask& t, int k0, int lane) {
    const bf16_t* vp = t.vb + ((size_t)(k0 >> 5) * (D / 32) * 128 + lane) * 8;
#pragma unroll
    for (int db = 0; db < D / 32; ++db)
#pragma unroll
        for (int s = 0; s < 2; ++s) vf[db][s] = *(const bf16x8*)(vp + (db * 2 + s) * 512);
}
__device__ __forceinline__ float xhalf_max(float v) { const auto r = __builtin_amdgcn_permlane32_swap(__float_as_uint(v), __float_as_uint(v), false, false); return fmaxf(__uint_as_float(r[0]), __uint_as_float(r[1])); }
__device__ __forceinline__ float xhalf_sum(float v) { const auto r = __builtin_amdgcn_permlane32_swap(__float_as_uint(v), __float_as_uint(v), false, false); return __uint_as_float(r[0]) + __uint_as_float(r[1]); }
template <int D, bool MASK>
__device__ __forceinline__ void attn_tile(const bf16x8 (&qf)[D / 16], const bf16x8 (&kf)[D / 16], const bf16x8 (&vf)[D / 32][2], f32x16 (&o)[D / 32], float& mrun, float& lrun,
                                          const AttnTask& t, int k0, int mq, int qi, int h) {
    f32x16 sc;
#pragma unroll
    for (int i = 0; i < 16; ++i) sc[i] = 0.f;
#pragma unroll
    for (int kk = 0; kk < D / 16; ++kk) sc = __builtin_amdgcn_mfma_f32_32x32x16_bf16(kf[kk], qf[kk], sc, 0, 0, 0);
    if (MASK) {
        if (k0 == mq - t.W || k0 == mq + t.W) {
#pragma unroll
            for (int i = 0; i < 16; ++i) { const int dlt = k0 + 16 * (i >> 3) + 8 * h + (i & 7) - qi; sc[i] = (dlt <= t.W && dlt >= -t.W) ? sc[i] : -1e30f; }
        }
    }
    float mt = sc[0];
#pragma unroll
    for (int i = 1; i < 16; ++i) mt = fmaxf(mt, sc[i]);
    mt = xhalf_max(mt) * t.scale2;
    const float mn = fmaxf(mrun, mt), alpha = fexp2(mrun - mn);
    float ps = 0.f;
#pragma unroll
    for (int i = 0; i < 16; ++i) { sc[i] = fexp2(__builtin_fmaf(sc[i], t.scale2, -mn)); ps += sc[i]; }
    ps = xhalf_sum(ps);
    lrun = lrun * alpha + ps; mrun = mn;
#pragma unroll
    for (int db = 0; db < D / 32; ++db)
#pragma unroll
        for (int i = 0; i < 16; ++i) o[db][i] *= alpha;
    bf16x8 pf[2];
#pragma unroll
    for (int s = 0; s < 2; ++s) { u32x4 w; w.x = pk2(sc[8 * s + 0], sc[8 * s + 1]); w.y = pk2(sc[8 * s + 2], sc[8 * s + 3]); w.z = pk2(sc[8 * s + 4], sc[8 * s + 5]); w.w = pk2(sc[8 * s + 6], sc[8 * s + 7]);
        pf[s] = __builtin_bit_cast(bf16x8, w); }
#pragma unroll
    for (int db = 0; db < D / 32; ++db)
#pragma unroll
        for (int s = 0; s < 2; ++s) o[db] = __builtin_amdgcn_mfma_f32_32x32x16_bf16(vf[db][s], pf[s], o[db], 0, 0, 0);
}
template <int D, bool MASK, bool PFV, int NQ>
__device__ __forceinline__ void attn_wave(const AttnTask& t, LAS unsigned char* scr, int lane) {
    const int r = lane & 31, h = lane >> 5;
    bf16x8 qf[NQ][D / 16];
#pragma unroll
    for (int q = 0; q < NQ; ++q) { const bf16_t* qp = t.q + (long)(t.m0 + 32 * q + r) * t.qstride + 8 * h;
#pragma unroll
        for (int kk = 0; kk < D / 16; ++kk) qf[q][kk] = *(const bf16x8*)(qp + 16 * kk); }
    f32x16 o[NQ][D / 32];
    float mrun[NQ], lrun[NQ];
#pragma unroll
    for (int q = 0; q < NQ; ++q) { mrun[q] = t.m_init; lrun[q] = t.l_init;
#pragma unroll
        for (int db = 0; db < D / 32; ++db)
#pragma unroll
            for (int i = 0; i < 16; ++i) o[q][db][i] = 0.f; }
    int klo = 0, khi = t.L;
    if (MASK) { klo = t.m0 - t.W; if (klo < 0) klo = 0; khi = t.m0 + 32 * NQ + t.W; if (khi > t.L) khi = t.L; }
    bf16x8 ka[D / 16], kb[D / 16], va[D / 32][2], vb[D / 32][2];
    attn_load_k<D>(ka, t, klo, lane);
    attn_load_v<D>(va, t, klo, lane);
#define ATT_TILES(KF, VF, K0) do { _Pragma("unroll") for (int q = 0; q < NQ; ++q) { const int mq = t.m0 + 32 * q; \
        if (!MASK || NQ == 1 || ((K0) >= mq - t.W && (K0) <= mq + t.W)) attn_tile<D, MASK>(qf[q], KF, VF, o[q], mrun[q], lrun[q], t, (K0), mq, mq + r, h); } } while (0)
    for (int k0 = klo; k0 < khi; k0 += 64) {
        const int k1 = k0 + 32, k2 = (k0 + 64 < khi) ? k0 + 64 : klo;
        const bool has1 = k1 < khi;
        attn_load_k<D>(kb, t, has1 ? k1 : klo, lane);
        if (PFV) attn_load_v<D>(vb, t, has1 ? k1 : klo, lane);
        __builtin_amdgcn_sched_barrier(0);
        ATT_TILES(ka, va, k0);
        __builtin_amdgcn_sched_barrier(0);
        if (!has1) break;
        if (!PFV) attn_load_v<D>(vb, t, k1, lane);
        attn_load_k<D>(ka, t, k2, lane);
        if (PFV) attn_load_v<D>(va, t, k2, lane);
        __builtin_amdgcn_sched_barrier(0);
        ATT_TILES(kb, vb, k1);
        __builtin_amdgcn_sched_barrier(0);
        if (!PFV) attn_load_v<D>(va, t, k2, lane);
    }
#undef ATT_TILES
#pragma unroll
    for (int q = 0; q < NQ; ++q) {
        const int qi = t.m0 + 32 * q + r;
        const float inv = 1.f / lrun[q];
        constexpr int RS = 2 * D + 16;
#pragma unroll
        for (int db = 0; db < D / 32; ++db)
#pragma unroll
            for (int g = 0; g < 4; ++g) { u32x2 w; w.x = pk2(o[q][db][4 * g + 0] * inv, o[q][db][4 * g + 1] * inv); w.y = pk2(o[q][db][4 * g + 2] * inv, o[q][db][4 * g + 3] * inv);
                *(LAS u32x2*)(scr + r * RS + (32 * db + 8 * g + 4 * h) * 2) = w; }
        LDS_WAIT();
        constexpr int CPR = D / 8, RPI = 64 / CPR;
#pragma unroll
        for (int it = 0; it < 32 / RPI; ++it) { const int row = it * RPI + lane / CPR, ch = lane % CPR;
            const u32x4 v = *(const LAS u32x4*)(scr + row * RS + ch * 16);
            *(u32x4*)(t.o + (long)(t.m0 + 32 * q + row) * t.ostride + ch * 8) = v; }
        LDS_WAIT();
        if (t.lse != nullptr && h == 0) t.lse[(long)qi * t.lsestride] = (mrun[q] + __builtin_amdgcn_logf(lrun[q])) * LN2;
    }
}

__device__ __forceinline__ void attn_wave_mem_lds(const AttnTask& t, LAS unsigned char* lds, int lane) {
    constexpr int D = 128;
    const int r = lane & 31, h = lane >> 5;
    bf16x8 qf[D / 16];
    const bf16_t* qp = t.q + (long)(t.m0 + r) * t.qstride + 8 * h;
#pragma unroll
    for (int kk = 0; kk < D / 16; ++kk) qf[kk] = *(const bf16x8*)(qp + 16 * kk);
    f32x16 o[D / 32];
#pragma unroll
    for (int db = 0; db < D / 32; ++db)
#pragma unroll
        for (int i = 0; i < 16; ++i) o[db][i] = 0.f;
    float mrun = t.m_init, lrun = t.l_init;
    const int qi = t.m0 + r;
    for (int kt = 0; kt < NMEM / 32; ++kt) {
        bf16x8 kf[D / 16], vf[D / 32][2];
#pragma unroll
        for (int kk = 0; kk < D / 16; ++kk) kf[kk] = *(const LAS bf16x8*)(lds + ((kt * (D / 16) + kk) * 64 + lane) * 16);
#pragma unroll
        for (int db = 0; db < D / 32; ++db)
#pragma unroll
            for (int s = 0; s < 2; ++s) vf[db][s] = *(const LAS bf16x8*)(lds + 65536 + (((kt * (D / 32) + db) * 2 + s) * 64 + lane) * 16);
        attn_tile<D, false>(qf, kf, vf, o, mrun, lrun, t, kt * 32, t.m0, qi, h);
    }
    const float inv = 1.f / lrun;
    bf16_t* op = t.o + (long)qi * t.ostride + 4 * h;
#pragma unroll
    for (int db = 0; db < D / 32; ++db)
#pragma unroll
        for (int g = 0; g < 4; ++g) { u32x2 w; w.x = pk2(o[db][4 * g + 0] * inv, o[db][4 * g + 1] * inv); w.y = pk2(o[db][4 * g + 2] * inv, o[db][4 * g + 3] * inv);
            *(u32x2*)(op + 32 * db + 8 * g) = w; }
}

__device__ __forceinline__ void attn_wave_win_lds(const AttnTask& t, LAS unsigned char* lds, int kt0, int lane) {
    constexpr int D = 64;
    const int r = lane & 31, h = lane >> 5;
    bf16x8 qf[D / 16];
    const bf16_t* qp = t.q + (long)(t.m0 + r) * t.qstride + 8 * h;
#pragma unroll
    for (int kk = 0; kk < D / 16; ++kk) qf[kk] = *(const bf16x8*)(qp + 16 * kk);
    f32x16 o[D / 32];
#pragma unroll
    for (int db = 0; db < D / 32; ++db)
#pragma unroll
        for (int i = 0; i < 16; ++i) o[db][i] = 0.f;
    float mrun = t.m_init, lrun = t.l_init;
    const int qi = t.m0 + r;
    int kta = (t.m0 - t.W) >> 5, ktb = (t.m0 + t.W) >> 5;
    if (kta < 0) kta = 0;
    if (ktb > t.L / 32 - 1) ktb = t.L / 32 - 1;
    for (int kt = kta; kt <= ktb; ++kt) {
        const int slot = kt - kt0;
        bf16x8 kf[D / 16], vf[D / 32][2];
#pragma unroll
        for (int kk = 0; kk < D / 16; ++kk) kf[kk] = *(const LAS bf16x8*)(lds + ((slot * (D / 16) + kk) * 64 + lane) * 16);
#pragma unroll
        for (int db = 0; db < D / 32; ++db)
#pragma unroll
            for (int s = 0; s < 2; ++s) vf[db][s] = *(const LAS bf16x8*)(lds + 65536 + (((slot * (D / 32) + db) * 2 + s) * 64 + lane) * 16);
        attn_tile<D, true>(qf, kf, vf, o, mrun, lrun, t, kt * 32, t.m0, qi, h);
    }
    const float inv = 1.f / lrun;
    bf16_t* op = t.o + (long)qi * t.ostride + 4 * h;
#pragma unroll
    for (int db = 0; db < D / 32; ++db)
#pragma unroll
        for (int g = 0; g < 4; ++g) { u32x2 w; w.x = pk2(o[db][4 * g + 0] * inv, o[db][4 * g + 1] * inv); w.y = pk2(o[db][4 * g + 2] * inv, o[db][4 * g + 3] * inv);
            *(u32x2*)(op + 32 * db + 8 * g) = w; }
}

__device__ __forceinline__ void phase_attention(PP p, LAS unsigned char* lds, int chunk, int layer) {
    int tid_ = threadIdx.x; OPAQUE_V(tid_); const int tid = tid_, lane = tid & 63, wave = __builtin_amdgcn_readfirstlane(tid >> 6);
    const bf16_t* proj = (const bf16_t*)(p->ws + WS_PROJ);
    const bf16_t* vta = (const bf16_t*)(p->ws + WS_VTA);
    const bf16_t* vtb = (const bf16_t*)(p->ws + WS_VTB);
    const bf16_t* kba = (const bf16_t*)(p->ws + WS_KBA); const bf16_t* kbb = (const bf16_t*)(p->ws + WS_KBB);
    bf16_t* oa = (bf16_t*)(p->ws + WS_OA); bf16_t* ob = (bf16_t*)(p->ws + WS_OB); bf16_t* oc = (bf16_t*)(p->ws + WS_OC);
    bf16_t* og = (bf16_t*)(p->ws + WS_OG); float* lseb = (float*)(p->ws + WS_LSE);
    const bf16_t* memk = (const bf16_t*)(p->ws + WS_MEMK) + (size_t)layer * NBATCH * NMEM * 512;
    const bf16_t* memvt = (const bf16_t*)(p->ws + WS_MEMVT) + (size_t)layer * NBATCH * NMEM * 512;
    constexpr int NT_B = CB * 4 * 4, NT_A = CB * 8 * 8, NT_C = CB * 4 * 8;
    for (int task = blockIdx.x; task < NT_B + NT_A + NT_C; task += gridDim.x) {
        if (task < NT_B) {
            const int bl = task >> 4, hh = (task >> 2) & 3, sp = task & 3;
            for (int wt = wave; wt < 32; wt += NWAVES) {
                const int g = wt < 8 ? 0 : (wt < 16 ? 1 : 2), tq = wt < 16 ? (wt & 7) : (wt - 16), sh = 2 * g, dil = 1 << sh, L = SEQ >> sh, hb = 4 * g + hh;
                int c, m0;
                if (g == 0) { c = 0; m0 = sp * 512 + 64 * tq; } else if (g == 1) { c = tq >> 1; m0 = sp * 128 + 64 * (tq & 1); } else { c = tq; m0 = sp * 32; }
                AttnTask t;
                const size_t rowb = (size_t)bl * SEQ + c;
                t.q = proj + rowb * INW + 768 + hb * 64; t.qstride = (long)dil * INW;
                t.kb = kbb + (size_t)(bl * 12 + hb) * 64 * SEQ + (size_t)c * L * 64; t.vb = vtb + (size_t)(bl * 12 + hb) * 64 * SEQ + (size_t)c * L * 64;
                t.o = og + (size_t)g * MC * 256 + rowb * 256 + hh * 64; t.ostride = (long)dil * 256;
                t.lse = lseb + (size_t)g * MC * 4 + rowb * 4 + hh; t.lsestride = (long)dil * 4;
                t.m0 = m0; t.L = L; t.W = 64; t.m_init = -1e30f; t.l_init = 0.f; t.scale2 = 0.125f * LOG2E;
                if (g == 2) attn_wave<64, true, true, 1>(t, lds + wave * 8192, lane); else attn_wave<64, true, true, 2>(t, lds + wave * 8192, lane);
            }
            __syncthreads();
            {
                const size_t row = (size_t)bl * SEQ + sp * 512 + tid;
                const float l0 = lseb[row * 4 + hh], l1 = lseb[(size_t)MC * 4 + row * 4 + hh], l2 = lseb[(size_t)2 * MC * 4 + row * 4 + hh];
                const float mx = fmaxf(l0, fmaxf(l1, l2));
                float a0 = fexp2((l0 - mx) * LOG2E), a1 = fexp2((l1 - mx) * LOG2E), a2 = fexp2((l2 - mx) * LOG2E);
                const float is = 1.f / (a0 + a1 + a2); a0 *= is; a1 *= is; a2 *= is;
                const bf16_t* s0 = og + row * 256 + hh * 64; const bf16_t* s1 = s0 + (size_t)MC * 256; const bf16_t* s2 = s1 + (size_t)MC * 256;
                bf16_t* dp = ob + row * 256 + hh * 64;
#pragma unroll
                for (int j = 0; j < 8; ++j) { const u32x4 x0 = *(const u32x4*)(s0 + 8 * j), x1 = *(const u32x4*)(s1 + 8 * j), x2 = *(const u32x4*)(s2 + 8 * j);
                    u32x4 w;
                    w.x = pk2(a0 * bf2f(x0.x & 0xffffu) + a1 * bf2f(x1.x & 0xffffu) + a2 * bf2f(x2.x & 0xffffu), a0 * bf2f(x0.x >> 16) + a1 * bf2f(x1.x >> 16) + a2 * bf2f(x2.x >> 16));
                    w.y = pk2(a0 * bf2f(x0.y & 0xffffu) + a1 * bf2f(x1.y & 0xffffu) + a2 * bf2f(x2.y & 0xffffu), a0 * bf2f(x0.y >> 16) + a1 * bf2f(x1.y >> 16) + a2 * bf2f(x2.y >> 16));
                    w.z = pk2(a0 * bf2f(x0.z & 0xffffu) + a1 * bf2f(x1.z & 0xffffu) + a2 * bf2f(x2.z & 0xffffu), a0 * bf2f(x0.z >> 16) + a1 * bf2f(x1.z >> 16) + a2 * bf2f(x2.z >> 16));
                    w.w = pk2(a0 * bf2f(x0.w & 0xffffu) + a1 * bf2f(x1.w & 0xffffu) + a2 * bf2f(x2.w & 0xffffu), a0 * bf2f(x0.w >> 16) + a1 * bf2f(x1.w >> 16) + a2 * bf2f(x2.w >> 16));
                    *(u32x4*)(dp + 8 * j) = w; }
            }
            __syncthreads();
        } else
        if (task < NT_B + NT_A) {
            const int ta = task - NT_B, bl = ta >> 6, ha = (ta >> 3) & 7, sp = ta & 7;
            AttnTask t;
            const size_t rowb = (size_t)bl * SEQ;
            t.q = proj + rowb * INW + ha * 64; t.qstride = INW;
            t.kb = kba + (size_t)(bl * 2 + (ha >> 2)) * 64 * SEQ; t.vb = vta + (size_t)(bl * 2 + (ha >> 2)) * 64 * SEQ;
            t.o = oa + rowb * 512 + ha * 64; t.ostride = 512; t.lse = nullptr; t.lsestride = 0;
            t.m0 = sp * 256 + 32 * wave; t.L = SEQ; t.W = 128; t.m_init = p->sink_a[layer * 8 + ha] * LOG2E; t.l_init = 1.f; t.scale2 = 0.125f * LOG2E;
            const int kt0 = 8 * sp - 4;
            {
                const char* ks = (const char*)t.kb + (long)kt0 * 4096; const char* vs = (const char*)t.vb + (long)kt0 * 4096;
                u32x4 tmp[16];
#pragma unroll
                for (int i = 0; i < 8; ++i) { const int c = tid + 512 * i, kt = kt0 + (c >> 8); const bool ok = kt >= 0 && kt < SEQ / 32;
                    tmp[i] = ok ? *(const u32x4*)(ks + (long)c * 16) : (u32x4){0u, 0u, 0u, 0u}; tmp[8 + i] = ok ? *(const u32x4*)(vs + (long)c * 16) : (u32x4){0u, 0u, 0u, 0u}; }
#pragma unroll
                for (int i = 0; i < 8; ++i) { *(LAS u32x4*)(lds + (tid + 512 * i) * 16) = tmp[i]; *(LAS u32x4*)(lds + 65536 + (tid + 512 * i) * 16) = tmp[8 + i]; }
            }
            __syncthreads();
            attn_wave_win_lds(t, lds, kt0, lane);
            __syncthreads();
        } else {
            const int tc = task - NT_B - NT_A, bl = tc >> 5, hc = (tc >> 3) & 3, sp = tc & 7, bg = chunk * CB + bl;
            AttnTask t;
            const size_t rowb = (size_t)bl * SEQ;
            t.q = proj + rowb * INW + 3072 + hc * 128; t.qstride = INW;
            t.kb = memk + (size_t)(bg * 4 + hc) * 128 * NMEM; t.vb = memvt + (size_t)(bg * 4 + hc) * 128 * NMEM;
            t.o = oc + rowb * 512 + hc * 128; t.ostride = 512; t.lse = nullptr; t.lsestride = 0;
            t.m0 = sp * 256 + 32 * wave; t.L = NMEM; t.W = 0; t.m_init = -1e30f; t.l_init = 0.f; t.scale2 = 0.08838834764831845f * LOG2E;
            {
                const u32x4* ks = (const u32x4*)t.kb; const u32x4* vs = (const u32x4*)t.vb;
                u32x4 tmp[16];
#pragma unroll
                for (int i = 0; i < 8; ++i) { tmp[i] = ks[tid + 512 * i]; tmp[8 + i] = vs[tid + 512 * i]; }
#pragma unroll
                for (int i = 0; i < 8; ++i) { *(LAS u32x4*)(lds + (tid + 512 * i) * 16) = tmp[i]; *(LAS u32x4*)(lds + 65536 + (tid + 512 * i) * 16) = tmp[8 + i]; }
            }
            __syncthreads();
            attn_wave_mem_lds(t, lds, lane);
            __syncthreads();
        }
    }
}

#define XB_TMO      128
#define XB_XCNT(j)  (256  + 64 * (j))
#define XB_XSUB(j)  (1280 + 64 * (j))
#define XB_XGEN(j)  (2304 + 64 * (j))
#define XB_TOP      3328
#define XB_TOPGEN   3392
#define XCD_BAR_WORDS 3456
#define XB_SPIN_CAP (1u << 18)

__device__ __forceinline__ unsigned xb_ld(unsigned* p)              { return __hip_atomic_load(p, __ATOMIC_RELAXED, __HIP_MEMORY_SCOPE_AGENT); }
__device__ __forceinline__ unsigned xb_add(unsigned* p, unsigned v) { return __hip_atomic_fetch_add(p, v, __ATOMIC_RELAXED, __HIP_MEMORY_SCOPE_AGENT); }
__device__ __forceinline__ unsigned xb_xcc_id() { return (unsigned)__builtin_amdgcn_s_getreg((3 << 11) | 20) & 0xFu; }
#define XB_SPIN(cond, bar) do { unsigned _sp = 0; while (cond) { __builtin_amdgcn_s_sleep(1); \
    if ((++_sp & 255u) == 0u) { if (xb_ld(&(bar)[XB_TMO])) break; if (_sp > XB_SPIN_CAP) { atomicAdd(&(bar)[XB_TMO], 1u); break; } } } } while (0)
struct XcdBarrier {
    unsigned* bar; unsigned x;
    volatile LAS unsigned* st;
};

__device__ __forceinline__ XcdBarrier xcd_barrier_post(unsigned* bar, volatile LAS unsigned* st) {
    XcdBarrier b; b.bar = bar; b.x = xb_xcc_id(); b.st = st;
    if (threadIdx.x == 0) (void)xb_add(&bar[XB_XCNT(b.x)], 1u);
    return b;
}
__device__ __forceinline__ void xcd_barrier_complete(unsigned* bar, unsigned x, unsigned& nloc, unsigned& nx) {
    const unsigned G = gridDim.x * gridDim.y * gridDim.z;
    unsigned sum, cnt, mine, sp = 0u;
    for (;;) {
        sum = 0u; cnt = 0u; mine = 0u;
#pragma unroll
        for (unsigned j = 0; j < 16; ++j) { const unsigned c = xb_ld(&bar[XB_XCNT(j)]); sum += c; cnt += (c > 0u) ? 1u : 0u; mine = (j == x) ? c : mine; }
        if (sum == G) break;
        __builtin_amdgcn_s_sleep(1);
        if ((++sp & 255u) == 0u) { if (xb_ld(&bar[XB_TMO])) break; if (sp > XB_SPIN_CAP) { atomicAdd(&bar[XB_TMO], 1u); break; } }
    }
    nloc = mine > 0u ? mine : 1u; nx = cnt > 0u ? cnt : 1u;
}

__device__ __forceinline__ void xcd_barrier(const XcdBarrier& b) {
    asm volatile("s_waitcnt vmcnt(0)" ::: "memory");
    __syncthreads();
    if (threadIdx.x == 0) {
        unsigned* bar = b.bar;
        __builtin_amdgcn_s_waitcnt(0);
        unsigned nloc = b.st[0], nx = b.st[1];
        if (nloc == 0u) { xcd_barrier_complete(bar, b.x, nloc, nx); b.st[0] = nloc; b.st[1] = nx; }
        const unsigned old = xb_add(&bar[XB_XSUB(b.x)], 1u);
        const unsigned gen = old / nloc;
        if (old + 1u == (gen + 1u) * nloc) {
            __builtin_amdgcn_fence(__ATOMIC_RELEASE, "agent");
            asm volatile("s_waitcnt vmcnt(0)" ::: "memory");
            const unsigned og = xb_add(&bar[XB_TOP], 1u);
            const unsigned tg = og / nx;
            if (og + 1u == (tg + 1u) * nx) xb_add(&bar[XB_TOPGEN], 1u);
            else XB_SPIN(xb_ld(&bar[XB_TOPGEN]) == tg, bar);
            __builtin_amdgcn_fence(__ATOMIC_ACQUIRE, "agent");
            xb_add(&bar[XB_XGEN(b.x)], 1u);
            asm volatile("s_waitcnt vmcnt(0)" ::: "memory");
        } else {
            XB_SPIN(xb_ld(&bar[XB_XGEN(b.x)]) == gen, bar);
            __builtin_amdgcn_fence(__ATOMIC_ACQUIRE, "agent");
            asm volatile("s_waitcnt vmcnt(0)" ::: "memory");
        }
    }
    __syncthreads();
}


constexpr int STEPS_PER_CHUNK = 1 + DEPTH * 8, N_STEPS = 2 + NCHUNK * STEPS_PER_CHUNK;
__device__ __forceinline__ void run_step(PP p, LAS unsigned char* lds, int s) {
    bf16_t* WT = (bf16_t*)(p->ws + WS_WT);
    if (s == 0) { phase_prologue_a(p, lds); return; }
    if (s == 1) {
        for (int l = 0; l < DEPTH; ++l) { EpiMemKV E; E.mk = (bf16_t*)(p->ws + WS_MEMK) + (size_t)l * NBATCH * NMEM * 512; E.mvt = (bf16_t*)(p->ws + WS_MEMVT) + (size_t)l * NBATCH * NMEM * 512;
            run_gemm(lds, (const bf16_t*)(p->ws + WS_MEMN) + (size_t)l * NBATCH * NMEM * DM, WT + (size_t)l * WL + WO_MKV, NBATCH * NMEM, 1024, DM, E, 64 * l); }
        return;
    }
    const int s2 = s - 2, chunk = s2 / STEPS_PER_CHUNK, r = s2 % STEPS_PER_CHUNK;
    if (r == 0) { phase_rows_first(p, chunk); return; }
    const int l = (r - 1) >> 3, ph = (r - 1) & 7;
    const bf16_t* wl = WT + (size_t)l * WL;
    bf16_t* H = (bf16_t*)(p->ws + WS_H); bf16_t* proj = (bf16_t*)(p->ws + WS_PROJ); bf16_t* mrg = (bf16_t*)(p->ws + WS_MRG);
    switch (ph) {
    case 0: { EpiIn E; E.proj = proj; E.vta = (bf16_t*)(p->ws + WS_VTA); E.vtb = (bf16_t*)(p->ws + WS_VTB); E.kba = (bf16_t*)(p->ws + WS_KBA); E.kbb = (bf16_t*)(p->ws + WS_KBB); E.rope = (const float*)(p->ws + WS_ROPE);
        run_gemm(lds, H, wl + WO_IN, MC, INW, DM, E, 0); } break;
    case 1: phase_attention(p, lds, chunk, l); break;
    case 2: {
        EpiGate E; E.mrg = mrg;
        E.gate = proj + 3584; E.accum = 0; run_gemm<EpiGate, GATE_FAST>(lds, (const bf16_t*)(p->ws + WS_OA), wl + WO_OA, MC, DM, 512, E, 0);
        E.gate = proj + 3584 + 1024; E.accum = 1; run_gemm<EpiGate, GATE_FAST>(lds, (const bf16_t*)(p->ws + WS_OB), wl + WO_OB, MC, DM, 256, E, 0);
        E.gate = proj + 3584 + 2048; E.accum = 1; run_gemm<EpiGate, GATE_FAST>(lds, (const bf16_t*)(p->ws + WS_OC), wl + WO_OC, MC, DM, 512, E, 0);
        } break;
    case 3: { EpiY E; E.Y = (bf16_t*)(p->ws + WS_Y); run_gemm(lds, mrg, wl + WO_OUT, MC, DM, DM, E, 0); } break;
    case 4: phase_rows_resid(p, chunk, l == 0, p->g_mix_post + l * DM, p->g_ffn_pre + l * DM, true); break;
    case 5: { EpiSwiGLU E; E.act = (bf16_t*)(p->ws + WS_ACT); run_gemm(lds, H, wl + WO_FIN, MC, 2 * FFH, DM, E, 0); } break;
    case 6: { EpiY E; E.Y = (bf16_t*)(p->ws + WS_Y); run_gemm(lds, (const bf16_t*)(p->ws + WS_ACT), wl + WO_FOUT, MC, DM, FFH, E, 0); } break;
    default: phase_rows_resid(p, chunk, false, p->g_ffn_post + l * DM, p->g_mix_pre + (l < DEPTH - 1 ? l + 1 : l) * DM, l < DEPTH - 1); break;
    }
}

__global__ void __launch_bounds__(NTHREADS, 2) fwd_megakernel(Params p) {
    extern __shared__ __attribute__((aligned(16))) unsigned char lds_raw[];
    LAS unsigned char* lds = (LAS unsigned char*)lds_raw;
    cg::grid_group grid = cg::this_grid();
    PP pp = (PP)__builtin_amdgcn_kernarg_segment_ptr();
    const int s_hi = pp->s_hi;
    __shared__ uint4 xb_words;
    if (threadIdx.x == 0) xb_words = make_uint4(0u, 0u, 0u, 0u);
    __syncthreads();
    const XcdBarrier xbar = xcd_barrier_post((unsigned*)(pp->ws + WS_BAR), (volatile LAS unsigned*)&xb_words);
    const int s_lo = pp->s_lo;
    for (int s = s_lo; s < s_hi; ++s) {
        PP q = pp; OPAQUE_S(q);
        run_step(q, lds, s);
        if (s + 1 < s_hi) { if (s == s_lo) grid.sync(); else xcd_barrier(xbar); }
    }
}

extern "C" void kernel_launch(void* const* d_in, const int* in_sizes, int n_in, void* d_out, int out_size, void* d_ws, size_t ws_size, hipStream_t stream) {
    static int grid_blocks = 0;
    if (grid_blocks == 0) {
        if (n_in != 18 || out_size != NBATCH * SEQ * DM || ws_size < WS_END) { fprintf(stderr, "kernel_launch: unexpected shapes / workspace (n_in %d out %d ws %zu need %zu)\n", n_in, out_size, ws_size, (size_t)WS_END); grid_blocks = -1; return; }
        int dev = 0, cus = 0, per_cu = 0;
        hipGetDevice(&dev);
        hipDeviceGetAttribute(&cus, hipDeviceAttributeMultiprocessorCount, dev);
        if (hipFuncSetAttribute((const void*)fwd_megakernel, hipFuncAttributeMaxDynamicSharedMemorySize, LDS_BYTES) != hipSuccess) { fprintf(stderr, "kernel_launch: hipFuncSetAttribute failed\n"); grid_blocks = -1; return; }
        hipOccupancyMaxActiveBlocksPerMultiprocessor(&per_cu, (const void*)fwd_megakernel, NTHREADS, LDS_BYTES);
        if (per_cu < 1) { fprintf(stderr, "kernel_launch: occupancy query says %d blocks per CU\n", per_cu); per_cu = 1; }
        (void)hipGetLastError();
        grid_blocks = cus * 1;
    }
    if (grid_blocks < 0) return;
    if (hipMemsetAsync((char*)d_ws + WS_BAR, 0, 16384, stream) != hipSuccess) { fprintf(stderr, "kernel_launch: hipMemsetAsync failed\n"); return; }
    Params p{};
    p.x_prompt = (const float*)d_in[0]; p.x_sample = (const float*)d_in[1]; p.mem_prompt = (const float*)d_in[2]; p.mem_sample = (const float*)d_in[3];
    p.g_mix_pre = (const float*)d_in[4]; p.g_mix_post = (const float*)d_in[5]; p.g_mem = (const float*)d_in[6]; p.w_in = (const float*)d_in[7];
    p.sink_a = (const float*)d_in[8]; p.w_mem_kv = (const float*)d_in[9]; p.w_o_a = (const float*)d_in[10]; p.w_o_b = (const float*)d_in[11];
    p.w_o_c = (const float*)d_in[12]; p.w_out = (const float*)d_in[13]; p.g_ffn_pre = (const float*)d_in[14]; p.g_ffn_post = (const float*)d_in[15];
    p.w_ffn_in = (const float*)d_in[16]; p.w_ffn_out = (const float*)d_in[17];
    p.out = (float*)d_out; p.ws = (unsigned char*)d_ws;
    for (int j = 0; j < 8; ++j) p.inv_freq[j] = powf(500000.0f, -(float)(2 * j) / 16.0f);
#if MK_MULTI_LAUNCH
    for (int s = 0; s < N_STEPS; ++s) {
        p.s_lo = s; p.s_hi = s + 1;
        hipLaunchKernelGGL(fwd_megakernel, dim3(grid_blocks), dim3(NTHREADS), LDS_BYTES, stream, p);
    }
#else
    p.s_lo = 0; p.s_hi = N_STEPS;
    void* args[] = {&p};
    hipError_t e = hipLaunchCooperativeKernel((const void*)fwd_megakernel, dim3(grid_blocks), dim3(NTHREADS), args, LDS_BYTES, stream);
    if (e != hipSuccess) fprintf(stderr, "kernel_launch: cooperative launch failed: %s (grid %d)\n", hipGetErrorString(e), grid_blocks);
#endif
}
```

```cpp
#include <hip/hip_runtime.h>
#include <hip/hip_cooperative_groups.h>
#include <cstdio>
#include <cstdint>
#include <cmath>
namespace cg = cooperative_groups;
#ifndef MK_MULTI_LAUNCH
#define MK_MULTI_LAUNCH 0
#endif
namespace pg8 {
#define PG8_LAS __attribute__((address_space(3)))
typedef unsigned short bf16_t;
typedef short bf16x8 __attribute__((ext_vector_type(8)));
typedef float f32x4 __attribute__((ext_vector_type(4)));
typedef unsigned u32x4 __attribute__((ext_vector_type(4)));
constexpr int BM = 256, BK = 64, HALF = 128, HTB = HALF * BK * 2  , STAGE_BYTES = 8 * HTB, NXCD = 8, WGM = 8;

__host__ __device__ __forceinline__ int lds_byte(int r, int c) { const int st = (r >> 4) * 2 + (c >> 5), rr = r & 15, cc = c & 31, ob = rr * 64 + cc * 2; return st * 1024 + (ob ^ (((ob >> 9) & 1) << 5)); }
__host__ __device__ __forceinline__ void stage_rc(int b, int& R, int& C) { const int st = b / 1024, sb = b % 1024, swz = sb ^ (((sb >> 9) & 1) << 5); R = (st >> 1) * 16 + swz / 64; C = (st & 1) * 32 + (swz % 64) / 2; }
__host__ __device__ __forceinline__ int perm32(int rho) { const int n = rho >> 4, i = rho & 15; return 8 * (i >> 2) + 4 * n + (i & 3); }

struct Unit { int pm, pn; };
struct Gemm { const bf16_t* A; const bf16_t* Bt; int M, N, K; };

struct StaticOrder {
    int nM, nN, nwg, G, c, wgm;
    __host__ __device__ void init(int M, int N, int G_, int c_, int wgm_ = WGM) { nM = M / BM; nN = N / BM; nwg = nM * nN; G = G_; c = c_; wgm = wgm_; }
    __host__ __device__ bool next(int i, Unit& u) const {
        const long L = (long)i * G + c; if (L >= nwg) return false;
        int wgid = (int)L; { const int q = nwg / NXCD, r = nwg % NXCD, xcd = wgid % NXCD, off = wgid / NXCD; wgid = (xcd < r ? xcd * (q + 1) : r * (q + 1) + (xcd - r) * q) + off; }
        const int nig = wgm * nN, gid = wgid / nig, fm = gid * wgm, gsz = (nM - fm) < wgm ? (nM - fm) : wgm;
        u.pm = fm + ((wgid % nig) % gsz); u.pn = (wgid % nig) / gsz; return true;
    }
    __device__ __forceinline__ void a_ready(const Unit&) const {}
    __device__ __forceinline__ void done(const Unit&) const {}
};
__device__ __forceinline__ unsigned cvt_pk_bf16(float lo, float hi) { unsigned r; asm volatile("v_cvt_pk_bf16_f32 %0, %1, %2" : "=v"(r) : "v"(lo), "v"(hi)); return r; }
typedef float f32x2 __attribute__((ext_vector_type(2)));
template <class Epi, class Sched, bool ALIGN_EPI = false, bool SP2 = false>
__device__ __forceinline__ void gemm_phase(PG8_LAS unsigned char* lds, const Gemm g, const Sched& S, const Epi& E) {
    int tid_ = threadIdx.x; asm volatile("" : "+v"(tid_)); const int tid = tid_, wid = __builtin_amdgcn_readfirstlane(tid >> 6), lane = tid & 63, wr = wid >> 2, wc = wid & 3, fr = lane & 15, fq = lane >> 4;
    const int K = g.K, nt = K / BK;
    unsigned voffA[2], voffB[2];
#pragma unroll
    for (int i = 0; i < 2; ++i) { int R, C; stage_rc(tid * 16 + i * 8192, R, C); const int Rb = Epi::PERM ? ((R & ~31) + perm32(R & 31)) : R;
        voffA[i] = (unsigned)(R * K + C) * 2u; voffB[i] = (unsigned)(Rb * K + C) * 2u; }
    const size_t kstep = (size_t)(BK * 2);
    const size_t hstep = (size_t)HALF * K * 2;
    const size_t tstep = 2 * hstep;
    const unsigned ldsw = (unsigned)wid * 1024u;
    const int aoff = lds_byte(wr * 64 + fr, fq * 8), boff = lds_byte(wc * 32 + fr, fq * 8);
#define PG8_SA(b, h) (((b) * 2 + (h)) * HTB)
#define PG8_SB(b, h) ((4 + (b) * 2 + (h)) * HTB)
#define PG8_STAGE(bufoff, gbase, voff) do { _Pragma("unroll") for (int _i = 0; _i < 2; ++_i) \
        __builtin_amdgcn_global_load_lds((const unsigned*)((const char*)(gbase) + (voff)[_i]), (PG8_LAS unsigned*)(lds + (bufoff) + ldsw + _i * 8192), 16, 0, 0); } while (0)
#define PG8_LDA(dst, b, h) do { _Pragma("unroll") for (int m = 0; m < 4; ++m) _Pragma("unroll") for (int k = 0; k < 2; ++k) dst[m][k] = *(const PG8_LAS bf16x8*)(lds + PG8_SA(b, h) + aoff + m * 2048 + k * 1024); } while (0)
#define PG8_LDB(dst, b, h) do { _Pragma("unroll") for (int n = 0; n < 2; ++n) _Pragma("unroll") for (int k = 0; k < 2; ++k) dst[n][k] = *(const PG8_LAS bf16x8*)(lds + PG8_SB(b, h) + boff + n * 2048 + k * 1024); } while (0)
#define PG8_MMA(ai, bj, At, Bt) do { __builtin_amdgcn_s_setprio(1); _Pragma("unroll") for (int m = 0; m < 4; ++m) _Pragma("unroll") for (int n = 0; n < 2; ++n) _Pragma("unroll") for (int k = 0; k < 2; ++k) \
        acc[ai][bj][m][n] = __builtin_amdgcn_mfma_f32_16x16x32_bf16(Bt[n][k], At[m][k], acc[ai][bj][m][n], 0, 0, 0); __builtin_amdgcn_s_setprio(0); } while (0)
#define PG8_WAIT_V(n) asm volatile("s_waitcnt vmcnt(" #n ")" ::: "memory")
#define PG8_WAIT_L(n) asm volatile("s_waitcnt lgkmcnt(" #n ")" ::: "memory")
#define PG8_BAR __builtin_amdgcn_s_barrier()
#define PG8_SCHED __builtin_amdgcn_sched_barrier(0)
    Unit cur, nxt; int ui = 0;
    if (!S.next(0, cur)) return;
    f32x4 acc[2][2][4][2];
#pragma unroll
    for (int a = 0; a < 2; ++a)
#pragma unroll
        for (int b = 0; b < 2; ++b)
#pragma unroll
            for (int m = 0; m < 4; ++m)
#pragma unroll
                for (int n = 0; n < 2; ++n) acc[a][b][m][n] = (f32x4){0.f, 0.f, 0.f, 0.f};
    bf16x8 At[4][2], B0[2][2], B1[2][2];
    const char* cA = (const char*)g.A + (size_t)cur.pm * tstep; const char* cB = (const char*)g.Bt + (size_t)cur.pn * tstep;
    S.a_ready(cur);
    if constexpr (SP2) {
        PG8_STAGE(PG8_SB(0, 0), cB, voffB); PG8_STAGE(PG8_SB(0, 1), cB + hstep, voffB); PG8_STAGE(PG8_SA(0, 0), cA, voffA); PG8_STAGE(PG8_SA(0, 1), cA + hstep, voffA);
        if (wr == 1) PG8_BAR;
        PG8_WAIT_V(2); PG8_BAR;
        PG8_STAGE(PG8_SB(1, 0), cB + kstep, voffB); PG8_STAGE(PG8_SA(1, 0), cA + kstep, voffA); PG8_STAGE(PG8_SB(1, 1), cB + hstep + kstep, voffB);
        PG8_WAIT_V(6); PG8_BAR;
    } else {
        PG8_STAGE(PG8_SB(0, 0), cB, voffB); PG8_STAGE(PG8_SA(0, 0), cA, voffA); PG8_STAGE(PG8_SB(0, 1), cB + hstep, voffB); PG8_STAGE(PG8_SA(0, 1), cA + hstep, voffA);
        if (wr == 1) PG8_BAR;
        PG8_WAIT_V(4); PG8_BAR;
        PG8_STAGE(PG8_SB(1, 0), cB + kstep, voffB); PG8_STAGE(PG8_SA(1, 0), cA + kstep, voffA); PG8_STAGE(PG8_SB(1, 1), cB + hstep + kstep, voffB);
        PG8_WAIT_V(6); PG8_BAR;
    }
    for (;;) {
        const bool has_next = S.next(ui + 1, nxt);
        const char* nA = has_next ? (const char*)g.A + (size_t)nxt.pm * tstep : cA; const char* nB = has_next ? (const char*)g.Bt + (size_t)nxt.pn * tstep : cB;
        for (int t = 0; t < nt; t += 2) {
            const bool last = (t == nt - 2);
            const char* a1 = cA + (size_t)(t + 1) * kstep;
            const char* a2 = last ? nA : cA + (size_t)(t + 2) * kstep; const char* b2 = last ? nB : cB + (size_t)(t + 2) * kstep;
            const char* a3 = a2 + kstep; const char* b3 = b2 + kstep;
            if (last && has_next) S.a_ready(nxt);
            if constexpr (SP2) {
            PG8_LDB(B0, 0, 0); PG8_LDB(B1, 0, 1); PG8_SCHED; PG8_LDA(At, 0, 0); PG8_STAGE(PG8_SA(1, 1), a1 + hstep, voffA);
            PG8_WAIT_V(8); PG8_WAIT_L(0); PG8_BAR; PG8_MMA(0, 0, At, B0); PG8_MMA(0, 1, At, B1); PG8_BAR; PG8_SCHED;
            PG8_LDA(At, 0, 1); PG8_STAGE(PG8_SB(0, 0), b2, voffB); PG8_STAGE(PG8_SB(0, 1), b2 + hstep, voffB); PG8_STAGE(PG8_SA(0, 0), a2, voffA);
            PG8_WAIT_V(8); PG8_WAIT_L(0); PG8_BAR; PG8_MMA(1, 0, At, B0); PG8_MMA(1, 1, At, B1); PG8_BAR; PG8_SCHED;
            PG8_LDB(B0, 1, 0); PG8_LDB(B1, 1, 1); PG8_SCHED; PG8_LDA(At, 1, 0); PG8_STAGE(PG8_SA(0, 1), a2 + hstep, voffA);
            PG8_WAIT_V(8); PG8_WAIT_L(0); PG8_BAR; PG8_MMA(0, 0, At, B0); PG8_MMA(0, 1, At, B1); PG8_BAR; PG8_SCHED;
            PG8_LDA(At, 1, 1); PG8_STAGE(PG8_SB(1, 0), b3, voffB); PG8_STAGE(PG8_SB(1, 1), b3 + hstep, voffB); PG8_STAGE(PG8_SA(1, 0), a3, voffA);
            PG8_WAIT_V(8); PG8_WAIT_L(0); PG8_BAR; PG8_MMA(1, 0, At, B0); PG8_MMA(1, 1, At, B1); PG8_BAR; PG8_SCHED;
            } else {
            PG8_LDB(B0, 0, 0); PG8_SCHED; PG8_LDA(At, 0, 0); PG8_STAGE(PG8_SA(1, 1), a1 + hstep, voffA);
            PG8_WAIT_L(8); PG8_BAR; PG8_WAIT_L(0); PG8_MMA(0, 0, At, B0); PG8_BAR; PG8_SCHED;
            PG8_LDB(B1, 0, 1); PG8_STAGE(PG8_SB(0, 0), b2, voffB);
            PG8_BAR; PG8_WAIT_L(0); PG8_MMA(0, 1, At, B1); PG8_BAR;
            PG8_LDA(At, 0, 1); PG8_STAGE(PG8_SA(0, 0), a2, voffA);
            PG8_BAR; PG8_WAIT_L(0); PG8_MMA(1, 0, At, B0); PG8_BAR; PG8_SCHED;
            PG8_STAGE(PG8_SB(0, 1), b2 + hstep, voffB);
            PG8_WAIT_V(6); PG8_BAR; PG8_MMA(1, 1, At, B1); PG8_BAR;
            PG8_LDB(B0, 1, 0); PG8_SCHED; PG8_LDA(At, 1, 0); PG8_STAGE(PG8_SA(0, 1), a2 + hstep, voffA);
            PG8_WAIT_L(8); PG8_BAR; PG8_WAIT_L(0); PG8_MMA(0, 0, At, B0); PG8_BAR; PG8_SCHED;
            PG8_LDB(B1, 1, 1); PG8_STAGE(PG8_SB(1, 0), b3, voffB);
            PG8_BAR; PG8_WAIT_L(0); PG8_MMA(0, 1, At, B1); PG8_BAR;
            PG8_LDA(At, 1, 1); PG8_STAGE(PG8_SA(1, 0), a3, voffA);
            PG8_BAR; PG8_WAIT_L(0); PG8_MMA(1, 0, At, B0); PG8_BAR; PG8_SCHED;
            PG8_STAGE(PG8_SB(1, 1), b3 + hstep, voffB);
            PG8_WAIT_V(6); PG8_BAR; PG8_MMA(1, 1, At, B1); PG8_BAR;
            }
        }
        if constexpr (ALIGN_EPI) { if (wr == 0) PG8_BAR; }
        if constexpr (!Epi::AFTER_DRAIN) { E(acc, cur, wr, wc, fr, fq); S.done(cur); }
        if (!has_next) break;
#pragma unroll
        for (int a = 0; a < 2; ++a)
#pragma unroll
            for (int b = 0; b < 2; ++b)
#pragma unroll
                for (int m = 0; m < 4; ++m)
#pragma unroll
                    for (int n = 0; n < 2; ++n) acc[a][b][m][n] = (f32x4){0.f, 0.f, 0.f, 0.f};
        cur = nxt; cA = nA; cB = nB; ++ui;
        if constexpr (ALIGN_EPI) { if (wr == 1) PG8_BAR; }
    }
    PG8_WAIT_V(0);
    if constexpr (!ALIGN_EPI) { if (wr == 0) PG8_BAR; }
    PG8_BAR;
    if constexpr (Epi::AFTER_DRAIN) { E.fused(acc, cur, wr, wc, fr, fq, lds, wid, lane); S.done(cur); }
#undef PG8_SA
#undef PG8_SB
#undef PG8_STAGE
#undef PG8_LDA
#undef PG8_LDB
#undef PG8_MMA
#undef PG8_WAIT_V
#undef PG8_WAIT_L
#undef PG8_BAR
#undef PG8_SCHED
}
}

using pg8::bf16_t; using pg8::bf16x8; using pg8::f32x4; using pg8::u32x4;
typedef float f32x16 __attribute__((ext_vector_type(16)));
typedef unsigned u32x2 __attribute__((ext_vector_type(2)));
#define LAS __attribute__((address_space(3)))
constexpr int NTHREADS = 512, NWAVES = 8, LDS_BYTES = pg8::STAGE_BYTES;
constexpr int DM = 1024, SEQ = 2048, NBATCH = 48, DEPTH = 4, NMEM = 256, INW = 6656, FFH = 2816;
constexpr int CB = 16, MC = CB * SEQ, NCHUNK = NBATCH / CB;
constexpr float EPS = 1e-6f, LOG2E = 1.4426950408889634f, LN2 = 0.6931471805599453f;
constexpr size_t WO_IN = 0, WO_MKV = WO_IN + (size_t)INW * DM, WO_OA = WO_MKV + (size_t)1024 * DM, WO_OB = WO_OA + (size_t)1024 * 512, WO_OC = WO_OB + (size_t)1024 * 256,
                 WO_OUT = WO_OC + (size_t)1024 * 512, WO_FIN = WO_OUT + (size_t)1024 * 1024, WO_FOUT = WO_FIN + (size_t)2 * FFH * DM, WL = WO_FOUT + (size_t)DM * FFH;
constexpr size_t al256(size_t x) { return (x + 255) & ~(size_t)255; }
constexpr size_t WS_WT = 0;
constexpr size_t WS_ROPE = al256(WS_WT + WL * DEPTH * 2);
constexpr size_t WS_MEMK = al256(WS_ROPE + (size_t)SEQ * 8 * 8);
constexpr size_t WS_MEMVT = al256(WS_MEMK + (size_t)DEPTH * NBATCH * NMEM * 512 * 2);
constexpr size_t WS_H = al256(WS_MEMVT + (size_t)DEPTH * NBATCH * NMEM * 512 * 2);
constexpr size_t WS_PROJ = al256(WS_H + (size_t)MC * DM * 2);
constexpr size_t WS_VTA = al256(WS_PROJ + (size_t)MC * INW * 2);
constexpr size_t WS_VTB = al256(WS_VTA + (size_t)CB * 2 * 64 * SEQ * 2);
constexpr size_t WS_OA = al256(WS_VTB + (size_t)CB * 12 * 64 * SEQ * 2);
constexpr size_t WS_OB = al256(WS_OA + (size_t)MC * 512 * 2);
constexpr size_t WS_OC = al256(WS_OB + (size_t)MC * 256 * 2);
constexpr size_t WS_MRG = al256(WS_OC + (size_t)MC * 512 * 2);
constexpr size_t WS_KBA = al256(WS_MRG + (size_t)MC * DM * 2);
constexpr size_t WS_KBB = al256(WS_KBA + (size_t)CB * 2 * 64 * SEQ * 2);
constexpr size_t WS_BAR = al256(WS_KBB + (size_t)CB * 12 * 64 * SEQ * 2);
constexpr size_t WS_END = al256(WS_BAR + 16384);
constexpr size_t WS_MEMN = WS_PROJ;
constexpr size_t WS_Y = WS_PROJ;
constexpr size_t WS_ACT = WS_PROJ + (size_t)MC * DM * 4;
constexpr size_t WS_OG = WS_MRG;
constexpr size_t WS_LSE = WS_MRG + (size_t)3 * MC * 256 * 2;
static_assert((size_t)DEPTH * NBATCH * NMEM * DM * 2 <= (size_t)MC * INW * 2, "memn overlay");
static_assert((size_t)MC * DM * 4 + (size_t)MC * FFH * 2 <= (size_t)MC * INW * 2, "y/act overlay");
static_assert((size_t)3 * MC * 256 * 2 + (size_t)3 * MC * 4 * 4 <= (size_t)MC * DM * 2, "og overlay");

struct Params {
    const float *x_prompt, *x_sample, *mem_prompt, *mem_sample, *g_mix_pre, *g_mix_post, *g_mem, *w_in, *sink_a, *w_mem_kv, *w_o_a, *w_o_b, *w_o_c, *w_out,
                *g_ffn_pre, *g_ffn_post, *w_ffn_in, *w_ffn_out;
    float* out; unsigned char* ws;
    float inv_freq[8];
    int s_lo, s_hi;
};

typedef const __attribute__((address_space(4))) Params* PP;
#define OPAQUE_V(x) asm volatile("" : "+v"(x))
#define OPAQUE_S(x) asm volatile("" : "+s"(x))
__device__ __forceinline__ float bf2f(unsigned b) { return __uint_as_float(b << 16); }
typedef __bf16 bf16x2v __attribute__((ext_vector_type(2)));
typedef float f32x2v __attribute__((ext_vector_type(2)));
__device__ __forceinline__ unsigned pk2(float lo, float hi) { const f32x2v v = {lo, hi}; return __builtin_bit_cast(unsigned, __builtin_convertvector(v, bf16x2v)); }
__device__ __forceinline__ float wave_sum(float v) {
#pragma unroll
    for (int o = 32; o > 0; o >>= 1) v += __shfl_xor(v, o);
    return v;
}
__device__ __forceinline__ float fexp2(float x) { return __builtin_amdgcn_exp2f(x); }
__device__ __forceinline__ float frcp(float x) { return __builtin_amdgcn_rcpf(x); }
__device__ __forceinline__ float sigmoidf_(float x) { return frcp(1.f + fexp2(-x * LOG2E)); }
#define LDS_WAIT() asm volatile("s_waitcnt lgkmcnt(0)" ::: "memory")

__device__ __forceinline__ int src_col_in(int n) {
    const bool qk = (n < 640) || (n >= 768 && n < 2304);
    const int p = n & 63;
    return (qk && p < 16) ? (n - p) + (p >> 1) + 8 * (p & 1) : n;
}
__device__ __forceinline__ int src_col_ffin(int n) { const int q = n >> 3, e = n & 7; return e < 4 ? 4 * q + e : FFH + 4 * q + (e - 4); }

template <int PERMT>
__device__ __forceinline__ void transpose_item(const float* W, int K, int N, bf16_t* WT, LAS float* scr, int item, int lane) {
    const int nblk = N / 32, kb = item / nblk, nb = item % nblk, k0 = 64 * kb, n0 = 32 * nb;
    const int nd = n0 + (lane & 31);
    const int ns = PERMT == 1 ? src_col_in(nd) : (PERMT == 2 ? src_col_ffin(nd) : nd);
#pragma unroll 8
    for (int i = 0; i < 32; ++i) { const int kk = 2 * i + (lane >> 5); scr[kk * 33 + (lane & 31)] = __builtin_nontemporal_load(W + (size_t)(k0 + kk) * N + ns); }
    LDS_WAIT();
    const int c = lane & 7;
#pragma unroll
    for (int j = 0; j < 4; ++j) { const int n = (lane >> 3) + 8 * j; const LAS float* s = scr + (8 * c) * 33 + n;
        u32x4 o; o.x = pk2(s[0 * 33], s[1 * 33]); o.y = pk2(s[2 * 33], s[3 * 33]); o.z = pk2(s[4 * 33], s[5 * 33]); o.w = pk2(s[6 * 33], s[7 * 33]);
        *(u32x4*)(WT + (size_t)(n0 + n) * K + k0 + 8 * c) = o; }
    LDS_WAIT();
}

__device__ __forceinline__ void phase_prologue_a(PP p, LAS unsigned char* lds) {
    int tid_ = threadIdx.x; OPAQUE_V(tid_); const int tid = tid_, lane = tid & 63, wave = __builtin_amdgcn_readfirstlane(tid >> 6);
    const int gw = blockIdx.x * NWAVES + wave, NGW = gridDim.x * NWAVES;
    LAS float* scr = (LAS float*)(lds + wave * 16384);
    bf16_t* WT = (bf16_t*)(p->ws + WS_WT);
    constexpr int I_IN = 16 * (INW / 32), I_MKV = 16 * 32, I_OA = 8 * 32, I_OB = 4 * 32, I_OC = 8 * 32, I_OUT = 16 * 32, I_FIN = 16 * (2 * FFH / 32), I_FOUT = (FFH / 64) * 32;
    constexpr int I_L = I_IN + I_MKV + I_OA + I_OB + I_OC + I_OUT + I_FIN + I_FOUT;
    for (int it = gw; it < I_L * DEPTH; it += NGW) {
        const int l = it / I_L; int r = it % I_L;
        bf16_t* wl = WT + (size_t)l * WL;
        if (r < I_IN) { transpose_item<1>(p->w_in + (size_t)l * DM * INW, DM, INW, wl + WO_IN, scr, r, lane); continue; } r -= I_IN;
        if (r < I_MKV) { transpose_item<0>(p->w_mem_kv + (size_t)l * DM * 1024, DM, 1024, wl + WO_MKV, scr, r, lane); continue; } r -= I_MKV;
        if (r < I_OA) { transpose_item<0>(p->w_o_a + (size_t)l * 512 * DM, 512, DM, wl + WO_OA, scr, r, lane); continue; } r -= I_OA;
        if (r < I_OB) { transpose_item<0>(p->w_o_b + (size_t)l * 256 * DM, 256, DM, wl + WO_OB, scr, r, lane); continue; } r -= I_OB;
        if (r < I_OC) { transpose_item<0>(p->w_o_c + (size_t)l * 512 * DM, 512, DM, wl + WO_OC, scr, r, lane); continue; } r -= I_OC;
        if (r < I_OUT) { transpose_item<0>(p->w_out + (size_t)l * DM * DM, DM, DM, wl + WO_OUT, scr, r, lane); continue; } r -= I_OUT;
        if (r < I_FIN) { transpose_item<2>(p->w_ffn_in + (size_t)l * DM * 2 * FFH, DM, 2 * FFH, wl + WO_FIN, scr, r, lane); continue; } r -= I_FIN;
        transpose_item<0>(p->w_ffn_out + (size_t)l * FFH * DM, FFH, DM, wl + WO_FOUT, scr, r, lane);
    }
    float2* rope = (float2*)(p->ws + WS_ROPE);
    for (int i = blockIdx.x * NTHREADS + tid; i < SEQ * 8; i += gridDim.x * NTHREADS) {
        const int pos = i >> 3, j = i & 7;
        const float ang = (float)pos * p->inv_freq[j];
        const double rev = (double)ang * 0.15915494309189535;
        const float fr = (float)(rev - rint(rev));
        rope[i] = make_float2(__builtin_amdgcn_cosf(fr), __builtin_amdgcn_sinf(fr));
    }
    bf16_t* memn = (bf16_t*)(p->ws + WS_MEMN);
    for (int R = gw; R < NBATCH * NMEM; R += NGW) {
        const float* src = (R < 16 * NMEM) ? p->mem_prompt + (size_t)R * DM : p->mem_sample + (size_t)(R - 16 * NMEM) * DM;
        f32x4 v[4]; float ss = 0.f;
#pragma unroll
        for (int j = 0; j < 4; ++j) { v[j] = *(const f32x4*)(src + 4 * (lane + 64 * j)); ss += v[j].x * v[j].x + v[j].y * v[j].y + v[j].z * v[j].z + v[j].w * v[j].w; }
        const float rstd = 1.f / sqrtf(wave_sum(ss) * (1.f / DM) + EPS);
#pragma unroll
        for (int l = 0; l < DEPTH; ++l)
#pragma unroll
            for (int j = 0; j < 4; ++j) { const f32x4 g = *(const f32x4*)(p->g_mem + l * DM + 4 * (lane + 64 * j));
                u32x2 o; o.x = pk2(v[j].x * rstd * g.x, v[j].y * rstd * g.y); o.y = pk2(v[j].z * rstd * g.z, v[j].w * rstd * g.w);
                *(u32x2*)(memn + ((size_t)l * NBATCH * NMEM + R) * DM + 4 * (lane + 64 * j)) = o; }
    }
}

__device__ __forceinline__ const float* x_in_row(PP p, int GR) { return GR < 16 * SEQ ? p->x_prompt + (size_t)GR * DM : p->x_sample + (size_t)(GR - 16 * SEQ) * DM; }

__device__ __forceinline__ void phase_rows_first(PP p, int chunk) {
    int tid_ = threadIdx.x; OPAQUE_V(tid_); const int lane = tid_ & 63, wave = __builtin_amdgcn_readfirstlane(tid_ >> 6);
    bf16_t* H = (bf16_t*)(p->ws + WS_H);
    for (int r = blockIdx.x * NWAVES + wave; r < MC; r += gridDim.x * NWAVES) {
        const float* src = x_in_row(p, chunk * MC + r);
        f32x4 v[4]; float ss = 0.f;
#pragma unroll
        for (int j = 0; j < 4; ++j) { v[j] = *(const f32x4*)(src + 4 * (lane + 64 * j)); ss += v[j].x * v[j].x + v[j].y * v[j].y + v[j].z * v[j].z + v[j].w * v[j].w; }
        const float rstd = 1.f / sqrtf(wave_sum(ss) * (1.f / DM) + EPS);
#pragma unroll
        for (int j = 0; j < 4; ++j) { const f32x4 g = *(const f32x4*)(p->g_mix_pre + 4 * (lane + 64 * j));
            u32x2 o; o.x = pk2(v[j].x * rstd * g.x, v[j].y * rstd * g.y); o.y = pk2(v[j].z * rstd * g.z, v[j].w * rstd * g.w);
            *(u32x2*)(H + (size_t)r * DM + 4 * (lane + 64 * j)) = o; }
    }
}
struct RowBuf { f32x4 x[4]; u32x2 y[4]; };
__device__ __forceinline__ void row_load(RowBuf& b, const bf16_t* yrow, const float* xrow, int lane) {
#pragma unroll
    for (int j = 0; j < 4; ++j) { b.y[j] = __builtin_nontemporal_load((const u32x2*)(yrow + 4 * (lane + 64 * j))); b.x[j] = __builtin_nontemporal_load((const f32x4*)(xrow + 4 * (lane + 64 * j))); }
}
__device__ __forceinline__ void row_process(RowBuf& b, float* dst, bf16_t* hrow, const float* g_post, const float* g_next, bool write_h, int lane) {
    f32x4 y[4]; float ss = 0.f;
#pragma unroll
    for (int j = 0; j < 4; ++j) { y[j].x = bf2f(b.y[j].x & 0xffffu); y[j].y = bf2f(b.y[j].x >> 16); y[j].z = bf2f(b.y[j].y & 0xffffu); y[j].w = bf2f(b.y[j].y >> 16);
        ss += y[j].x * y[j].x + y[j].y * y[j].y + y[j].z * y[j].z + y[j].w * y[j].w; }
    const float ry = 1.f / sqrtf(wave_sum(ss) * (1.f / DM) + EPS);
    float sx = 0.f;
#pragma unroll
    for (int j = 0; j < 4; ++j) { const f32x4 g = *(const f32x4*)(g_post + 4 * (lane + 64 * j)); f32x4 x = b.x[j];
        x.x += y[j].x * ry * g.x; x.y += y[j].y * ry * g.y; x.z += y[j].z * ry * g.z; x.w += y[j].w * ry * g.w;
        __builtin_nontemporal_store(x, (f32x4*)(dst + 4 * (lane + 64 * j))); b.x[j] = x;
        sx += x.x * x.x + x.y * x.y + x.z * x.z + x.w * x.w; }
    if (write_h) {
        const float rx = 1.f / sqrtf(wave_sum(sx) * (1.f / DM) + EPS);
#pragma unroll
        for (int j = 0; j < 4; ++j) { const f32x4 g = *(const f32x4*)(g_next + 4 * (lane + 64 * j)); const f32x4 x = b.x[j];
            u32x2 o; o.x = pk2(x.x * rx * g.x, x.y * rx * g.y); o.y = pk2(x.z * rx * g.z, x.w * rx * g.w);
            *(u32x2*)(hrow + 4 * (lane + 64 * j)) = o; }
    }
}
__device__ __forceinline__ void phase_rows_resid(PP p, int chunk, bool src_is_input, const float* g_post, const float* g_next, bool write_h) {
    int tid_ = threadIdx.x; OPAQUE_V(tid_); const int lane = tid_ & 63, wave = __builtin_amdgcn_readfirstlane(tid_ >> 6);
    bf16_t* H = (bf16_t*)(p->ws + WS_H);
    const bf16_t* Y = (const bf16_t*)(p->ws + WS_Y);
    float* out = p->out;
    const int stride = gridDim.x * NWAVES;
    int r = blockIdx.x * NWAVES + wave;
    if (r >= MC) return;
    RowBuf A, B;
#define ROW_SRC(rr) (src_is_input ? x_in_row(p, chunk * MC + (rr)) : out + (size_t)(chunk * MC + (rr)) * DM)
    row_load(A, Y + (size_t)r * DM, ROW_SRC(r), lane);
    for (;;) {
        const int r1 = r + stride;
        if (r1 < MC) row_load(B, Y + (size_t)r1 * DM, ROW_SRC(r1), lane);
        row_process(A, out + (size_t)(chunk * MC + r) * DM, H + (size_t)r * DM, g_post, g_next, write_h, lane);
        if (r1 >= MC) break;
        const int r2 = r1 + stride;
        if (r2 < MC) row_load(A, Y + (size_t)r2 * DM, ROW_SRC(r2), lane);
        row_process(B, out + (size_t)(chunk * MC + r1) * DM, H + (size_t)r1 * DM, g_post, g_next, write_h, lane);
        if (r2 >= MC) break;
        r = r2;
    }
#undef ROW_SRC
}

__device__ __forceinline__ int pi32(int r) { return (r & 0x13) | ((r & 4) << 1) | ((r & 8) >> 1); }
template <int D> __device__ __forceinline__ size_t kblk_off(int p, int c8) { const int kt = p >> 5, r = pi32(p & 31); return ((size_t)(kt * (D / 16) + (c8 >> 1)) * 64 + (c8 & 1) * 32 + r) * 8; }
template <int D> __device__ __forceinline__ size_t vblk_off(int p, int d) { const int kt = p >> 5, w = p & 31; return ((((size_t)kt * (D / 32) + (d >> 5)) * 2 + (w >> 4)) * 64 + ((w >> 3) & 1) * 32 + (d & 31)) * 8 + (w & 7); }
template <int D> __device__ __forceinline__ void store8_vblk(bf16_t* img, int p, int d0, const f32x4& a, const f32x4& b) {
    const unsigned o0 = pk2(a.x, a.y), o1 = pk2(a.z, a.w), o2 = pk2(b.x, b.y), o3 = pk2(b.z, b.w);
    bf16_t* base = img + vblk_off<D>(p, d0);
    base[0] = (bf16_t)(o0 & 0xffffu); base[8] = (bf16_t)(o0 >> 16); base[16] = (bf16_t)(o1 & 0xffffu); base[24] = (bf16_t)(o1 >> 16);
    base[32] = (bf16_t)(o2 & 0xffffu); base[40] = (bf16_t)(o2 >> 16); base[48] = (bf16_t)(o3 & 0xffffu); base[56] = (bf16_t)(o3 >> 16);
}
__device__ __forceinline__ u32x4 pack8(const f32x4& a, const f32x4& b) { u32x4 o; o.x = pk2(a.x, a.y); o.y = pk2(a.z, a.w); o.z = pk2(b.x, b.y); o.w = pk2(b.z, b.w); return o; }
__device__ __forceinline__ void store8_strided(bf16_t* base, size_t stride, const f32x4& a, const f32x4& b) {
    const u32x4 o = pack8(a, b);
    base[0 * stride] = (bf16_t)(o.x & 0xffffu); base[1 * stride] = (bf16_t)(o.x >> 16); base[2 * stride] = (bf16_t)(o.y & 0xffffu); base[3 * stride] = (bf16_t)(o.y >> 16);
    base[4 * stride] = (bf16_t)(o.z & 0xffffu); base[5 * stride] = (bf16_t)(o.z >> 16); base[6 * stride] = (bf16_t)(o.w & 0xffffu); base[7 * stride] = (bf16_t)(o.w >> 16);
}
struct EpiIn {
    static constexpr bool PERM = true, AFTER_DRAIN = false;
    bf16_t* proj; bf16_t* vta; bf16_t* vtb; bf16_t* kba; bf16_t* kbb; const float* rope;
    __device__ __forceinline__ void operator()(const f32x4 (&acc)[2][2][4][2], const pg8::Unit& u, int wr, int wc, int fr, int fq) const {
        const int row0 = u.pm * 256 + wr * 64 + fr;
#pragma unroll
        for (int bj = 0; bj < 2; ++bj) {
            const int c128 = u.pn * 256 + bj * 128, cb = c128 + wc * 32 + 8 * fq;
            if (c128 >= 3584) {
#pragma unroll
                for (int ai = 0; ai < 2; ++ai)
#pragma unroll
                    for (int m = 0; m < 4; ++m) { const int row = row0 + ai * 128 + m * 16; f32x4 a = acc[ai][bj][m][0], b = acc[ai][bj][m][1];
                        a.x = sigmoidf_(a.x); a.y = sigmoidf_(a.y); a.z = sigmoidf_(a.z); a.w = sigmoidf_(a.w); b.x = sigmoidf_(b.x); b.y = sigmoidf_(b.y); b.z = sigmoidf_(b.z); b.w = sigmoidf_(b.w);
                        __builtin_nontemporal_store(pack8(a, b), (u32x4*)(proj + (size_t)row * INW + cb)); }
            } else if (c128 >= 3072) {
#pragma unroll
                for (int ai = 0; ai < 2; ++ai)
#pragma unroll
                    for (int m = 0; m < 4; ++m) { const int row = row0 + ai * 128 + m * 16; __builtin_nontemporal_store(pack8(acc[ai][bj][m][0], acc[ai][bj][m][1]), (u32x4*)(proj + (size_t)row * INW + cb)); }
            } else if (c128 == 640) {
                const int kvh = (cb - 640) >> 6, d0 = (cb - 640) & 63;
#pragma unroll
                for (int ai = 0; ai < 2; ++ai)
#pragma unroll
                    for (int m = 0; m < 4; ++m) { const int row = row0 + ai * 128 + m * 16, bl = row >> 11, pos = row & 2047;
                        store8_vblk<64>(vta + (size_t)(bl * 2 + kvh) * 64 * SEQ, pos, d0, acc[ai][bj][m][0], acc[ai][bj][m][1]); }
            } else if (c128 >= 2304) {
                const int hb = (cb - 2304) >> 6, d0 = (cb - 2304) & 63, sh = 2 * (hb >> 2);
#pragma unroll
                for (int ai = 0; ai < 2; ++ai)
#pragma unroll
                    for (int m = 0; m < 4; ++m) { const int row = row0 + ai * 128 + m * 16, bl = row >> 11, pos = row & 2047;
                        const int pg = (pos & ((1 << sh) - 1)) * (SEQ >> sh) + (pos >> sh);
                        store8_vblk<64>(vtb + (size_t)(bl * 12 + hb) * 64 * SEQ, pg, d0, acc[ai][bj][m][0], acc[ai][bj][m][1]); }
            } else {
                const bool rp = ((wc & 1) == 0) && (fq < 2);
#pragma unroll
                for (int ai = 0; ai < 2; ++ai)
#pragma unroll
                    for (int m = 0; m < 4; ++m) { const int row = row0 + ai * 128 + m * 16; f32x4 a = acc[ai][bj][m][0], b = acc[ai][bj][m][1];
                        if (rp) { const int pos = row & 2047; const f32x4* t = (const f32x4*)(rope + (size_t)pos * 16 + 8 * fq); const f32x4 t0 = t[0], t1 = t[1];
                            f32x4 a2, b2;
                            a2.x = a.x * t0.x - a.y * t0.y; a2.y = a.y * t0.x + a.x * t0.y; a2.z = a.z * t0.z - a.w * t0.w; a2.w = a.w * t0.z + a.z * t0.w;
                            b2.x = b.x * t1.x - b.y * t1.y; b2.y = b.y * t1.x + b.x * t1.y; b2.z = b.z * t1.z - b.w * t1.w; b2.w = b.w * t1.z + b.z * t1.w;
                            a = a2; b = b2; }
                        if (c128 == 512) {
                            const int bl = row >> 11, pos = row & 2047, kvh = (cb - 512) >> 6, c8 = ((cb - 512) & 63) >> 3;
                            *(u32x4*)(kba + (size_t)(bl * 2 + kvh) * 64 * SEQ + kblk_off<64>(pos, c8)) = pack8(a, b);
                        } else if (c128 >= 1536) {
                            const int bl = row >> 11, pos = row & 2047, hb = (cb - 1536) >> 6, c8 = ((cb - 1536) & 63) >> 3, sh = 2 * (hb >> 2);
                            const int pg = (pos & ((1 << sh) - 1)) * (SEQ >> sh) + (pos >> sh);
                            *(u32x4*)(kbb + (size_t)(bl * 12 + hb) * 64 * SEQ + kblk_off<64>(pg, c8)) = pack8(a, b);
                        } else __builtin_nontemporal_store(pack8(a, b), (u32x4*)(proj + (size_t)row * INW + cb)); }
            }
        }
    }
};
struct EpiMemKV {
    static constexpr bool PERM = true, AFTER_DRAIN = false;
    bf16_t* mk; bf16_t* mvt;
    __device__ __forceinline__ void operator()(const f32x4 (&acc)[2][2][4][2], const pg8::Unit& u, int wr, int wc, int fr, int fq) const {
        const int row0 = u.pm * 256 + wr * 64 + fr;
#pragma unroll
        for (int bj = 0; bj < 2; ++bj) {
            const int c128 = u.pn * 256 + bj * 128, cb = c128 + wc * 32 + 8 * fq;
            if (c128 < 512) {
#pragma unroll
                for (int ai = 0; ai < 2; ++ai)
#pragma unroll
                    for (int m = 0; m < 4; ++m) { const int row = row0 + ai * 128 + m * 16, b = row >> 8, j = row & 255, hc = cb >> 7, c8 = (cb & 127) >> 3;
                        *(u32x4*)(mk + (size_t)(b * 4 + hc) * 128 * NMEM + kblk_off<128>(j, c8)) = pack8(acc[ai][bj][m][0], acc[ai][bj][m][1]); }
            } else {
                const int hc = (cb - 512) >> 7, d0 = (cb - 512) & 127;
#pragma unroll
                for (int ai = 0; ai < 2; ++ai)
#pragma unroll
                    for (int m = 0; m < 4; ++m) { const int row = row0 + ai * 128 + m * 16, b = row >> 8, j = row & 255;
                        store8_vblk<128>(mvt + (size_t)(b * 4 + hc) * 128 * NMEM, j, d0, acc[ai][bj][m][0], acc[ai][bj][m][1]); }
            }
        }
    }
};
struct EpiGate {
    static constexpr bool PERM = true, AFTER_DRAIN = false;
    const bf16_t* gate; bf16_t* mrg; int accum;
    __device__ __forceinline__ void operator()(const f32x4 (&acc)[2][2][4][2], const pg8::Unit& u, int wr, int wc, int fr, int fq) const {
        const int row0 = u.pm * 256 + wr * 64 + fr, cb0 = u.pn * 256 + wc * 32 + 8 * fq;
#pragma unroll
        for (int ai = 0; ai < 2; ++ai) {
            u32x4 g[4][2], o[4][2];
#pragma unroll
            for (int m = 0; m < 4; ++m)
#pragma unroll
                for (int bj = 0; bj < 2; ++bj) g[m][bj] = __builtin_nontemporal_load((const u32x4*)(gate + (size_t)(row0 + ai * 128 + m * 16) * INW + cb0 + bj * 128));
            if (accum) {
#pragma unroll
                for (int m = 0; m < 4; ++m)
#pragma unroll
                    for (int bj = 0; bj < 2; ++bj) o[m][bj] = *(const u32x4*)(mrg + (size_t)(row0 + ai * 128 + m * 16) * DM + cb0 + bj * 128);
            }
#pragma unroll
            for (int m = 0; m < 4; ++m)
#pragma unroll
                for (int bj = 0; bj < 2; ++bj) {
                    const u32x4 gg = g[m][bj];
                    f32x4 a = acc[ai][bj][m][0], b = acc[ai][bj][m][1];
                    a.x *= bf2f(gg.x & 0xffffu); a.y *= bf2f(gg.x >> 16); a.z *= bf2f(gg.y & 0xffffu); a.w *= bf2f(gg.y >> 16);
                    b.x *= bf2f(gg.z & 0xffffu); b.y *= bf2f(gg.z >> 16); b.z *= bf2f(gg.w & 0xffffu); b.w *= bf2f(gg.w >> 16);
                    if (accum) { const u32x4 oo = o[m][bj];
                        a.x += bf2f(oo.x & 0xffffu); a.y += bf2f(oo.x >> 16); a.z += bf2f(oo.y & 0xffffu); a.w += bf2f(oo.y >> 16);
                        b.x += bf2f(oo.z & 0xffffu); b.y += bf2f(oo.z >> 16); b.z += bf2f(oo.w & 0xffffu); b.w += bf2f(oo.w >> 16); }
                    *(u32x4*)(mrg + (size_t)(row0 + ai * 128 + m * 16) * DM + cb0 + bj * 128) = pack8(a, b);
                }
        }
    }
};
struct EpiY {
    static constexpr bool PERM = true, AFTER_DRAIN = false;
    bf16_t* Y;
    __device__ __forceinline__ void operator()(const f32x4 (&acc)[2][2][4][2], const pg8::Unit& u, int wr, int wc, int fr, int fq) const {
        const int row0 = u.pm * 256 + wr * 64 + fr;
#pragma unroll
        for (int ai = 0; ai < 2; ++ai)
#pragma unroll
            for (int m = 0; m < 4; ++m)
#pragma unroll
                for (int bj = 0; bj < 2; ++bj)
                    *(u32x4*)(Y + (size_t)(row0 + ai * 128 + m * 16) * DM + u.pn * 256 + bj * 128 + wc * 32 + 8 * fq) = pack8(acc[ai][bj][m][0], acc[ai][bj][m][1]);
    }
};
struct EpiSwiGLU {
    static constexpr bool PERM = true, AFTER_DRAIN = false;
    bf16_t* act;
    __device__ __forceinline__ void operator()(const f32x4 (&acc)[2][2][4][2], const pg8::Unit& u, int wr, int wc, int fr, int fq) const {
        const int row0 = u.pm * 256 + wr * 64 + fr;
#pragma unroll
        for (int ai = 0; ai < 2; ++ai)
#pragma unroll
            for (int m = 0; m < 4; ++m)
#pragma unroll
                for (int bj = 0; bj < 2; ++bj) { const int cb = u.pn * 256 + bj * 128 + wc * 32 + 8 * fq; const f32x4 g = acc[ai][bj][m][0], v = acc[ai][bj][m][1];
                    u32x2 o; o.x = pk2(g.x * sigmoidf_(g.x) * v.x, g.y * sigmoidf_(g.y) * v.y); o.y = pk2(g.z * sigmoidf_(g.z) * v.z, g.w * sigmoidf_(g.w) * v.w);
                    *(u32x2*)(act + (size_t)(row0 + ai * 128 + m * 16) * FFH + (cb >> 1)) = o; }
    }
};
#ifndef GATE_FAST
#define GATE_FAST true
#endif
template <class Epi, bool FAST = true>
__device__ __forceinline__ void run_gemm(LAS unsigned char* lds, const bf16_t* A, const bf16_t* Bt, int M, int N, int K, const Epi& E, int crot) {
    pg8::Gemm g; g.A = A; g.Bt = Bt; g.M = M; g.N = N; g.K = K;
#ifndef WGM_WIDE
#define WGM_WIDE 4
#endif
#ifndef WGM_NARROW
#define WGM_NARROW 8
#endif
    pg8::StaticOrder S; S.init(M, N, (int)gridDim.x, (int)((blockIdx.x + crot) % gridDim.x), N > 1024 ? WGM_WIDE : WGM_NARROW);
    pg8::gemm_phase<Epi, pg8::StaticOrder, FAST, FAST>(lds, g, S, E);
}

struct AttnTask {
    const bf16_t* q; long qstride;
    const bf16_t* kb; const bf16_t* vb;
    bf16_t* o; long ostride;
    float* lse; long lsestride;
    int m0, L, W;
    float m_init, l_init, scale2;
};
template <int D>
__device__ __forceinline__ void attn_load_k(bf16x8 (&kf)[D / 16], const AttnTask& t, int k0, int lane) {
    const bf16_t* kp = t.kb + ((size_t)(k0 >> 5) * (D / 16) * 64 + lane) * 8;
#pragma unroll
    for (int kk = 0; kk < D / 16; ++kk) kf[kk] = *(const bf16x8*)(kp + kk * 512);
}
template <int D>
__device__ __forceinline__ void attn_load_v(bf16x8 (&vf)[D / 32][2], const AttnTask& t, int k0, int lane) {
    const bf16_t* vp = t.vb + ((size_t)(k0 >> 5) * (D / 32) * 128 + lane) * 8;
#pragma unroll
    for (int db = 0; db < D / 32; ++db)
#pragma unroll
        for (int s = 0; s < 2; ++s) vf[db][s] = *(const bf16x8*)(vp + (db * 2 + s) * 512);
}
__device__ __forceinline__ float xhalf_max(float v) { const auto r = __builtin_amdgcn_permlane32_swap(__float_as_uint(v), __float_as_uint(v), false, false); return fmaxf(__uint_as_float(r[0]), __uint_as_float(r[1])); }
__device__ __forceinline__ float xhalf_sum(float v) { const auto r = __builtin_amdgcn_permlane32_swap(__float_as_uint(v), __float_as_uint(v), false, false); return __uint_as_float(r[0]) + __uint_as_float(r[1]); }
template <int D, bool MASK>
__device__ __forceinline__ void attn_tile(const bf16x8 (&qf)[D / 16], const bf16x8 (&kf)[D / 16], const bf16x8 (&vf)[D / 32][2], f32x16 (&o)[D / 32], float& mrun, float& lrun,
                                          const AttnTask& t, int k0, int mq, int qi, int h) {
    f32x16 sc;
#pragma unroll
    for (int i = 0; i < 16; ++i) sc[i] = 0.f;
#pragma unroll
    for (int kk = 0; kk < D / 16; ++kk) sc = __builtin_amdgcn_mfma_f32_32x32x16_bf16(kf[kk], qf[kk], sc, 0, 0, 0);
    if (MASK) {
        if (k0 == mq - t.W || k0 == mq + t.W) {
#pragma unroll
            for (int i = 0; i < 16; ++i) { const int dlt = k0 + 16 * (i >> 3) + 8 * h + (i & 7) - qi; sc[i] = (dlt <= t.W && dlt >= -t.W) ? sc[i] : -1e30f; }
        }
    }
    float mt = sc[0];
#pragma unroll
    for (int i = 1; i < 16; ++i) mt = fmaxf(mt, sc[i]);
    mt = xhalf_max(mt) * t.scale2;
    const float mn = fmaxf(mrun, mt), alpha = fexp2(mrun - mn);
    float ps = 0.f;
#pragma unroll
    for (int i = 0; i < 16; ++i) { sc[i] = fexp2(__builtin_fmaf(sc[i], t.scale2, -mn)); ps += sc[i]; }
    ps = xhalf_sum(ps);
    lrun = lrun * alpha + ps; mrun = mn;
#pragma unroll
    for (int db = 0; db < D / 32; ++db)
#pragma unroll
        for (int i = 0; i < 16; ++i) o[db][i] *= alpha;
    bf16x8 pf[2];
#pragma unroll
    for (int s = 0; s < 2; ++s) { u32x4 w; w.x = pk2(sc[8 * s + 0], sc[8 * s + 1]); w.y = pk2(sc[8 * s + 2], sc[8 * s + 3]); w.z = pk2(sc[8 * s + 4], sc[8 * s + 5]); w.w = pk2(sc[8 * s + 6], sc[8 * s + 7]);
        pf[s] = __builtin_bit_cast(bf16x8, w); }
#pragma unroll
    for (int db = 0; db < D / 32; ++db)
#pragma unroll
        for (int s = 0; s < 2; ++s) o[db] = __builtin_amdgcn_mfma_f32_32x32x16_bf16(vf[db][s], pf[s], o[db], 0, 0, 0);
}
template <int D, bool MASK, bool PFV, int NQ>
__device__ __forceinline__ void attn_wave(const AttnTask& t, LAS unsigned char* scr, int lane) {
    const int r = lane & 31, h = lane >> 5;
    bf16x8 qf[NQ][D / 16];
#pragma unroll
    for (int q = 0; q < NQ; ++q) { const bf16_t* qp = t.q + (long)(t.m0 + 32 * q + r) * t.qstride + 8 * h;
#pragma unroll
        for (int kk = 0; kk < D / 16; ++kk) qf[q][kk] = *(const bf16x8*)(qp + 16 * kk); }
    f32x16 o[NQ][D / 32];
    float mrun[NQ], lrun[NQ];
#pragma unroll
    for (int q = 0; q < NQ; ++q) { mrun[q] = t.m_init; lrun[q] = t.l_init;
#pragma unroll
        for (int db = 0; db < D / 32; ++db)
#pragma unroll
            for (int i = 0; i < 16; ++i) o[q][db][i] = 0.f; }
    int klo = 0, khi = t.L;
    if (MASK) { klo = t.m0 - t.W; if (klo < 0) klo = 0; khi = t.m0 + 32 * NQ + t.W; if (khi > t.L) khi = t.L; }
    bf16x8 ka[D / 16], kb[D / 16], va[D / 32][2], vb[D / 32][2];
    attn_load_k<D>(ka, t, klo, lane);
    attn_load_v<D>(va, t, klo, lane);
#define ATT_TILES(KF, VF, K0) do { _Pragma("unroll") for (int q = 0; q < NQ; ++q) { const int mq = t.m0 + 32 * q; \
        if (!MASK || NQ == 1 || ((K0) >= mq - t.W && (K0) <= mq + t.W)) attn_tile<D, MASK>(qf[q], KF, VF, o[q], mrun[q], lrun[q], t, (K0), mq, mq + r, h); } } while (0)
    for (int k0 = klo; k0 < khi; k0 += 64) {
        const int k1 = k0 + 32, k2 = (k0 + 64 < khi) ? k0 + 64 : klo;
        const bool has1 = k1 < khi;
        attn_load_k<D>(kb, t, has1 ? k1 : klo, lane);
        if (PFV) attn_load_v<D>(vb, t, has1 ? k1 : klo, lane);
        __builtin_amdgcn_sched_barrier(0);
        ATT_TILES(ka, va, k0);
        __builtin_amdgcn_sched_barrier(0);
        if (!has1) break;
        if (!PFV) attn_load_v<D>(vb, t, k1, lane);
        attn_load_k<D>(ka, t, k2, lane);
        if (PFV) attn_load_v<D>(va, t, k2, lane);
        __builtin_amdgcn_sched_barrier(0);
        ATT_TILES(kb, vb, k1);
        __builtin_amdgcn_sched_barrier(0);
        if (!PFV) attn_load_v<D>(va, t, k2, lane);
    }
#undef ATT_TILES
#pragma unroll
    for (int q = 0; q < NQ; ++q) {
        const int qi = t.m0 + 32 * q + r;
        const float inv = 1.f / lrun[q];
        constexpr int RS = 2 * D + 16;
#pragma unroll
        for (int db = 0; db < D / 32; ++db)
#pragma unroll
            for (int g = 0; g < 4; ++g) { u32x2 w; w.x = pk2(o[q][db][4 * g + 0] * inv, o[q][db][4 * g + 1] * inv); w.y = pk2(o[q][db][4 * g + 2] * inv, o[q][db][4 * g + 3] * inv);
                *(LAS u32x2*)(scr + r * RS + (32 * db + 8 * g + 4 * h) * 2) = w; }
        LDS_WAIT();
        constexpr int CPR = D / 8, RPI = 64 / CPR;
#pragma unroll
        for (int it = 0; it < 32 / RPI; ++it) { const int row = it * RPI + lane / CPR, ch = lane % CPR;
            const u32x4 v = *(const LAS u32x4*)(scr + row * RS + ch * 16);
            *(u32x4*)(t.o + (long)(t.m0 + 32 * q + row) * t.ostride + ch * 8) = v; }
        LDS_WAIT();
        if (t.lse != nullptr && h == 0) t.lse[(long)qi * t.lsestride] = (mrun[q] + __builtin_amdgcn_logf(lrun[q])) * LN2;
    }
}

__device__ __forceinline__ void attn_wave_mem_lds(const AttnTask& t, LAS unsigned char* lds, int lane) {
    constexpr int D = 128;
    const int r = lane & 31, h = lane >> 5;
    bf16x8 qf[D / 16];
    const bf16_t* qp = t.q + (long)(t.m0 + r) * t.qstride + 8 * h;
#pragma unroll
    for (int kk = 0; kk < D / 16; ++kk) qf[kk] = *(const bf16x8*)(qp + 16 * kk);
    f32x16 o[D / 32];
#pragma unroll
    for (int db = 0; db < D / 32; ++db)
#pragma unroll
        for (int i = 0; i < 16; ++i) o[db][i] = 0.f;
    float mrun = t.m_init, lrun = t.l_init;
    const int qi = t.m0 + r;
    for (int kt = 0; kt < NMEM / 32; ++kt) {
        bf16x8 kf[D / 16], vf[D / 32][2];
#pragma unroll
        for (int kk = 0; kk < D / 16; ++kk) kf[kk] = *(const LAS bf16x8*)(lds + ((kt * (D / 16) + kk) * 64 + lane) * 16);
#pragma unroll
        for (int db = 0; db < D / 32; ++db)
#pragma unroll
            for (int s = 0; s < 2; ++s) vf[db][s] = *(const LAS bf16x8*)(lds + 65536 + (((kt * (D / 32) + db) * 2 + s) * 64 + lane) * 16);
        attn_tile<D, false>(qf, kf, vf, o, mrun, lrun, t, kt * 32, t.m0, qi, h);
    }
    const float inv = 1.f / lrun;
    bf16_t* op = t.o + (long)qi * t.ostride + 4 * h;
#pragma unroll
    for (int db = 0; db < D / 32; ++db)
#pragma unroll
        for (int g = 0; g < 4; ++g) { u32x2 w; w.x = pk2(o[db][4 * g + 0] * inv, o[db][4 * g + 1] * inv); w.y = pk2(o[db][4 * g + 2] * inv, o[db][4 * g + 3] * inv);
            *(u32x2*)(op + 32 * db + 8 * g) = w; }
}

__device__ __forceinline__ void attn_wave_win_lds(const AttnTask& t, LAS unsigned char* lds, int kt0, int lane) {
    constexpr int D = 64;
    const int r = lane & 31, h = lane >> 5;
    bf16x8 qf[D / 16];
    const bf16_t* qp = t.q + (long)(t.m0 + r) * t.qstride + 8 * h;
#pragma unroll
    for (int kk = 0; kk < D / 16; ++kk) qf[kk] = *(const bf16x8*)(qp + 16 * kk);
    f32x16 o[D / 32];
#pragma unroll
    for (int db = 0; db < D / 32; ++db)
#pragma unroll
        for (int i = 0; i < 16; ++i) o[db][i] = 0.f;
    float mrun = t.m_init, lrun = t.l_init;
    const int qi = t.m0 + r;
    int kta = (t.m0 - t.W) >> 5, ktb = (t.m0 + t.W) >> 5;
    if (kta < 0) kta = 0;
    if (ktb > t.L / 32 - 1) ktb = t.L / 32 - 1;
    for (int kt = kta; kt <= ktb; ++kt) {
        const int slot = kt - kt0;
        bf16x8 kf[D / 16], vf[D / 32][2];
#pragma unroll
        for (int kk = 0; kk < D / 16; ++kk) kf[kk] = *(const LAS bf16x8*)(lds + ((slot * (D / 16) + kk) * 64 + lane) * 16);
#pragma unroll
        for (int db = 0; db < D / 32; ++db)
#pragma unroll
            for (int s = 0; s < 2; ++s) vf[db][s] = *(const LAS bf16x8*)(lds + 65536 + (((slot * (D / 32) + db) * 2 + s) * 64 + lane) * 16);
        attn_tile<D, true>(qf, kf, vf, o, mrun, lrun, t, kt * 32, t.m0, qi, h);
    }
    const float inv = 1.f / lrun;
    bf16_t* op = t.o + (long)qi * t.ostride + 4 * h;
#pragma unroll
    for (int db = 0; db < D / 32; ++db)
#pragma unroll
        for (int g = 0; g < 4; ++g) { u32x2 w; w.x = pk2(o[db][4 * g + 0] * inv, o[db][4 * g + 1] * inv); w.y = pk2(o[db][4 * g + 2] * inv, o[db][4 * g + 3] * inv);
            *(u32x2*)(op + 32 * db + 8 * g) = w; }
}

__device__ __forceinline__ void phase_attention(PP p, LAS unsigned char* lds, int chunk, int layer) {
    int tid_ = threadIdx.x; OPAQUE_V(tid_); const int tid = tid_, lane = tid & 63, wave = __builtin_amdgcn_readfirstlane(tid >> 6);
    const bf16_t* proj = (const bf16_t*)(p->ws + WS_PROJ);
    const bf16_t* vta = (const bf16_t*)(p->ws + WS_VTA);
    const bf16_t* vtb = (const bf16_t*)(p->ws + WS_VTB);
    const bf16_t* kba = (const bf16_t*)(p->ws + WS_KBA); const bf16_t* kbb = (const bf16_t*)(p->ws + WS_KBB);
    bf16_t* oa = (bf16_t*)(p->ws + WS_OA); bf16_t* ob = (bf16_t*)(p->ws + WS_OB); bf16_t* oc = (bf16_t*)(p->ws + WS_OC);
    bf16_t* og = (bf16_t*)(p->ws + WS_OG); float* lseb = (float*)(p->ws + WS_LSE);
    const bf16_t* memk = (const bf16_t*)(p->ws + WS_MEMK) + (size_t)layer * NBATCH * NMEM * 512;
    const bf16_t* memvt = (const bf16_t*)(p->ws + WS_MEMVT) + (size_t)layer * NBATCH * NMEM * 512;
    constexpr int NT_B = CB * 4 * 4, NT_A = CB * 8 * 8, NT_C = CB * 4 * 8;
    for (int task = blockIdx.x; task < NT_B + NT_A + NT_C; task += gridDim.x) {
        if (task < NT_B) {
            const int bl = task >> 4, hh = (task >> 2) & 3, sp = task & 3;
            for (int wt = wave; wt < 32; wt += NWAVES) {
                const int g = wt < 8 ? 0 : (wt < 16 ? 1 : 2), tq = wt < 16 ? (wt & 7) : (wt - 16), sh = 2 * g, dil = 1 << sh, L = SEQ >> sh, hb = 4 * g + hh;
                int c, m0;
                if (g == 0) { c = 0; m0 = sp * 512 + 64 * tq; } else if (g == 1) { c = tq >> 1; m0 = sp * 128 + 64 * (tq & 1); } else { c = tq; m0 = sp * 32; }
                AttnTask t;
                const size_t rowb = (size_t)bl * SEQ + c;
                t.q = proj + rowb * INW + 768 + hb * 64; t.qstride = (long)dil * INW;
                t.kb = kbb + (size_t)(bl * 12 + hb) * 64 * SEQ + (size_t)c * L * 64; t.vb = vtb + (size_t)(bl * 12 + hb) * 64 * SEQ + (size_t)c * L * 64;
                t.o = og + (size_t)g * MC * 256 + rowb * 256 + hh * 64; t.ostride = (long)dil * 256;
                t.lse = lseb + (size_t)g * MC * 4 + rowb * 4 + hh; t.lsestride = (long)dil * 4;
                t.m0 = m0; t.L = L; t.W = 64; t.m_init = -1e30f; t.l_init = 0.f; t.scale2 = 0.125f * LOG2E;
                if (g == 2) attn_wave<64, true, true, 1>(t, lds + wave * 8192, lane); else attn_wave<64, true, true, 2>(t, lds + wave * 8192, lane);
            }
            __syncthreads();
            {
                const size_t row = (size_t)bl * SEQ + sp * 512 + tid;
                const float l0 = lseb[row * 4 + hh], l1 = lseb[(size_t)MC * 4 + row * 4 + hh], l2 = lseb[(size_t)2 * MC * 4 + row * 4 + hh];
                const float mx = fmaxf(l0, fmaxf(l1, l2));
                float a0 = fexp2((l0 - mx) * LOG2E), a1 = fexp2((l1 - mx) * LOG2E), a2 = fexp2((l2 - mx) * LOG2E);
                const float is = 1.f / (a0 + a1 + a2); a0 *= is; a1 *= is; a2 *= is;
                const bf16_t* s0 = og + row * 256 + hh * 64; const bf16_t* s1 = s0 + (size_t)MC * 256; const bf16_t* s2 = s1 + (size_t)MC * 256;
                bf16_t* dp = ob + row * 256 + hh * 64;
#pragma unroll
                for (int j = 0; j < 8; ++j) { const u32x4 x0 = *(const u32x4*)(s0 + 8 * j), x1 = *(const u32x4*)(s1 + 8 * j), x2 = *(const u32x4*)(s2 + 8 * j);
                    u32x4 w;
                    w.x = pk2(a0 * bf2f(x0.x & 0xffffu) + a1 * bf2f(x1.x & 0xffffu) + a2 * bf2f(x2.x & 0xffffu), a0 * bf2f(x0.x >> 16) + a1 * bf2f(x1.x >> 16) + a2 * bf2f(x2.x >> 16));
                    w.y = pk2(a0 * bf2f(x0.y & 0xffffu) + a1 * bf2f(x1.y & 0xffffu) + a2 * bf2f(x2.y & 0xffffu), a0 * bf2f(x0.y >> 16) + a1 * bf2f(x1.y >> 16) + a2 * bf2f(x2.y >> 16));
                    w.z = pk2(a0 * bf2f(x0.z & 0xffffu) + a1 * bf2f(x1.z & 0xffffu) + a2 * bf2f(x2.z & 0xffffu), a0 * bf2f(x0.z >> 16) + a1 * bf2f(x1.z >> 16) + a2 * bf2f(x2.z >> 16));
                    w.w = pk2(a0 * bf2f(x0.w & 0xffffu) + a1 * bf2f(x1.w & 0xffffu) + a2 * bf2f(x2.w & 0xffffu), a0 * bf2f(x0.w >> 16) + a1 * bf2f(x1.w >> 16) + a2 * bf2f(x2.w >> 16));
                    *(u32x4*)(dp + 8 * j) = w; }
            }
            __syncthreads();
        } else
        if (task < NT_B + NT_A) {
            const int ta = task - NT_B, bl = ta >> 6, ha = (ta >> 3) & 7, sp = ta & 7;
            AttnTask t;
            const size_t rowb = (size_t)bl * SEQ;
            t.q = proj + rowb * INW + ha * 64; t.qstride = INW;
            t.kb = kba + (size_t)(bl * 2 + (ha >> 2)) * 64 * SEQ; t.vb = vta + (size_t)(bl * 2 + (ha >> 2)) * 64 * SEQ;
            t.o = oa + rowb * 512 + ha * 64; t.ostride = 512; t.lse = nullptr; t.lsestride = 0;
            t.m0 = sp * 256 + 32 * wave; t.L = SEQ; t.W = 128; t.m_init = p->sink_a[layer * 8 + ha] * LOG2E; t.l_init = 1.f; t.scale2 = 0.125f * LOG2E;
            const int kt0 = 8 * sp - 4;
            {
                const char* ks = (const char*)t.kb + (long)kt0 * 4096; const char* vs = (const char*)t.vb + (long)kt0 * 4096;
                u32x4 tmp[16];
#pragma unroll
                for (int i = 0; i < 8; ++i) { const int c = tid + 512 * i, kt = kt0 + (c >> 8); const bool ok = kt >= 0 && kt < SEQ / 32;
                    tmp[i] = ok ? *(const u32x4*)(ks + (long)c * 16) : (u32x4){0u, 0u, 0u, 0u}; tmp[8 + i] = ok ? *(const u32x4*)(vs + (long)c * 16) : (u32x4){0u, 0u, 0u, 0u}; }
#pragma unroll
                for (int i = 0; i < 8; ++i) { *(LAS u32x4*)(lds + (tid + 512 * i) * 16) = tmp[i]; *(LAS u32x4*)(lds + 65536 + (tid + 512 * i) * 16) = tmp[8 + i]; }
            }
            __syncthreads();
            attn_wave_win_lds(t, lds, kt0, lane);
            __syncthreads();
        } else {
            const int tc = task - NT_B - NT_A, bl = tc >> 5, hc = (tc >> 3) & 3, sp = tc & 7, bg = chunk * CB + bl;
            AttnTask t;
            const size_t rowb = (size_t)bl * SEQ;
            t.q = proj + rowb * INW + 3072 + hc * 128; t.qstride = INW;
            t.kb = memk + (size_t)(bg * 4 + hc) * 128 * NMEM; t.vb = memvt + (size_t)(bg * 4 + hc) * 128 * NMEM;
            t.o = oc + rowb * 512 + hc * 128; t.ostride = 512; t.lse = nullptr; t.lsestride = 0;
            t.m0 = sp * 256 + 32 * wave; t.L = NMEM; t.W = 0; t.m_init = -1e30f; t.l_init = 0.f; t.scale2 = 0.08838834764831845f * LOG2E;
            {
                const u32x4* ks = (const u32x4*)t.kb; const u32x4* vs = (const u32x4*)t.vb;
                u32x4 tmp[16];
#pragma unroll
                for (int i = 0; i < 8; ++i) { tmp[i] = ks[tid + 512 * i]; tmp[8 + i] = vs[tid + 512 * i]; }
#pragma unroll
                for (int i = 0; i < 8; ++i) { *(LAS u32x4*)(lds + (tid + 512 * i) * 16) = tmp[i]; *(LAS u32x4*)(lds + 65536 + (tid + 512 * i) * 16) = tmp[8 + i]; }
            }
            __syncthreads();
            attn_wave_mem_lds(t, lds, lane);
            __syncthreads();
        }
    }
}

#define XB_TMO      128
#define XB_XCNT(j)  (256  + 64 * (j))
#define XB_XSUB(j)  (1280 + 64 * (j))
#define XB_XGEN(j)  (2304 + 64 * (j))
#define XB_TOP      3328
#define XB_TOPGEN   3392
#define XCD_BAR_WORDS 3456
#define XB_SPIN_CAP (1u << 18)

__device__ __forceinline__ unsigned xb_ld(unsigned* p)              { return __hip_atomic_load(p, __ATOMIC_RELAXED, __HIP_MEMORY_SCOPE_AGENT); }
__device__ __forceinline__ unsigned xb_add(unsigned* p, unsigned v) { return __hip_atomic_fetch_add(p, v, __ATOMIC_RELAXED, __HIP_MEMORY_SCOPE_AGENT); }
__device__ __forceinline__ unsigned xb_xcc_id() { return (unsigned)__builtin_amdgcn_s_getreg((3 << 11) | 20) & 0xFu; }
#define XB_SPIN(cond, bar) do { unsigned _sp = 0; while (cond) { __builtin_amdgcn_s_sleep(1); \
    if ((++_sp & 255u) == 0u) { if (xb_ld(&(bar)[XB_TMO])) break; if (_sp > XB_SPIN_CAP) { atomicAdd(&(bar)[XB_TMO], 1u); break; } } } } while (0)
struct XcdBarrier {
    unsigned* bar; unsigned x;
    volatile LAS unsigned* st;
};

__device__ __forceinline__ XcdBarrier xcd_barrier_post(unsigned* bar, volatile LAS unsigned* st) {
    XcdBarrier b; b.bar = bar; b.x = xb_xcc_id(); b.st = st;
    if (threadIdx.x == 0) (void)xb_add(&bar[XB_XCNT(b.x)], 1u);
    return b;
}
__device__ __forceinline__ void xcd_barrier_complete(unsigned* bar, unsigned x, unsigned& nloc, unsigned& nx) {
    const unsigned G = gridDim.x * gridDim.y * gridDim.z;
    unsigned sum, cnt, mine, sp = 0u;
    for (;;) {
        sum = 0u; cnt = 0u; mine = 0u;
#pragma unroll
        for (unsigned j = 0; j < 16; ++j) { const unsigned c = xb_ld(&bar[XB_XCNT(j)]); sum += c; cnt += (c > 0u) ? 1u : 0u; mine = (j == x) ? c : mine; }
        if (sum == G) break;
        __builtin_amdgcn_s_sleep(1);
        if ((++sp & 255u) == 0u) { if (xb_ld(&bar[XB_TMO])) break; if (sp > XB_SPIN_CAP) { atomicAdd(&bar[XB_TMO], 1u); break; } }
    }
    nloc = mine > 0u ? mine : 1u; nx = cnt > 0u ? cnt : 1u;
}

__device__ __forceinline__ void xcd_barrier(const XcdBarrier& b) {
    asm volatile("s_waitcnt vmcnt(0)" ::: "memory");
    __syncthreads();
    if (threadIdx.x == 0) {
        unsigned* bar = b.bar;
        __builtin_amdgcn_s_waitcnt(0);
        unsigned nloc = b.st[0], nx = b.st[1];
        if (nloc == 0u) { xcd_barrier_complete(bar, b.x, nloc, nx); b.st[0] = nloc; b.st[1] = nx; }
        const unsigned old = xb_add(&bar[XB_XSUB(b.x)], 1u);
        const unsigned gen = old / nloc;
        if (old + 1u == (gen + 1u) * nloc) {
            __builtin_amdgcn_fence(__ATOMIC_RELEASE, "agent");
            asm volatile("s_waitcnt vmcnt(0)" ::: "memory");
            const unsigned og = xb_add(&bar[XB_TOP], 1u);
            const unsigned tg = og / nx;
            if (og + 1u == (tg + 1u) * nx) xb_add(&bar[XB_TOPGEN], 1u);
            else XB_SPIN(xb_ld(&bar[XB_TOPGEN]) == tg, bar);
            __builtin_amdgcn_fence(__ATOMIC_ACQUIRE, "agent");
            xb_add(&bar[XB_XGEN(b.x)], 1u);
            asm volatile("s_waitcnt vmcnt(0)" ::: "memory");
        } else {
            XB_SPIN(xb_ld(&bar[XB_XGEN(b.x)]) == gen, bar);
            __builtin_amdgcn_fence(__ATOMIC_ACQUIRE, "agent");
            asm volatile("s_waitcnt vmcnt(0)" ::: "memory");
        }
    }
    __syncthreads();
}


constexpr int STEPS_PER_CHUNK = 1 + DEPTH * 8, N_STEPS = 2 + NCHUNK * STEPS_PER_CHUNK;
__device__ __forceinline__ void run_step(PP p, LAS unsigned char* lds, int s) {
    bf16_t* WT = (bf16_t*)(p->ws + WS_WT);
    if (s == 0) { phase_prologue_a(p, lds); return; }
    if (s == 1) {
        for (int l = 0; l < DEPTH; ++l) { EpiMemKV E; E.mk = (bf16_t*)(p->ws + WS_MEMK) + (size_t)l * NBATCH * NMEM * 512; E.mvt = (bf16_t*)(p->ws + WS_MEMVT) + (size_t)l * NBATCH * NMEM * 512;
            run_gemm(lds, (const bf16_t*)(p->ws + WS_MEMN) + (size_t)l * NBATCH * NMEM * DM, WT + (size_t)l * WL + WO_MKV, NBATCH * NMEM, 1024, DM, E, 64 * l); }
        return;
    }
    const int s2 = s - 2, chunk = s2 / STEPS_PER_CHUNK, r = s2 % STEPS_PER_CHUNK;
    if (r == 0) { phase_rows_first(p, chunk); return; }
    const int l = (r - 1) >> 3, ph = (r - 1) & 7;
    const bf16_t* wl = WT + (size_t)l * WL;
    bf16_t* H = (bf16_t*)(p->ws + WS_H); bf16_t* proj = (bf16_t*)(p->ws + WS_PROJ); bf16_t* mrg = (bf16_t*)(p->ws + WS_MRG);
    switch (ph) {
    case 0: { EpiIn E; E.proj = proj; E.vta = (bf16_t*)(p->ws + WS_VTA); E.vtb = (bf16_t*)(p->ws + WS_VTB); E.kba = (bf16_t*)(p->ws + WS_KBA); E.kbb = (bf16_t*)(p->ws + WS_KBB); E.rope = (const float*)(p->ws + WS_ROPE);
        run_gemm(lds, H, wl + WO_IN, MC, INW, DM, E, 0); } break;
    case 1: phase_attention(p, lds, chunk, l); break;
    case 2: {
        EpiGate E; E.mrg = mrg;
        E.gate = proj + 3584; E.accum = 0; run_gemm<EpiGate, GATE_FAST>(lds, (const bf16_t*)(p->ws + WS_OA), wl + WO_OA, MC, DM, 512, E, 0);
        E.gate = proj + 3584 + 1024; E.accum = 1; run_gemm<EpiGate, GATE_FAST>(lds, (const bf16_t*)(p->ws + WS_OB), wl + WO_OB, MC, DM, 256, E, 0);
        E.gate = proj + 3584 + 2048; E.accum = 1; run_gemm<EpiGate, GATE_FAST>(lds, (const bf16_t*)(p->ws + WS_OC), wl + WO_OC, MC, DM, 512, E, 0);
        } break;
    case 3: { EpiY E; E.Y = (bf16_t*)(p->ws + WS_Y); run_gemm(lds, mrg, wl + WO_OUT, MC, DM, DM, E, 0); } break;
    case 4: phase_rows_resid(p, chunk, l == 0, p->g_mix_post + l * DM, p->g_ffn_pre + l * DM, true); break;
    case 5: { EpiSwiGLU E; E.act = (bf16_t*)(p->ws + WS_ACT); run_gemm(lds, H, wl + WO_FIN, MC, 2 * FFH, DM, E, 0); } break;
    case 6: { EpiY E; E.Y = (bf16_t*)(p->ws + WS_Y); run_gemm(lds, (const bf16_t*)(p->ws + WS_ACT), wl + WO_FOUT, MC, DM, FFH, E, 0); } break;
    default: phase_rows_resid(p, chunk, false, p->g_ffn_post + l * DM, p->g_mix_pre + (l < DEPTH - 1 ? l + 1 : l) * DM, l < DEPTH - 1); break;
    }
}

__global__ void __launch_bounds__(NTHREADS, 2) fwd_megakernel(Params p) {
    extern __shared__ __attribute__((aligned(16))) unsigned char lds_raw[];
    LAS unsigned char* lds = (LAS unsigned char*)lds_raw;
    cg::grid_group grid = cg::this_grid();
    PP pp = (PP)__builtin_amdgcn_kernarg_segment_ptr();
    const int s_hi = pp->s_hi;
    __shared__ uint4 xb_words;
    if (threadIdx.x == 0) xb_words = make_uint4(0u, 0u, 0u, 0u);
    __syncthreads();
    const XcdBarrier xbar = xcd_barrier_post((unsigned*)(pp->ws + WS_BAR), (volatile LAS unsigned*)&xb_words);
    const int s_lo = pp->s_lo;
    for (int s = s_lo; s < s_hi; ++s) {
        PP q = pp; OPAQUE_S(q);
        run_step(q, lds, s);
        if (s + 1 < s_hi) { if (s == s_lo) grid.sync(); else xcd_barrier(xbar); }
    }
}

extern "C" void kernel_launch(void* const* d_in, const int* in_sizes, int n_in, void* d_out, int out_size, void* d_ws, size_t ws_size, hipStream_t stream) {
    static int grid_blocks = 0;
    if (grid_blocks == 0) {
        if (n_in != 18 || out_size != NBATCH * SEQ * DM || ws_size < WS_END) { fprintf(stderr, "kernel_launch: unexpected shapes / workspace (n_in %d out %d ws %zu need %zu)\n", n_in, out_size, ws_size, (size_t)WS_END); grid_blocks = -1; return; }
        int dev = 0, cus = 0, per_cu = 0;
        hipGetDevice(&dev);
        hipDeviceGetAttribute(&cus, hipDeviceAttributeMultiprocessorCount, dev);
        if (hipFuncSetAttribute((const void*)fwd_megakernel, hipFuncAttributeMaxDynamicSharedMemorySize, LDS_BYTES) != hipSuccess) { fprintf(stderr, "kernel_launch: hipFuncSetAttribute failed\n"); grid_blocks = -1; return; }
        hipOccupancyMaxActiveBlocksPerMultiprocessor(&per_cu, (const void*)fwd_megakernel, NTHREADS, LDS_BYTES);
        if (per_cu < 1) { fprintf(stderr, "kernel_launch: occupancy query says %d blocks per CU\n", per_cu); per_cu = 1; }
        (void)hipGetLastError();
        grid_blocks = cus * 1;
    }
    if (grid_blocks < 0) return;
    if (hipMemsetAsync((char*)d_ws + WS_BAR, 0, 16384, stream) != hipSuccess) { fprintf(stderr, "kernel_launch: hipMemsetAsync failed\n"); return; }
    Params p{};
    p.x_prompt = (const float*)d_in[0]; p.x_sample = (const float*)d_in[1]; p.mem_prompt = (const float*)d_in[2]; p.mem_sample = (const float*)d_in[3];
    p.g_mix_pre = (const float*)d_in[4]; p.g_mix_post = (const float*)d_in[5]; p.g_mem = (const float*)d_in[6]; p.w_in = (const float*)d_in[7];
    p.sink_a = (const float*)d_in[8]; p.w_mem_kv = (const float*)d_in[9]; p.w_o_a = (const float*)d_in[10]; p.w_o_b = (const float*)d_in[11];
    p.w_o_c = (const float*)d_in[12]; p.w_out = (const float*)d_in[13]; p.g_ffn_pre = (const float*)d_in[14]; p.g_ffn_post = (const float*)d_in[15];
    p.w_ffn_in = (const float*)d_in[16]; p.w_ffn_out = (const float*)d_in[17];
    p.out = (float*)d_out; p.ws = (unsigned char*)d_ws;
    for (int j = 0; j < 8; ++j) p.inv_freq[j] = powf(500000.0f, -(float)(2 * j) / 16.0f);
#if MK_MULTI_LAUNCH
    for (int s = 0; s < N_STEPS; ++s) {
        p.s_lo = s; p.s_hi = s + 1;
        hipLaunchKernelGGL(fwd_megakernel, dim3(grid_blocks), dim3(NTHREADS), LDS_BYTES, stream, p);
    }
#else
    p.s_lo = 0; p.s_hi = N_STEPS;
    void* args[] = {&p};
    hipError_t e = hipLaunchCooperativeKernel((const void*)fwd_megakernel, dim3(grid_blocks), dim3(NTHREADS), args, LDS_BYTES, stream);
    if (e != hipSuccess) fprintf(stderr, "kernel_launch: cooperative launch failed: %s (grid %d)\n", hipGetErrorString(e), grid_blocks);
#endif
}
```

```cpp
#include <hip/hip_runtime.h>
#include <hip/hip_cooperative_groups.h>
#include <cstdio>
#include <cstdint>
#include <cmath>
namespace cg = cooperative_groups;
#ifndef MK_MULTI_LAUNCH
#define MK_MULTI_LAUNCH 0
#endif
namespace pg8 {
#define PG8_LAS __attribute__((address_space(3)))
typedef unsigned short bf16_t;
typedef short bf16x8 __attribute__((ext_vector_type(8)));
typedef float f32x4 __attribute__((ext_vector_type(4)));
typedef unsigned u32x4 __attribute__((ext_vector_type(4)));
constexpr int BM = 256, BK = 64, HALF = 128, HTB = HALF * BK * 2  , STAGE_BYTES = 8 * HTB, NXCD = 8, WGM = 8;

__host__ __device__ __forceinline__ int lds_byte(int r, int c) { const int st = (r >> 4) * 2 + (c >> 5), rr = r & 15, cc = c & 31, ob = rr * 64 + cc * 2; return st * 1024 + (ob ^ (((ob >> 9) & 1) << 5)); }
__host__ __device__ __forceinline__ void stage_rc(int b, int& R, int& C) { const int st = b / 1024, sb = b % 1024, swz = sb ^ (((sb >> 9) & 1) << 5); R = (st >> 1) * 16 + swz / 64; C = (st & 1) * 32 + (swz % 64) / 2; }
__host__ __device__ __forceinline__ int perm32(int rho) { const int n = rho >> 4, i = rho & 15; return 8 * (i >> 2) + 4 * n + (i & 3); }

struct Unit { int pm, pn; };
struct Gemm { const bf16_t* A; const bf16_t* Bt; int M, N, K; };

struct StaticOrder {
    int nM, nN, nwg, G, c, wgm;
    __host__ __device__ void init(int M, int N, int G_, int c_, int wgm_ = WGM) { nM = M / BM; nN = N / BM; nwg = nM * nN; G = G_; c = c_; wgm = wgm_; }
    __host__ __device__ bool next(int i, Unit& u) const {
        const long L = (long)i * G + c; if (L >= nwg) return false;
        int wgid = (int)L; { const int q = nwg / NXCD, r = nwg % NXCD, xcd = wgid % NXCD, off = wgid / NXCD; wgid = (xcd < r ? xcd * (q + 1) : r * (q + 1) + (xcd - r) * q) + off; }
        const int nig = wgm * nN, gid = wgid / nig, fm = gid * wgm, gsz = (nM - fm) < wgm ? (nM - fm) : wgm;
        u.pm = fm + ((wgid % nig) % gsz); u.pn = (wgid % nig) / gsz; return true;
    }
    __device__ __forceinline__ void a_ready(const Unit&) const {}
    __device__ __forceinline__ void done(const Unit&) const {}
};
__device__ __forceinline__ unsigned cvt_pk_bf16(float lo, float hi) { unsigned r; asm volatile("v_cvt_pk_bf16_f32 %0, %1, %2" : "=v"(r) : "v"(lo), "v"(hi)); return r; }
typedef float f32x2 __attribute__((ext_vector_type(2)));
template <class Epi, class Sched, bool ALIGN_EPI = false, bool SP2 = false>
__device__ __forceinline__ void gemm_phase(PG8_LAS unsigned char* lds, const Gemm g, const Sched& S, const Epi& E) {
    int tid_ = threadIdx.x; asm volatile("" : "+v"(tid_)); const int tid = tid_, wid = __builtin_amdgcn_readfirstlane(tid >> 6), lane = tid & 63, wr = wid >> 2, wc = wid & 3, fr = lane & 15, fq = lane >> 4;
    const int K = g.K, nt = K / BK;
    unsigned voffA[2], voffB[2];
#pragma unroll
    for (int i = 0; i < 2; ++i) { int R, C; stage_rc(tid * 16 + i * 8192, R, C); const int Rb = Epi::PERM ? ((R & ~31) + perm32(R & 31)) : R;
        voffA[i] = (unsigned)(R * K + C) * 2u; voffB[i] = (unsigned)(Rb * K + C) * 2u; }
    const size_t kstep = (size_t)(BK * 2);
    const size_t hstep = (size_t)HALF * K * 2;
    const size_t tstep = 2 * hstep;
    const unsigned ldsw = (unsigned)wid * 1024u;
    const int aoff = lds_byte(wr * 64 + fr, fq * 8), boff = lds_byte(wc * 32 + fr, fq * 8);
#define PG8_SA(b, h) (((b) * 2 + (h)) * HTB)
#define PG8_SB(b, h) ((4 + (b) * 2 + (h)) * HTB)
#define PG8_STAGE(bufoff, gbase, voff) do { _Pragma("unroll") for (int _i = 0; _i < 2; ++_i) \
        __builtin_amdgcn_global_load_lds((const unsigned*)((const char*)(gbase) + (voff)[_i]), (PG8_LAS unsigned*)(lds + (bufoff) + ldsw + _i * 8192), 16, 0, 0); } while (0)
#define PG8_LDA(dst, b, h) do { _Pragma("unroll") for (int m = 0; m < 4; ++m) _Pragma("unroll") for (int k = 0; k < 2; ++k) dst[m][k] = *(const PG8_LAS bf16x8*)(lds + PG8_SA(b, h) + aoff + m * 2048 + k * 1024); } while (0)
#define PG8_LDB(dst, b, h) do { _Pragma("unroll") for (int n = 0; n < 2; ++n) _Pragma("unroll") for (int k = 0; k < 2; ++k) dst[n][k] = *(const PG8_LAS bf16x8*)(lds + PG8_SB(b, h) + boff + n * 2048 + k * 1024); } while (0)
#define PG8_MMA(ai, bj, At, Bt) do { __builtin_amdgcn_s_setprio(1); _Pragma("unroll") for (int m = 0; m < 4; ++m) _Pragma("unroll") for (int n = 0; n < 2; ++n) _Pragma("unroll") for (int k = 0; k < 2; ++k) \
        acc[ai][bj][m][n] = __builtin_amdgcn_mfma_f32_16x16x32_bf16(Bt[n][k], At[m][k], acc[ai][bj][m][n], 0, 0, 0); __builtin_amdgcn_s_setprio(0); } while (0)
#define PG8_WAIT_V(n) asm volatile("s_waitcnt vmcnt(" #n ")" ::: "memory")
#define PG8_WAIT_L(n) asm volatile("s_waitcnt lgkmcnt(" #n ")" ::: "memory")
#define PG8_BAR __builtin_amdgcn_s_barrier()
#define PG8_SCHED __builtin_amdgcn_sched_barrier(0)
    Unit cur, nxt; int ui = 0;
    if (!S.next(0, cur)) return;
    f32x4 acc[2][2][4][2];
#pragma unroll
    for (int a = 0; a < 2; ++a)
#pragma unroll
        for (int b = 0; b < 2; ++b)
#pragma unroll
            for (int m = 0; m < 4; ++m)
#pragma unroll
                for (int n = 0; n < 2; ++n) acc[a][b][m][n] = (f32x4){0.f, 0.f, 0.f, 0.f};
    bf16x8 At[4][2], B0[2][2], B1[2][2];
    const char* cA = (const char*)g.A + (size_t)cur.pm * tstep; const char* cB = (const char*)g.Bt + (size_t)cur.pn * tstep;
    S.a_ready(cur);
    if constexpr (SP2) {
        PG8_STAGE(PG8_SB(0, 0), cB, voffB); PG8_STAGE(PG8_SB(0, 1), cB + hstep, voffB); PG8_STAGE(PG8_SA(0, 0), cA, voffA); PG8_STAGE(PG8_SA(0, 1), cA + hstep, voffA);
        if (wr == 1) PG8_BAR;
        PG8_WAIT_V(2); PG8_BAR;
        PG8_STAGE(PG8_SB(1, 0), cB + kstep, voffB); PG8_STAGE(PG8_SA(1, 0), cA + kstep, voffA); PG8_STAGE(PG8_SB(1, 1), cB + hstep + kstep, voffB);
        PG8_WAIT_V(6); PG8_BAR;
    } else {
        PG8_STAGE(PG8_SB(0, 0), cB, voffB); PG8_STAGE(PG8_SA(0, 0), cA, voffA); PG8_STAGE(PG8_SB(0, 1), cB + hstep, voffB); PG8_STAGE(PG8_SA(0, 1), cA + hstep, voffA);
        if (wr == 1) PG8_BAR;
        PG8_WAIT_V(4); PG8_BAR;
        PG8_STAGE(PG8_SB(1, 0), cB + kstep, voffB); PG8_STAGE(PG8_SA(1, 0), cA + kstep, voffA); PG8_STAGE(PG8_SB(1, 1), cB + hstep + kstep, voffB);
        PG8_WAIT_V(6); PG8_BAR;
    }
    for (;;) {
        const bool has_next = S.next(ui + 1, nxt);
        const char* nA = has_next ? (const char*)g.A + (size_t)nxt.pm * tstep : cA; const char* nB = has_next ? (const char*)g.Bt + (size_t)nxt.pn * tstep : cB;
        for (int t = 0; t < nt; t += 2) {
            const bool last = (t == nt - 2);
            const char* a1 = cA + (size_t)(t + 1) * kstep;
            const char* a2 = last ? nA : cA + (size_t)(t + 2) * kstep; const char* b2 = last ? nB : cB + (size_t)(t + 2) * kstep;
            const char* a3 = a2 + kstep; const char* b3 = b2 + kstep;
            if (last && has_next) S.a_ready(nxt);
            if constexpr (SP2) {
            PG8_LDB(B0, 0, 0); PG8_LDB(B1, 0, 1); PG8_SCHED; PG8_LDA(At, 0, 0); PG8_STAGE(PG8_SA(1, 1), a1 + hstep, voffA);
            PG8_WAIT_V(8); PG8_WAIT_L(0); PG8_BAR; PG8_MMA(0, 0, At, B0); PG8_MMA(0, 1, At, B1); PG8_BAR; PG8_SCHED;
            PG8_LDA(At, 0, 1); PG8_STAGE(PG8_SB(0, 0), b2, voffB); PG8_STAGE(PG8_SB(0, 1), b2 + hstep, voffB); PG8_STAGE(PG8_SA(0, 0), a2, voffA);
            PG8_WAIT_V(8); PG8_WAIT_L(0); PG8_BAR; PG8_MMA(1, 0, At, B0); PG8_MMA(1, 1, At, B1); PG8_BAR; PG8_SCHED;
            PG8_LDB(B0, 1, 0); PG8_LDB(B1, 1, 1); PG8_SCHED; PG8_LDA(At, 1, 0); PG8_STAGE(PG8_SA(0, 1), a2 + hstep, voffA);
            PG8_WAIT_V(8); PG8_WAIT_L(0); PG8_BAR; PG8_MMA(0, 0, At, B0); PG8_MMA(0, 1, At, B1); PG8_BAR; PG8_SCHED;
            PG8_LDA(At, 1, 1); PG8_STAGE(PG8_SB(1, 0), b3, voffB); PG8_STAGE(PG8_SB(1, 1), b3 + hstep, voffB); PG8_STAGE(PG8_SA(1, 0), a3, voffA);
            PG8_WAIT_V(8); PG8_WAIT_L(0); PG8_BAR; PG8_MMA(1, 0, At, B0); PG8_MMA(1, 1, At, B1); PG8_BAR; PG8_SCHED;
            } else {
            PG8_LDB(B0, 0, 0); PG8_SCHED; PG8_LDA(At, 0, 0); PG8_STAGE(PG8_SA(1, 1), a1 + hstep, voffA);
            PG8_WAIT_L(8); PG8_BAR; PG8_WAIT_L(0); PG8_MMA(0, 0, At, B0); PG8_BAR; PG8_SCHED;
            PG8_LDB(B1, 0, 1); PG8_STAGE(PG8_SB(0, 0), b2, voffB);
            PG8_BAR; PG8_WAIT_L(0); PG8_MMA(0, 1, At, B1); PG8_BAR;
            PG8_LDA(At, 0, 1); PG8_STAGE(PG8_SA(0, 0), a2, voffA);
            PG8_BAR; PG8_WAIT_L(0); PG8_MMA(1, 0, At, B0); PG8_BAR; PG8_SCHED;
            PG8_STAGE(PG8_SB(0, 1), b2 + hstep, voffB);
            PG8_WAIT_V(6); PG8_BAR; PG8_MMA(1, 1, At, B1); PG8_BAR;
            PG8_LDB(B0, 1, 0); PG8_SCHED; PG8_LDA(At, 1, 0); PG8_STAGE(PG8_SA(0, 1), a2 + hstep, voffA);
            PG8_WAIT_L(8); PG8_BAR; PG8_WAIT_L(0); PG8_MMA(0, 0, At, B0); PG8_BAR; PG8_SCHED;
            PG8_LDB(B1, 1, 1); PG8_STAGE(PG8_SB(1, 0), b3, voffB);
            PG8_BAR; PG8_WAIT_L(0); PG8_MMA(0, 1, At, B1); PG8_BAR;
            PG8_LDA(At, 1, 1); PG8_STAGE(PG8_SA(1, 0), a3, voffA);
            PG8_BAR; PG8_WAIT_L(0); PG8_MMA(1, 0, At, B0); PG8_BAR; PG8_SCHED;
            PG8_STAGE(PG8_SB(1, 1), b3 + hstep, voffB);
            PG8_WAIT_V(6); PG8_BAR; PG8_MMA(1, 1, At, B1); PG8_BAR;
            }
        }
        if constexpr (ALIGN_EPI) { if (wr == 0) PG8_BAR; }
        if constexpr (!Epi::AFTER_DRAIN) { E(acc, cur, wr, wc, fr, fq); S.done(cur); }
        if (!has_next) break;
#pragma unroll
        for (int a = 0; a < 2; ++a)
#pragma unroll
            for (int b = 0; b < 2; ++b)
#pragma unroll
                for (int m = 0; m < 4; ++m)
#pragma unroll
                    for (int n = 0; n < 2; ++n) acc[a][b][m][n] = (f32x4){0.f, 0.f, 0.f, 0.f};
        cur = nxt; cA = nA; cB = nB; ++ui;
        if constexpr (ALIGN_EPI) { if (wr == 1) PG8_BAR; }
    }
    PG8_WAIT_V(0);
    if constexpr (!ALIGN_EPI) { if (wr == 0) PG8_BAR; }
    PG8_BAR;
    if constexpr (Epi::AFTER_DRAIN) { E.fused(acc, cur, wr, wc, fr, fq, lds, wid, lane); S.done(cur); }
#undef PG8_SA
#undef PG8_SB
#undef PG8_STAGE
#undef PG8_LDA
#undef PG8_LDB
#undef PG8_MMA
#undef PG8_WAIT_V
#undef PG8_WAIT_L
#undef PG8_BAR
#undef PG8_SCHED
}
}

using pg8::bf16_t; using pg8::bf16x8; using pg8::f32x4; using pg8::u32x4;
typedef float f32x16 __attribute__((ext_vector_type(16)));
typedef unsigned u32x2 __attribute__((ext_vector_type(2)));
#define LAS __attribute__((address_space(3)))
constexpr int NTHREADS = 512, NWAVES = 8, LDS_BYTES = pg8::STAGE_BYTES;
constexpr int DM = 1024, SEQ = 2048, NBATCH = 48, DEPTH = 4, NMEM = 256, INW = 6656, FFH = 2816;
constexpr int CB = 16, MC = CB * SEQ, NCHUNK = NBATCH / CB;
constexpr float EPS = 1e-6f, LOG2E = 1.4426950408889634f, LN2 = 0.6931471805599453f;
constexpr size_t WO_IN = 0, WO_MKV = WO_IN + (size_t)INW * DM, WO_OA = WO_MKV + (size_t)1024 * DM, WO_OB = WO_OA + (size_t)1024 * 512, WO_OC = WO_OB + (size_t)1024 * 256,
                 WO_OUT = WO_OC + (size_t)1024 * 512, WO_FIN = WO_OUT + (size_t)1024 * 1024, WO_FOUT = WO_FIN + (size_t)2 * FFH * DM, WL = WO_FOUT + (size_t)DM * FFH;
constexpr size_t al256(size_t x) { return (x + 255) & ~(size_t)255; }
constexpr size_t WS_WT = 0;
constexpr size_t WS_ROPE = al256(WS_WT + WL * DEPTH * 2);
constexpr size_t WS_MEMK = al256(WS_ROPE + (size_t)SEQ * 8 * 8);
constexpr size_t WS_MEMVT = al256(WS_MEMK + (size_t)DEPTH * NBATCH * NMEM * 512 * 2);
constexpr size_t WS_H = al256(WS_MEMVT + (size_t)DEPTH * NBATCH * NMEM * 512 * 2);
constexpr size_t WS_PROJ = al256(WS_H + (size_t)MC * DM * 2);
constexpr size_t WS_VTA = al256(WS_PROJ + (size_t)MC * INW * 2);
constexpr size_t WS_VTB = al256(WS_VTA + (size_t)CB * 2 * 64 * SEQ * 2);
constexpr size_t WS_OA = al256(WS_VTB + (size_t)CB * 12 * 64 * SEQ * 2);
constexpr size_t WS_OB = al256(WS_OA + (size_t)MC * 512 * 2);
constexpr size_t WS_OC = al256(WS_OB + (size_t)MC * 256 * 2);
constexpr size_t WS_MRG = al256(WS_OC + (size_t)MC * 512 * 2);
constexpr size_t WS_KBA = al256(WS_MRG + (size_t)MC * DM * 2);
constexpr size_t WS_KBB = al256(WS_KBA + (size_t)CB * 2 * 64 * SEQ * 2);
constexpr size_t WS_BAR = al256(WS_KBB + (size_t)CB * 12 * 64 * SEQ * 2);
constexpr size_t WS_END = al256(WS_BAR + 16384);
constexpr size_t WS_MEMN = WS_PROJ;
constexpr size_t WS_Y = WS_PROJ;
constexpr size_t WS_ACT = WS_PROJ + (size_t)MC * DM * 4;
constexpr size_t WS_OG = WS_MRG;
constexpr size_t WS_LSE = WS_MRG + (size_t)3 * MC * 256 * 2;
static_assert((size_t)DEPTH * NBATCH * NMEM * DM * 2 <= (size_t)MC * INW * 2, "memn overlay");
static_assert((size_t)MC * DM * 4 + (size_t)MC * FFH * 2 <= (size_t)MC * INW * 2, "y/act overlay");
static_assert((size_t)3 * MC * 256 * 2 + (size_t)3 * MC * 4 * 4 <= (size_t)MC * DM * 2, "og overlay");

struct Params {
    const float *x_prompt, *x_sample, *mem_prompt, *mem_sample, *g_mix_pre, *g_mix_post, *g_mem, *w_in, *sink_a, *w_mem_kv, *w_o_a, *w_o_b, *w_o_c, *w_out,
                *g_ffn_pre, *g_ffn_post, *w_ffn_in, *w_ffn_out;
    float* out; unsigned char* ws;
    float inv_freq[8];
    int s_lo, s_hi;
};

typedef const __attribute__((address_space(4))) Params* PP;
#define OPAQUE_V(x) asm volatile("" : "+v"(x))
#define OPAQUE_S(x) asm volatile("" : "+s"(x))
__device__ __forceinline__ float bf2f(unsigned b) { return __uint_as_float(b << 16); }
typedef __bf16 bf16x2v __attribute__((ext_vector_type(2)));
typedef float f32x2v __attribute__((ext_vector_type(2)));
__device__ __forceinline__ unsigned pk2(float lo, float hi) { const f32x2v v = {lo, hi}; return __builtin_bit_cast(unsigned, __builtin_convertvector(v, bf16x2v)); }
__device__ __forceinline__ float wave_sum(float v) {
#pragma unroll
    for (int o = 32; o > 0; o >>= 1) v += __shfl_xor(v, o);
    return v;
}
__device__ __forceinline__ float fexp2(float x) { return __builtin_amdgcn_exp2f(x); }
__device__ __forceinline__ float frcp(float x) { return __builtin_amdgcn_rcpf(x); }
__device__ __forceinline__ float sigmoidf_(float x) { return frcp(1.f + fexp2(-x * LOG2E)); }
#define LDS_WAIT() asm volatile("s_waitcnt lgkmcnt(0)" ::: "memory")

__device__ __forceinline__ int src_col_in(int n) {
    const bool qk = (n < 640) || (n >= 768 && n < 2304);
    const int p = n & 63;
    return (qk && p < 16) ? (n - p) + (p >> 1) + 8 * (p & 1) : n;
}
__device__ __forceinline__ int src_col_ffin(int n) { const int q = n >> 3, e = n & 7; return e < 4 ? 4 * q + e : FFH + 4 * q + (e - 4); }

template <int PERMT>
__device__ __forceinline__ void transpose_item(const float* W, int K, int N, bf16_t* WT, LAS float* scr, int item, int lane) {
    const int nblk = N / 32, kb = item / nblk, nb = item % nblk, k0 = 64 * kb, n0 = 32 * nb;
    const int nd = n0 + (lane & 31);
    const int ns = PERMT == 1 ? src_col_in(nd) : (PERMT == 2 ? src_col_ffin(nd) : nd);
#pragma unroll 8
    for (int i = 0; i < 32; ++i) { const int kk = 2 * i + (lane >> 5); scr[kk * 33 + (lane & 31)] = __builtin_nontemporal_load(W + (size_t)(k0 + kk) * N + ns); }
    LDS_WAIT();
    const int c = lane & 7;
#pragma unroll
    for (int j = 0; j < 4; ++j) { const int n = (lane >> 3) + 8 * j; const LAS float* s = scr + (8 * c) * 33 + n;
        u32x4 o; o.x = pk2(s[0 * 33], s[1 * 33]); o.y = pk2(s[2 * 33], s[3 * 33]); o.z = pk2(s[4 * 33], s[5 * 33]); o.w = pk2(s[6 * 33], s[7 * 33]);
        *(u32x4*)(WT + (size_t)(n0 + n) * K + k0 + 8 * c) = o; }
    LDS_WAIT();
}

__device__ __forceinline__ void phase_prologue_a(PP p, LAS unsigned char* lds) {
    int tid_ = threadIdx.x; OPAQUE_V(tid_); const int tid = tid_, lane = tid & 63, wave = __builtin_amdgcn_readfirstlane(tid >> 6);
    const int gw = blockIdx.x * NWAVES + wave, NGW = gridDim.x * NWAVES;
    LAS float* scr = (LAS float*)(lds + wave * 16384);
    bf16_t* WT = (bf16_t*)(p->ws + WS_WT);
    constexpr int I_IN = 16 * (INW / 32), I_MKV = 16 * 32, I_OA = 8 * 32, I_OB = 4 * 32, I_OC = 8 * 32, I_OUT = 16 * 32, I_FIN = 16 * (2 * FFH / 32), I_FOUT = (FFH / 64) * 32;
    constexpr int I_L = I_IN + I_MKV + I_OA + I_OB + I_OC + I_OUT + I_FIN + I_FOUT;
    for (int it = gw; it < I_L * DEPTH; it += NGW) {
        const int l = it / I_L; int r = it % I_L;
        bf16_t* wl = WT + (size_t)l * WL;
        if (r < I_IN) { transpose_item<1>(p->w_in + (size_t)l * DM * INW, DM, INW, wl + WO_IN, scr, r, lane); continue; } r -= I_IN;
        if (r < I_MKV) { transpose_item<0>(p->w_mem_kv + (size_t)l * DM * 1024, DM, 1024, wl + WO_MKV, scr, r, lane); continue; } r -= I_MKV;
        if (r < I_OA) { transpose_item<0>(p->w_o_a + (size_t)l * 512 * DM, 512, DM, wl + WO_OA, scr, r, lane); continue; } r -= I_OA;
        if (r < I_OB) { transpose_item<0>(p->w_o_b + (size_t)l * 256 * DM, 256, DM, wl + WO_OB, scr, r, lane); continue; } r -= I_OB;
        if (r < I_OC) { transpose_item<0>(p->w_o_c + (size_t)l * 512 * DM, 512, DM, wl + WO_OC, scr, r, lane); continue; } r -= I_OC;
        if (r < I_OUT) { transpose_item<0>(p->w_out + (size_t)l * DM * DM, DM, DM, wl + WO_OUT, scr, r, lane); continue; } r -= I_OUT;
        if (r < I_FIN) { transpose_item<2>(p->w_ffn_in + (size_t)l * DM * 2 * FFH, DM, 2 * FFH, wl + WO_FIN, scr, r, lane); continue; } r -= I_FIN;
        transpose_item<0>(p->w_ffn_out + (size_t)l * FFH * DM, FFH, DM, wl + WO_FOUT, scr, r, lane);
    }
    float2* rope = (float2*)(p->ws + WS_ROPE);
    for (int i = blockIdx.x * NTHREADS + tid; i < SEQ * 8; i += gridDim.x * NTHREADS) {
        const int pos = i >> 3, j = i & 7;
        const float ang = (float)pos * p->inv_freq[j];
        const double rev = (double)ang * 0.15915494309189535;
        const float fr = (float)(rev - rint(rev));
        rope[i] = make_float2(__builtin_amdgcn_cosf(fr), __builtin_amdgcn_sinf(fr));
    }
    bf16_t* memn = (bf16_t*)(p->ws + WS_MEMN);
    for (int R = gw; R < NBATCH * NMEM; R += NGW) {
        const float* src = (R < 16 * NMEM) ? p->mem_prompt + (size_t)R * DM : p->mem_sample + (size_t)(R - 16 * NMEM) * DM;
        f32x4 v[4]; float ss = 0.f;
#pragma unroll
        for (int j = 0; j < 4; ++j) { v[j] = *(const f32x4*)(src + 4 * (lane + 64 * j)); ss += v[j].x * v[j].x + v[j].y * v[j].y + v[j].z * v[j].z + v[j].w * v[j].w; }
        const float rstd = 1.f / sqrtf(wave_sum(ss) * (1.f / DM) + EPS);
#pragma unroll
        for (int l = 0; l < DEPTH; ++l)
#pragma unroll
            for (int j = 0; j < 4; ++j) { const f32x4 g = *(const f32x4*)(p->g_mem + l * DM + 4 * (lane + 64 * j));
                u32x2 o; o.x = pk2(v[j].x * rstd * g.x, v[j].y * rstd * g.y); o.y = pk2(v[j].z * rstd * g.z, v[j].w * rstd * g.w);
                *(u32x2*)(memn + ((size_t)l * NBATCH * NMEM + R) * DM + 4 * (lane + 64 * j)) = o; }
    }
}

__device__ __forceinline__ const float* x_in_row(PP p, int GR) { return GR < 16 * SEQ ? p->x_prompt + (size_t)GR * DM : p->x_sample + (size_t)(GR - 16 * SEQ) * DM; }

__device__ __forceinline__ void phase_rows_first(PP p, int chunk) {
    int tid_ = threadIdx.x; OPAQUE_V(tid_); const int lane = tid_ & 63, wave = __builtin_amdgcn_readfirstlane(tid_ >> 6);
    bf16_t* H = (bf16_t*)(p->ws + WS_H);
    for (int r = blockIdx.x * NWAVES + wave; r < MC; r += gridDim.x * NWAVES) {
        const float* src = x_in_row(p, chunk * MC + r);
        f32x4 v[4]; float ss = 0.f;
#pragma unroll
        for (int j = 0; j < 4; ++j) { v[j] = *(const f32x4*)(src + 4 * (lane + 64 * j)); ss += v[j].x * v[j].x + v[j].y * v[j].y + v[j].z * v[j].z + v[j].w * v[j].w; }
        const float rstd = 1.f / sqrtf(wave_sum(ss) * (1.f / DM) + EPS);
#pragma unroll
        for (int j = 0; j < 4; ++j) { const f32x4 g = *(const f32x4*)(p->g_mix_pre + 4 * (lane + 64 * j));
            u32x2 o; o.x = pk2(v[j].x * rstd * g.x, v[j].y * rstd * g.y); o.y = pk2(v[j].z * rstd * g.z, v[j].w * rstd * g.w);
            *(u32x2*)(H + (size_t)r * DM + 4 * (lane + 64 * j)) = o; }
    }
}
struct RowBuf { f32x4 x[4]; u32x2 y[4]; };
__device__ __forceinline__ void row_load(RowBuf& b, const bf16_t* yrow, const float* xrow, int lane) {
#pragma unroll
    for (int j = 0; j < 4; ++j) { b.y[j] = __builtin_nontemporal_load((const u32x2*)(yrow + 4 * (lane + 64 * j))); b.x[j] = __builtin_nontemporal_load((const f32x4*)(xrow + 4 * (lane + 64 * j))); }
}
__device__ __forceinline__ void row_process(RowBuf& b, float* dst, bf16_t* hrow, const float* g_post, const float* g_next, bool write_h, int lane) {
    f32x4 y[4]; float ss = 0.f;
#pragma unroll
    for (int j = 0; j < 4; ++j) { y[j].x = bf2f(b.y[j].x & 0xffffu); y[j].y = bf2f(b.y[j].x >> 16); y[j].z = bf2f(b.y[j].y & 0xffffu); y[j].w = bf2f(b.y[j].y >> 16);
        ss += y[j].x * y[j].x + y[j].y * y[j].y + y[j].z * y[j].z + y[j].w * y[j].w; }
    const float ry = 1.f / sqrtf(wave_sum(ss) * (1.f / DM) + EPS);
    float sx = 0.f;
#pragma unroll
    for (int j = 0; j < 4; ++j) { const f32x4 g = *(const f32x4*)(g_post + 4 * (lane + 64 * j)); f32x4 x = b.x[j];
        x.x += y[j].x * ry * g.x; x.y += y[j].y * ry * g.y; x.z += y[j].z * ry * g.z; x.w += y[j].w * ry * g.w;
        __builtin_nontemporal_store(x, (f32x4*)(dst + 4 * (lane + 64 * j))); b.x[j] = x;
        sx += x.x * x.x + x.y * x.y + x.z * x.z + x.w * x.w; }
    if (write_h) {
        const float rx = 1.f / sqrtf(wave_sum(sx) * (1.f / DM) + EPS);
#pragma unroll
        for (int j = 0; j < 4; ++j) { const f32x4 g = *(const f32x4*)(g_next + 4 * (lane + 64 * j)); const f32x4 x = b.x[j];
            u32x2 o; o.x = pk2(x.x * rx * g.x, x.y * rx * g.y); o.y = pk2(x.z * rx * g.z, x.w * rx * g.w);
            *(u32x2*)(hrow + 4 * (lane + 64 * j)) = o; }
    }
}
__device__ __forceinline__ void phase_rows_resid(PP p, int chunk, bool src_is_input, const float* g_post, const float* g_next, bool write_h) {
    int tid_ = threadIdx.x; OPAQUE_V(tid_); const int lane = tid_ & 63, wave = __builtin_amdgcn_readfirstlane(tid_ >> 6);
    bf16_t* H = (bf16_t*)(p->ws + WS_H);
    const bf16_t* Y = (const bf16_t*)(p->ws + WS_Y);
    float* out = p->out;
    const int stride = gridDim.x * NWAVES;
    int r = blockIdx.x * NWAVES + wave;
    if (r >= MC) return;
    RowBuf A, B;
#define ROW_SRC(rr) (src_is_input ? x_in_row(p, chunk * MC + (rr)) : out + (size_t)(chunk * MC + (rr)) * DM)
    row_load(A, Y + (size_t)r * DM, ROW_SRC(r), lane);
    for (;;) {
        const int r1 = r + stride;
        if (r1 < MC) row_load(B, Y + (size_t)r1 * DM, ROW_SRC(r1), lane);
        row_process(A, out + (size_t)(chunk * MC + r) * DM, H + (size_t)r * DM, g_post, g_next, write_h, lane);
        if (r1 >= MC) break;
        const int r2 = r1 + stride;
        if (r2 < MC) row_load(A, Y + (size_t)r2 * DM, ROW_SRC(r2), lane);
        row_process(B, out + (size_t)(chunk * MC + r1) * DM, H + (size_t)r1 * DM, g_post, g_next, write_h, lane);
        if (r2 >= MC) break;
        r = r2;
    }
#undef ROW_SRC
}

__device__ __forceinline__ int pi32(int r) { return (r & 0x13) | ((r & 4) << 1) | ((r & 8) >> 1); }
template <int D> __device__ __forceinline__ size_t kblk_off(int p, int c8) { const int kt = p >> 5, r = pi32(p & 31); return ((size_t)(kt * (D / 16) + (c8 >> 1)) * 64 + (c8 & 1) * 32 + r) * 8; }
template <int D> __device__ __forceinline__ size_t vblk_off(int p, int d) { const int kt = p >> 5, w = p & 31; return ((((size_t)kt * (D / 32) + (d >> 5)) * 2 + (w >> 4)) * 64 + ((w >> 3) & 1) * 32 + (d & 31)) * 8 + (w & 7); }
template <int D> __device__ __forceinline__ void store8_vblk(bf16_t* img, int p, int d0, const f32x4& a, const f32x4& b) {
    const unsigned o0 = pk2(a.x, a.y), o1 = pk2(a.z, a.w), o2 = pk2(b.x, b.y), o3 = pk2(b.z, b.w);
    bf16_t* base = img + vblk_off<D>(p, d0);
    base[0] = (bf16_t)(o0 & 0xffffu); base[8] = (bf16_t)(o0 >> 16); base[16] = (bf16_t)(o1 & 0xffffu); base[24] = (bf16_t)(o1 >> 16);
    base[32] = (bf16_t)(o2 & 0xffffu); base[40] = (bf16_t)(o2 >> 16); base[48] = (bf16_t)(o3 & 0xffffu); base[56] = (bf16_t)(o3 >> 16);
}
__device__ __forceinline__ u32x4 pack8(const f32x4& a, const f32x4& b) { u32x4 o; o.x = pk2(a.x, a.y); o.y = pk2(a.z, a.w); o.z = pk2(b.x, b.y); o.w = pk2(b.z, b.w); return o; }
__device__ __forceinline__ void store8_strided(bf16_t* base, size_t stride, const f32x4& a, const f32x4& b) {
    const u32x4 o = pack8(a, b);
    base[0 * stride] = (bf16_t)(o.x & 0xffffu); base[1 * stride] = (bf16_t)(o.x >> 16); base[2 * stride] = (bf16_t)(o.y & 0xffffu); base[3 * stride] = (bf16_t)(o.y >> 16);
    base[4 * stride] = (bf16_t)(o.z & 0xffffu); base[5 * stride] = (bf16_t)(o.z >> 16); base[6 * stride] = (bf16_t)(o.w & 0xffffu); base[7 * stride] = (bf16_t)(o.w >> 16);
}
struct EpiIn {
    static constexpr bool PERM = true, AFTER_DRAIN = false;
    bf16_t* proj; bf16_t* vta; bf16_t* vtb; bf16_t* kba; bf16_t* kbb; const float* rope;
    __device__ __forceinline__ void operator()(const f32x4 (&acc)[2][2][4][2], const pg8::Unit& u, int wr, int wc, int fr, int fq) const {
        const int row0 = u.pm * 256 + wr * 64 + fr;
#pragma unroll
        for (int bj = 0; bj < 2; ++bj) {
            const int c128 = u.pn * 256 + bj * 128, cb = c128 + wc * 32 + 8 * fq;
            if (c128 >= 3584) {
#pragma unroll
                for (int ai = 0; ai < 2; ++ai)
#pragma unroll
                    for (int m = 0; m < 4; ++m) { const int row = row0 + ai * 128 + m * 16; f32x4 a = acc[ai][bj][m][0], b = acc[ai][bj][m][1];
                        a.x = sigmoidf_(a.x); a.y = sigmoidf_(a.y); a.z = sigmoidf_(a.z); a.w = sigmoidf_(a.w); b.x = sigmoidf_(b.x); b.y = sigmoidf_(b.y); b.z = sigmoidf_(b.z); b.w = sigmoidf_(b.w);
                        __builtin_nontemporal_store(pack8(a, b), (u32x4*)(proj + (size_t)row * INW + cb)); }
            } else if (c128 >= 3072) {
#pragma unroll
                for (int ai = 0; ai < 2; ++ai)
#pragma unroll
                    for (int m = 0; m < 4; ++m) { const int row = row0 + ai * 128 + m * 16; __builtin_nontemporal_store(pack8(acc[ai][bj][m][0], acc[ai][bj][m][1]), (u32x4*)(proj + (size_t)row * INW + cb)); }
            } else if (c128 == 640) {
                const int kvh = (cb - 640) >> 6, d0 = (cb - 640) & 63;
#pragma unroll
                for (int ai = 0; ai < 2; ++ai)
#pragma unroll
                    for (int m = 0; m < 4; ++m) { const int row = row0 + ai * 128 + m * 16, bl = row >> 11, pos = row & 2047;
                        store8_vblk<64>(vta + (size_t)(bl * 2 + kvh) * 64 * SEQ, pos, d0, acc[ai][bj][m][0], acc[ai][bj][m][1]); }
            } else if (c128 >= 2304) {
                const int hb = (cb - 2304) >> 6, d0 = (cb - 2304) & 63, sh = 2 * (hb >> 2);
#pragma unroll
                for (int ai = 0; ai < 2; ++ai)
#pragma unroll
                    for (int m = 0; m < 4; ++m) { const int row = row0 + ai * 128 + m * 16, bl = row >> 11, pos = row & 2047;
                        const int pg = (pos & ((1 << sh) - 1)) * (SEQ >> sh) + (pos >> sh);
                        store8_vblk<64>(vtb + (size_t)(bl * 12 + hb) * 64 * SEQ, pg, d0, acc[ai][bj][m][0], acc[ai][bj][m][1]); }
            } else {
                const bool rp = ((wc & 1) == 0) && (fq < 2);
#pragma unroll
                for (int ai = 0; ai < 2; ++ai)
#pragma unroll
                    for (int m = 0; m < 4; ++m) { const int row = row0 + ai * 128 + m * 16; f32x4 a = acc[ai][bj][m][0], b = acc[ai][bj][m][1];
                        if (rp) { const int pos = row & 2047; const f32x4* t = (const f32x4*)(rope + (size_t)pos * 16 + 8 * fq); const f32x4 t0 = t[0], t1 = t[1];
                            f32x4 a2, b2;
                            a2.x = a.x * t0.x - a.y * t0.y; a2.y = a.y * t0.x + a.x * t0.y; a2.z = a.z * t0.z - a.w * t0.w; a2.w = a.w * t0.z + a.z * t0.w;
                            b2.x = b.x * t1.x - b.y * t1.y; b2.y = b.y * t1.x + b.x * t1.y; b2.z = b.z * t1.z - b.w * t1.w; b2.w = b.w * t1.z + b.z * t1.w;
                            a = a2; b = b2; }
                        if (c128 == 512) {
                            const int bl = row >> 11, pos = row & 2047, kvh = (cb - 512) >> 6, c8 = ((cb - 512) & 63) >> 3;
                            *(u32x4*)(kba + (size_t)(bl * 2 + kvh) * 64 * SEQ + kblk_off<64>(pos, c8)) = pack8(a, b);
                        } else if (c128 >= 1536) {
                            const int bl = row >> 11, pos = row & 2047, hb = (cb - 1536) >> 6, c8 = ((cb - 1536) & 63) >> 3, sh = 2 * (hb >> 2);
                            const int pg = (pos & ((1 << sh) - 1)) * (SEQ >> sh) + (pos >> sh);
                            *(u32x4*)(kbb + (size_t)(bl * 12 + hb) * 64 * SEQ + kblk_off<64>(pg, c8)) = pack8(a, b);
                        } else __builtin_nontemporal_store(pack8(a, b), (u32x4*)(proj + (size_t)row * INW + cb)); }
            }
        }
    }
};
struct EpiMemKV {
    static constexpr bool PERM = true, AFTER_DRAIN = false;
    bf16_t* mk; bf16_t* mvt;
    __device__ __forceinline__ void operator()(const f32x4 (&acc)[2][2][4][2], const pg8::Unit& u, int wr, int wc, int fr, int fq) const {
        const int row0 = u.pm * 256 + wr * 64 + fr;
#pragma unroll
        for (int bj = 0; bj < 2; ++bj) {
            const int c128 = u.pn * 256 + bj * 128, cb = c128 + wc * 32 + 8 * fq;
            if (c128 < 512) {
#pragma unroll
                for (int ai = 0; ai < 2; ++ai)
#pragma unroll
                    for (int m = 0; m < 4; ++m) { const int row = row0 + ai * 128 + m * 16, b = row >> 8, j = row & 255, hc = cb >> 7, c8 = (cb & 127) >> 3;
                        *(u32x4*)(mk + (size_t)(b * 4 + hc) * 128 * NMEM + kblk_off<128>(j, c8)) = pack8(acc[ai][bj][m][0], acc[ai][bj][m][1]); }
            } else {
                const int hc = (cb - 512) >> 7, d0 = (cb - 512) & 127;
#pragma unroll
                for (int ai = 0; ai < 2; ++ai)
#pragma unroll
                    for (int m = 0; m < 4; ++m) { const int row = row0 + ai * 128 + m * 16, b = row >> 8, j = row & 255;
                        store8_vblk<128>(mvt + (size_t)(b * 4 + hc) * 128 * NMEM, j, d0, acc[ai][bj][m][0], acc[ai][bj][m][1]); }
            }
        }
    }
};
struct EpiGate {
    static constexpr bool PERM = true, AFTER_DRAIN = false;
    const bf16_t* gate; bf16_t* mrg; int accum;
    __device__ __forceinline__ void operator()(const f32x4 (&acc)[2][2][4][2], const pg8::Unit& u, int wr, int wc, int fr, int fq) const {
        const int row0 = u.pm * 256 + wr * 64 + fr, cb0 = u.pn * 256 + wc * 32 + 8 * fq;
#pragma unroll
        for (int ai = 0; ai < 2; ++ai) {
            u32x4 g[4][2], o[4][2];
#pragma unroll
            for (int m = 0; m < 4; ++m)
#pragma unroll
                for (int bj = 0; bj < 2; ++bj) g[m][bj] = __builtin_nontemporal_load((const u32x4*)(gate + (size_t)(row0 + ai * 128 + m * 16) * INW + cb0 + bj * 128));
            if (accum) {
#pragma unroll
                for (int m = 0; m < 4; ++m)
#pragma unroll
                    for (int bj = 0; bj < 2; ++bj) o[m][bj] = *(const u32x4*)(mrg + (size_t)(row0 + ai * 128 + m * 16) * DM + cb0 + bj * 128);
            }
#pragma unroll
            for (int m = 0; m < 4; ++m)
#pragma unroll
                for (int bj = 0; bj < 2; ++bj) {
                    const u32x4 gg = g[m][bj];
                    f32x4 a = acc[ai][bj][m][0], b = acc[ai][bj][m][1];
                    a.x *= bf2f(gg.x & 0xffffu); a.y *= bf2f(gg.x >> 16); a.z *= bf2f(gg.y & 0xffffu); a.w *= bf2f(gg.y >> 16);
                    b.x *= bf2f(gg.z & 0xffffu); b.y *= bf2f(gg.z >> 16); b.z *= bf2f(gg.w & 0xffffu); b.w *= bf2f(gg.w >> 16);
                    if (accum) { const u32x4 oo = o[m][bj];
                        a.x += bf2f(oo.x & 0xffffu); a.y += bf2f(oo.x >> 16); a.z += bf2f(oo.y & 0xffffu); a.w += bf2f(oo.y >> 16);
                        b.x += bf2f(oo.z & 0xffffu); b.y += bf2f(oo.z >> 16); b.z += bf2f(oo.w & 0xffffu); b.w += bf2f(oo.w >> 16); }
                    *(u32x4*)(mrg + (size_t)(row0 + ai * 128 + m * 16) * DM + cb0 + bj * 128) = pack8(a, b);
                }
        }
    }
};
struct EpiY {
    static constexpr bool PERM = true, AFTER_DRAIN = false;
    bf16_t* Y;
    __device__ __forceinline__ void operator()(const f32x4 (&acc)[2][2][4][2], const pg8::Unit& u, int wr, int wc, int fr, int fq) const {
        const int row0 = u.pm * 256 + wr * 64 + fr;
#pragma unroll
        for (int ai = 0; ai < 2; ++ai)
#pragma unroll
            for (int m = 0; m < 4; ++m)
#pragma unroll
                for (int bj = 0; bj < 2; ++bj)
                    *(u32x4*)(Y + (size_t)(row0 + ai * 128 + m * 16) * DM + u.pn * 256 + bj * 128 + wc * 32 + 8 * fq) = pack8(acc[ai][bj][m][0], acc[ai][bj][m][1]);
    }
};
struct EpiSwiGLU {
    static constexpr bool PERM = true, AFTER_DRAIN = false;
    bf16_t* act;
    __device__ __forceinline__ void operator()(const f32x4 (&acc)[2][2][4][2], const pg8::Unit& u, int wr, int wc, int fr, int fq) const {
        const int row0 = u.pm * 256 + wr * 64 + fr;
#pragma unroll
        for (int ai = 0; ai < 2; ++ai)
#pragma unroll
            for (int m = 0; m < 4; ++m)
#pragma unroll
                for (int bj = 0; bj < 2; ++bj) { const int cb = u.pn * 256 + bj * 128 + wc * 32 + 8 * fq; const f32x4 g = acc[ai][bj][m][0], v = acc[ai][bj][m][1];
                    u32x2 o; o.x = pk2(g.x * sigmoidf_(g.x) * v.x, g.y * sigmoidf_(g.y) * v.y); o.y = pk2(g.z * sigmoidf_(g.z) * v.z, g.w * sigmoidf_(g.w) * v.w);
                    *(u32x2*)(act + (size_t)(row0 + ai * 128 + m * 16) * FFH + (cb >> 1)) = o; }
    }
};
#ifndef GATE_FAST
#define GATE_FAST true
#endif
template <class Epi, bool FAST = true>
__device__ __forceinline__ void run_gemm(LAS unsigned char* lds, const bf16_t* A, const bf16_t* Bt, int M, int N, int K, const Epi& E, int crot) {
    pg8::Gemm g; g.A = A; g.Bt = Bt; g.M = M; g.N = N; g.K = K;
#ifndef WGM_WIDE
#define WGM_WIDE 4
#endif
#ifndef WGM_NARROW
#define WGM_NARROW 8
#endif
    pg8::StaticOrder S; S.init(M, N, (int)gridDim.x, (int)((blockIdx.x + crot) % gridDim.x), N > 1024 ? WGM_WIDE : WGM_NARROW);
    pg8::gemm_phase<Epi, pg8::StaticOrder, FAST, FAST>(lds, g, S, E);
}

struct AttnTask {
    const bf16_t* q; long qstride;
    const bf16_t* kb; const bf16_t* vb;
    bf16_t* o; long ostride;
    float* lse; long lsestride;
    int m0, L, W;
    float m_init, l_init, scale2;
};
template <int D>
__device__ __forceinline__ void attn_load_k(bf16x8 (&kf)[D / 16], const AttnTask& t, int k0, int lane) {
    const bf16_t* kp = t.kb + ((size_t)(k0 >> 5) * (D / 16) * 64 + lane) * 8;
#pragma unroll
    for (int kk = 0; kk < D / 16; ++kk) kf[kk] = *(const bf16x8*)(kp + kk * 512);
}
template <int D>
__device__ __forceinline__ void attn_load_v(bf16x8 (&vf)[D / 32][2], const AttnTask& t, int k0, int lane) {
    const bf16_t* vp = t.vb + ((size_t)(k0 >> 5) * (D / 32) * 128 + lane) * 8;
#pragma unroll
    for (int db = 0; db < D / 32; ++db)
#pragma unroll
        for (int s = 0; s < 2; ++s) vf[db][s] = *(const bf16x8*)(vp + (db * 2 + s) * 512);
}
__device__ __forceinline__ float xhalf_max(float v) { const auto r = __builtin_amdgcn_permlane32_swap(__float_as_uint(v), __float_as_uint(v), false, false); return fmaxf(__uint_as_float(r[0]), __uint_as_float(r[1])); }
__device__ __forceinline__ float xhalf_sum(float v) { const auto r = __builtin_amdgcn_permlane32_swap(__float_as_uint(v), __float_as_uint(v), false, false); return __uint_as_float(r[0]) + __uint_as_float(r[1]); }
template <int D, bool MASK>
__device__ __forceinline__ void attn_tile(const bf16x8 (&qf)[D / 16], const bf16x8 (&kf)[D / 16], const bf16x8 (&vf)[D / 32][2], f32x16 (&o)[D / 32], float& mrun, float& lrun,
                                          const AttnTask& t, int k0, int mq, int qi, int h) {
    f32x16 sc;
#pragma unroll
    for (int i = 0; i < 16; ++i) sc[i] = 0.f;
#pragma unroll
    for (int kk = 0; kk < D / 16; ++kk) sc = __builtin_amdgcn_mfma_f32_32x32x16_bf16(kf[kk], qf[kk], sc, 0, 0, 0);
    if (MASK) {
        if (k0 == mq - t.W || k0 == mq + t.W) {
#pragma unroll
            for (int i = 0; i < 16; ++i) { const int dlt = k0 + 16 * (i >> 3) + 8 * h + (i & 7) - qi; sc[i] = (dlt <= t.W && dlt >= -t.W) ? sc[i] : -1e30f; }
        }
    }
    float mt = sc[0];
#pragma unroll
    for (int i = 1; i < 16; ++i) mt = fmaxf(mt, sc[i]);
    mt = xhalf_max(mt) * t.scale2;
    const float mn = fmaxf(mrun, mt), alpha = fexp2(mrun - mn);
    float ps = 0.f;
#pragma unroll
    for (int i = 0; i < 16; ++i) { sc[i] = fexp2(__builtin_fmaf(sc[i], t.scale2, -mn)); ps += sc[i]; }
    ps = xhalf_sum(ps);
    lrun = lrun * alpha + ps; mrun = mn;
#pragma unroll
    for (int db = 0; db < D / 32; ++db)
#pragma unroll
        for (int i = 0; i < 16; ++i) o[db][i] *= alpha;
    bf16x8 pf[2];
#pragma unroll
    for (int s = 0; s < 2; ++s) { u32x4 w; w.x = pk2(sc[8 * s + 0], sc[8 * s + 1]); w.y = pk2(sc[8 * s + 2], sc[8 * s + 3]); w.z = pk2(sc[8 * s + 4], sc[8 * s + 5]); w.w = pk2(sc[8 * s + 6], sc[8 * s + 7]);
        pf[s] = __builtin_bit_cast(bf16x8, w); }
#pragma unroll
    for (int db = 0; db < D / 32; ++db)
#pragma unroll
        for (int s = 0; s < 2; ++s) o[db] = __builtin_amdgcn_mfma_f32_32x32x16_bf16(vf[db][s], pf[s], o[db], 0, 0, 0);
}
template <int D, bool MASK, bool PFV, int NQ>
__device__ __forceinline__ void attn_wave(const AttnTask& t, LAS unsigned char* scr, int lane) {
    const int r = lane & 31, h = lane >> 5;
    bf16x8 qf[NQ][D / 16];
#pragma unroll
    for (int q = 0; q < NQ; ++q) { const bf16_t* qp = t.q + (long)(t.m0 + 32 * q + r) * t.qstride + 8 * h;
#pragma unroll
        for (int kk = 0; kk < D / 16; ++kk) qf[q][kk] = *(const bf16x8*)(qp + 16 * kk); }
    f32x16 o[NQ][D / 32];
    float mrun[NQ], lrun[NQ];
#pragma unroll
    for (int q = 0; q < NQ; ++q) { mrun[q] = t.m_init; lrun[q] = t.l_init;
#pragma unroll
        for (int db = 0; db < D / 32; ++db)
#pragma unroll
            for (int i = 0; i < 16; ++i) o[q][db][i] = 0.f; }
    int klo = 0, khi = t.L;
    if (MASK) { klo = t.m0 - t.W; if (klo < 0) klo = 0; khi = t.m0 + 32 * NQ + t.W; if (khi > t.L) khi = t.L; }
    bf16x8 ka[D / 16], kb[D / 16], va[D / 32][2], vb[D / 32][2];
    attn_load_k<D>(ka, t, klo, lane);
    attn_load_v<D>(va, t, klo, lane);
#define ATT_TILES(KF, VF, K0) do { _Pragma("unroll") for (int q = 0; q < NQ; ++q) { const int mq = t.m0 + 32 * q; \
        if (!MASK || NQ == 1 || ((K0) >= mq - t.W && (K0) <= mq + t.W)) attn_tile<D, MASK>(qf[q], KF, VF, o[q], mrun[q], lrun[q], t, (K0), mq, mq + r, h); } } while (0)
    for (int k0 = klo; k0 < khi; k0 += 64) {
        const int k1 = k0 + 32, k2 = (k0 + 64 < khi) ? k0 + 64 : klo;
        const bool has1 = k1 < khi;
        attn_load_k<D>(kb, t, has1 ? k1 : klo, lane);
        if (PFV) attn_load_v<D>(vb, t, has1 ? k1 : klo, lane);
        __builtin_amdgcn_sched_barrier(0);
        ATT_TILES(ka, va, k0);
        __builtin_amdgcn_sched_barrier(0);
        if (!has1) break;
        if (!PFV) attn_load_v<D>(vb, t, k1, lane);
        attn_load_k<D>(ka, t, k2, lane);
        if (PFV) attn_load_v<D>(va, t, k2, lane);
        __builtin_amdgcn_sched_barrier(0);
        ATT_TILES(kb, vb, k1);
        __builtin_amdgcn_sched_barrier(0);
        if (!PFV) attn_load_v<D>(va, t, k2, lane);
    }
#undef ATT_TILES
#pragma unroll
    for (int q = 0; q < NQ; ++q) {
        const int qi = t.m0 + 32 * q + r;
        const float inv = 1.f / lrun[q];
        constexpr int RS = 2 * D + 16;
#pragma unroll
        for (int db = 0; db < D / 32; ++db)
#pragma unroll
            for (int g = 0; g < 4; ++g) { u32x2 w; w.x = pk2(o[q][db][4 * g + 0] * inv, o[q][db][4 * g + 1] * inv); w.y = pk2(o[q][db][4 * g + 2] * inv, o[q][db][4 * g + 3] * inv);
                *(LAS u32x2*)(scr + r * RS + (32 * db + 8 * g + 4 * h) * 2) = w; }
        LDS_WAIT();
        constexpr int CPR = D / 8, RPI = 64 / CPR;
#pragma unroll
        for (int it = 0; it < 32 / RPI; ++it) { const int row = it * RPI + lane / CPR, ch = lane % CPR;
            const u32x4 v = *(const LAS u32x4*)(scr + row * RS + ch * 16);
            *(u32x4*)(t.o + (long)(t.m0 + 32 * q + row) * t.ostride + ch * 8) = v; }
        LDS_WAIT();
        if (t.lse != nullptr && h == 0) t.lse[(long)qi * t.lsestride] = (mrun[q] + __builtin_amdgcn_logf(lrun[q])) * LN2;
    }
}

__device__ __forceinline__ void attn_wave_mem_lds(const AttnTask& t, LAS unsigned char* lds, int lane) {
    constexpr int D = 128;
    const int r = lane & 31, h = lane >> 5;
    bf16x8 qf[D / 16];
    const bf16_t* qp = t.q + (long)(t.m0 + r) * t.qstride + 8 * h;
#pragma unroll
    for (int kk = 0; kk < D / 16; ++kk) qf[kk] = *(const bf16x8*)(qp + 16 * kk);
    f32x16 o[D / 32];
#pragma unroll
    for (int db = 0; db < D / 32; ++db)
#pragma unroll
        for (int i = 0; i < 16; ++i) o[db][i] = 0.f;
    float mrun = t.m_init, lrun = t.l_init;
    const int qi = t.m0 + r;
    for (int kt = 0; kt < NMEM / 32; ++kt) {
        bf16x8 kf[D / 16], vf[D / 32][2];
#pragma unroll
        for (int kk = 0; kk < D / 16; ++kk) kf[kk] = *(const LAS bf16x8*)(lds + ((kt * (D / 16) + kk) * 64 + lane) * 16);
#pragma unroll
        for (int db = 0; db < D / 32; ++db)
#pragma unroll
            for (int s = 0; s < 2; ++s) vf[db][s] = *(const LAS bf16x8*)(lds + 65536 + (((kt * (D / 32) + db) * 2 + s) * 64 + lane) * 16);
        attn_tile<D, false>(qf, kf, vf, o, mrun, lrun, t, kt * 32, t.m0, qi, h);
    }
    const float inv = 1.f / lrun;
    bf16_t* op = t.o + (long)qi * t.ostride + 4 * h;
#pragma unroll
    for (int db = 0; db < D / 32; ++db)
#pragma unroll
        for (int g = 0; g < 4; ++g) { u32x2 w; w.x = pk2(o[db][4 * g + 0] * inv, o[db][4 * g + 1] * inv); w.y = pk2(o[db][4 * g + 2] * inv, o[db][4 * g + 3] * inv);
            *(u32x2*)(op + 32 * db + 8 * g) = w; }
}

__device__ __forceinline__ void attn_wave_win_lds(const AttnTask& t, LAS unsigned char* lds, int kt0, int lane) {
    constexpr int D = 64;
    const int r = lane & 31, h = lane >> 5;
    bf16x8 qf[D / 16];
    const bf16_t* qp = t.q + (long)(t.m0 + r) * t.qstride + 8 * h;
#pragma unroll
    for (int kk = 0; kk < D / 16; ++kk) qf[kk] = *(const bf16x8*)(qp + 16 * kk);
    f32x16 o[D / 32];
#pragma unroll
    for (int db = 0; db < D / 32; ++db)
#pragma unroll
        for (int i = 0; i < 16; ++i) o[db][i] = 0.f;
    float mrun = t.m_init, lrun = t.l_init;
    const int qi = t.m0 + r;
    int kta = (t.m0 - t.W) >> 5, ktb = (t.m0 + t.W) >> 5;
    if (kta < 0) kta = 0;
    if (ktb > t.L / 32 - 1) ktb = t.L / 32 - 1;
    for (int kt = kta; kt <= ktb; ++kt) {
        const int slot = kt - kt0;
        bf16x8 kf[D / 16], vf[D / 32][2];
#pragma unroll
        for (int kk = 0; kk < D / 16; ++kk) kf[kk] = *(const LAS bf16x8*)(lds + ((slot * (D / 16) + kk) * 64 + lane) * 16);
#pragma unroll
        for (int db = 0; db < D / 32; ++db)
#pragma unroll
            for (int s = 0; s < 2; ++s) vf[db][s] = *(const LAS bf16x8*)(lds + 65536 + (((slot * (D / 32) + db) * 2 + s) * 64 + lane) * 16);
        attn_tile<D, true>(qf, kf, vf, o, mrun, lrun, t, kt * 32, t.m0, qi, h);
    }
    const float inv = 1.f / lrun;
    bf16_t* op = t.o + (long)qi * t.ostride + 4 * h;
#pragma unroll
    for (int db = 0; db < D / 32; ++db)
#pragma unroll
        for (int g = 0; g < 4; ++g) { u32x2 w; w.x = pk2(o[db][4 * g + 0] * inv, o[db][4 * g + 1] * inv); w.y = pk2(o[db][4 * g + 2] * inv, o[db][4 * g + 3] * inv);
            *(u32x2*)(op + 32 * db + 8 * g) = w; }
}

__device__ __forceinline__ void phase_attention(PP p, LAS unsigned char* lds, int chunk, int layer) {
    int tid_ = threadIdx.x; OPAQUE_V(tid_); const int tid = tid_, lane = tid & 63, wave = __builtin_amdgcn_readfirstlane(tid >> 6);
    const bf16_t* proj = (const bf16_t*)(p->ws + WS_PROJ);
    const bf16_t* vta = (const bf16_t*)(p->ws + WS_VTA);
    const bf16_t* vtb = (const bf16_t*)(p->ws + WS_VTB);
    const bf16_t* kba = (const bf16_t*)(p->ws + WS_KBA); const bf16_t* kbb = (const bf16_t*)(p->ws + WS_KBB);
    bf16_t* oa = (bf16_t*)(p->ws + WS_OA); bf16_t* ob = (bf16_t*)(p->ws + WS_OB); bf16_t* oc = (bf16_t*)(p->ws + WS_OC);
    bf16_t* og = (bf16_t*)(p->ws + WS_OG); float* lseb = (float*)(p->ws + WS_LSE);
    const bf16_t* memk = (const bf16_t*)(p->ws + WS_MEMK) + (size_t)layer * NBATCH * NMEM * 512;
    const bf16_t* memvt = (const bf16_t*)(p->ws + WS_MEMVT) + (size_t)layer * NBATCH * NMEM * 512;
    constexpr int NT_B = CB * 4 * 4, NT_A = CB * 8 * 8, NT_C = CB * 4 * 8;
    for (int task = blockIdx.x; task < NT_B + NT_A + NT_C; task += gridDim.x) {
        if (task < NT_B) {
            const int bl = (task & 63) >> 2, hh = task & 3, sp = task >> 6;
            for (int wt = wave; wt < 32; wt += NWAVES) {
                const int g = wt < 8 ? 0 : (wt < 16 ? 1 : 2), tq = wt < 16 ? (wt & 7) : (wt - 16), sh = 2 * g, dil = 1 << sh, L = SEQ >> sh, hb = 4 * g + hh;
                int c, m0;
                if (g == 0) { c = 0; m0 = sp * 512 + 64 * tq; } else if (g == 1) { c = tq >> 1; m0 = sp * 128 + 64 * (tq & 1); } else { c = tq; m0 = sp * 32; }
                AttnTask t;
                const size_t rowb = (size_t)bl * SEQ + c;
                t.q = proj + rowb * INW + 768 + hb * 64; t.qstride = (long)dil * INW;
                t.kb = kbb + (size_t)(bl * 12 + hb) * 64 * SEQ + (size_t)c * L * 64; t.vb = vtb + (size_t)(bl * 12 + hb) * 64 * SEQ + (size_t)c * L * 64;
                t.o = og + (size_t)g * MC * 256 + rowb * 256 + hh * 64; t.ostride = (long)dil * 256;
                t.lse = lseb + (size_t)g * MC * 4 + rowb * 4 + hh; t.lsestride = (long)dil * 4;
                t.m0 = m0; t.L = L; t.W = 64; t.m_init = -1e30f; t.l_init = 0.f; t.scale2 = 0.125f * LOG2E;
                if (g == 2) attn_wave<64, true, true, 1>(t, lds + wave * 8192, lane); else attn_wave<64, true, true, 2>(t, lds + wave * 8192, lane);
            }
            __syncthreads();
            {
                const size_t row = (size_t)bl * SEQ + sp * 512 + tid;
                const float l0 = lseb[row * 4 + hh], l1 = lseb[(size_t)MC * 4 + row * 4 + hh], l2 = lseb[(size_t)2 * MC * 4 + row * 4 + hh];
                const float mx = fmaxf(l0, fmaxf(l1, l2));
                float a0 = fexp2((l0 - mx) * LOG2E), a1 = fexp2((l1 - mx) * LOG2E), a2 = fexp2((l2 - mx) * LOG2E);
                const float is = 1.f / (a0 + a1 + a2); a0 *= is; a1 *= is; a2 *= is;
                const bf16_t* s0 = og + row * 256 + hh * 64; const bf16_t* s1 = s0 + (size_t)MC * 256; const bf16_t* s2 = s1 + (size_t)MC * 256;
                bf16_t* dp = ob + row * 256 + hh * 64;
#pragma unroll
                for (int j = 0; j < 8; ++j) { const u32x4 x0 = *(const u32x4*)(s0 + 8 * j), x1 = *(const u32x4*)(s1 + 8 * j), x2 = *(const u32x4*)(s2 + 8 * j);
                    u32x4 w;
                    w.x = pk2(a0 * bf2f(x0.x & 0xffffu) + a1 * bf2f(x1.x & 0xffffu) + a2 * bf2f(x2.x & 0xffffu), a0 * bf2f(x0.x >> 16) + a1 * bf2f(x1.x >> 16) + a2 * bf2f(x2.x >> 16));
                    w.y = pk2(a0 * bf2f(x0.y & 0xffffu) + a1 * bf2f(x1.y & 0xffffu) + a2 * bf2f(x2.y & 0xffffu), a0 * bf2f(x0.y >> 16) + a1 * bf2f(x1.y >> 16) + a2 * bf2f(x2.y >> 16));
                    w.z = pk2(a0 * bf2f(x0.z & 0xffffu) + a1 * bf2f(x1.z & 0xffffu) + a2 * bf2f(x2.z & 0xffffu), a0 * bf2f(x0.z >> 16) + a1 * bf2f(x1.z >> 16) + a2 * bf2f(x2.z >> 16));
                    w.w = pk2(a0 * bf2f(x0.w & 0xffffu) + a1 * bf2f(x1.w & 0xffffu) + a2 * bf2f(x2.w & 0xffffu), a0 * bf2f(x0.w >> 16) + a1 * bf2f(x1.w >> 16) + a2 * bf2f(x2.w >> 16));
                    *(u32x4*)(dp + 8 * j) = w; }
            }
            __syncthreads();
        } else
        if (task < NT_B + NT_A) {
            const int ta = task - NT_B, bk = ta & 31, inr = ta >> 5, bl = bk >> 1, ha = (bk & 1) * 4 + (inr >> 3), sp = inr & 7;
            AttnTask t;
            const size_t rowb = (size_t)bl * SEQ;
            t.q = proj + rowb * INW + ha * 64; t.qstride = INW;
            t.kb = kba + (size_t)(bl * 2 + (ha >> 2)) * 64 * SEQ; t.vb = vta + (size_t)(bl * 2 + (ha >> 2)) * 64 * SEQ;
            t.o = oa + rowb * 512 + ha * 64; t.ostride = 512; t.lse = nullptr; t.lsestride = 0;
            t.m0 = sp * 256 + 32 * wave; t.L = SEQ; t.W = 128; t.m_init = p->sink_a[layer * 8 + ha] * LOG2E; t.l_init = 1.f; t.scale2 = 0.125f * LOG2E;
            const int kt0 = 8 * sp - 4;
            {
                const char* ks = (const char*)t.kb + (long)kt0 * 4096; const char* vs = (const char*)t.vb + (long)kt0 * 4096;
                u32x4 tmp[16];
#pragma unroll
                for (int i = 0; i < 8; ++i) { const int c = tid + 512 * i, kt = kt0 + (c >> 8); const bool ok = kt >= 0 && kt < SEQ / 32;
                    tmp[i] = ok ? *(const u32x4*)(ks + (long)c * 16) : (u32x4){0u, 0u, 0u, 0u}; tmp[8 + i] = ok ? *(const u32x4*)(vs + (long)c * 16) : (u32x4){0u, 0u, 0u, 0u}; }
#pragma unroll
                for (int i = 0; i < 8; ++i) { *(LAS u32x4*)(lds + (tid + 512 * i) * 16) = tmp[i]; *(LAS u32x4*)(lds + 65536 + (tid + 512 * i) * 16) = tmp[8 + i]; }
            }
            __syncthreads();
            attn_wave_win_lds(t, lds, kt0, lane);
            __syncthreads();
        } else {
            const int tc = task - NT_B - NT_A, bl = (tc & 63) >> 2, hc = tc & 3, sp = tc >> 6, bg = chunk * CB + bl;
            AttnTask t;
            const size_t rowb = (size_t)bl * SEQ;
            t.q = proj + rowb * INW + 3072 + hc * 128; t.qstride = INW;
            t.kb = memk + (size_t)(bg * 4 + hc) * 128 * NMEM; t.vb = memvt + (size_t)(bg * 4 + hc) * 128 * NMEM;
            t.o = oc + rowb * 512 + hc * 128; t.ostride = 512; t.lse = nullptr; t.lsestride = 0;
            t.m0 = sp * 256 + 32 * wave; t.L = NMEM; t.W = 0; t.m_init = -1e30f; t.l_init = 0.f; t.scale2 = 0.08838834764831845f * LOG2E;
            {
                const u32x4* ks = (const u32x4*)t.kb; const u32x4* vs = (const u32x4*)t.vb;
                u32x4 tmp[16];
#pragma unroll
                for (int i = 0; i < 8; ++i) { tmp[i] = ks[tid + 512 * i]; tmp[8 + i] = vs[tid + 512 * i]; }
#pragma unroll
                for (int i = 0; i < 8; ++i) { *(LAS u32x4*)(lds + (tid + 512 * i) * 16) = tmp[i]; *(LAS u32x4*)(lds + 65536 + (tid + 512 * i) * 16) = tmp[8 + i]; }
            }
            __syncthreads();
            attn_wave_mem_lds(t, lds, lane);
            __syncthreads();
        }
    }
}

#define XB_TMO      128
#define XB_XCNT(j)  (256  + 64 * (j))
#define XB_XSUB(j)  (1280 + 64 * (j))
#define XB_XGEN(j)  (2304 + 64 * (j))
#define XB_TOP      3328
#define XB_TOPGEN   3392
#define XCD_BAR_WORDS 3456
#define XB_SPIN_CAP (1u << 18)

__device__ __forceinline__ unsigned xb_ld(unsigned* p)              { return __hip_atomic_load(p, __ATOMIC_RELAXED, __HIP_MEMORY_SCOPE_AGENT); }
__device__ __forceinline__ unsigned xb_add(unsigned* p, unsigned v) { return __hip_atomic_fetch_add(p, v, __ATOMIC_RELAXED, __HIP_MEMORY_SCOPE_AGENT); }
__device__ __forceinline__ unsigned xb_xcc_id() { return (unsigned)__builtin_amdgcn_s_getreg((3 << 11) | 20) & 0xFu; }
#define XB_SPIN(cond, bar) do { unsigned _sp = 0; while (cond) { __builtin_amdgcn_s_sleep(1); \
    if ((++_sp & 255u) == 0u) { if (xb_ld(&(bar)[XB_TMO])) break; if (_sp > XB_SPIN_CAP) { atomicAdd(&(bar)[XB_TMO], 1u); break; } } } } while (0)
struct XcdBarrier {
    unsigned* bar; unsigned x;
    volatile LAS unsigned* st;
};

__device__ __forceinline__ XcdBarrier xcd_barrier_post(unsigned* bar, volatile LAS unsigned* st) {
    XcdBarrier b; b.bar = bar; b.x = xb_xcc_id(); b.st = st;
    if (threadIdx.x == 0) (void)xb_add(&bar[XB_XCNT(b.x)], 1u);
    return b;
}
__device__ __forceinline__ void xcd_barrier_complete(unsigned* bar, unsigned x, unsigned& nloc, unsigned& nx) {
    const unsigned G = gridDim.x * gridDim.y * gridDim.z;
    unsigned sum, cnt, mine, sp = 0u;
    for (;;) {
        sum = 0u; cnt = 0u; mine = 0u;
#pragma unroll
        for (unsigned j = 0; j < 16; ++j) { const unsigned c = xb_ld(&bar[XB_XCNT(j)]); sum += c; cnt += (c > 0u) ? 1u : 0u; mine = (j == x) ? c : mine; }
        if (sum == G) break;
        __builtin_amdgcn_s_sleep(1);
        if ((++sp & 255u) == 0u) { if (xb_ld(&bar[XB_TMO])) break; if (sp > XB_SPIN_CAP) { atomicAdd(&bar[XB_TMO], 1u); break; } }
    }
    nloc = mine > 0u ? mine : 1u; nx = cnt > 0u ? cnt : 1u;
}

__device__ __forceinline__ void xcd_barrier(const XcdBarrier& b) {
    asm volatile("s_waitcnt vmcnt(0)" ::: "memory");
    __syncthreads();
    if (threadIdx.x == 0) {
        unsigned* bar = b.bar;
        __builtin_amdgcn_s_waitcnt(0);
        unsigned nloc = b.st[0], nx = b.st[1];
        if (nloc == 0u) { xcd_barrier_complete(bar, b.x, nloc, nx); b.st[0] = nloc; b.st[1] = nx; }
        const unsigned old = xb_add(&bar[XB_XSUB(b.x)], 1u);
        const unsigned gen = old / nloc;
        if (old + 1u == (gen + 1u) * nloc) {
            __builtin_amdgcn_fence(__ATOMIC_RELEASE, "agent");
            asm volatile("s_waitcnt vmcnt(0)" ::: "memory");
            const unsigned og = xb_add(&bar[XB_TOP], 1u);
            const unsigned tg = og / nx;
            if (og + 1u == (tg + 1u) * nx) xb_add(&bar[XB_TOPGEN], 1u);
            else XB_SPIN(xb_ld(&bar[XB_TOPGEN]) == tg, bar);
            __builtin_amdgcn_fence(__ATOMIC_ACQUIRE, "agent");
            xb_add(&bar[XB_XGEN(b.x)], 1u);
            asm volatile("s_waitcnt vmcnt(0)" ::: "memory");
        } else {
            XB_SPIN(xb_ld(&bar[XB_XGEN(b.x)]) == gen, bar);
            __builtin_amdgcn_fence(__ATOMIC_ACQUIRE, "agent");
            asm volatile("s_waitcnt vmcnt(0)" ::: "memory");
        }
    }
    __syncthreads();
}


constexpr int STEPS_PER_CHUNK = 1 + DEPTH * 8, N_STEPS = 2 + NCHUNK * STEPS_PER_CHUNK;
__device__ __forceinline__ void run_step(PP p, LAS unsigned char* lds, int s) {
    bf16_t* WT = (bf16_t*)(p->ws + WS_WT);
    if (s == 0) { phase_prologue_a(p, lds); return; }
    if (s == 1) {
        for (int l = 0; l < DEPTH; ++l) { EpiMemKV E; E.mk = (bf16_t*)(p->ws + WS_MEMK) + (size_t)l * NBATCH * NMEM * 512; E.mvt = (bf16_t*)(p->ws + WS_MEMVT) + (size_t)l * NBATCH * NMEM * 512;
            run_gemm(lds, (const bf16_t*)(p->ws + WS_MEMN) + (size_t)l * NBATCH * NMEM * DM, WT + (size_t)l * WL + WO_MKV, NBATCH * NMEM, 1024, DM, E, 64 * l); }
        return;
    }
    const int s2 = s - 2, chunk = s2 / STEPS_PER_CHUNK, r = s2 % STEPS_PER_CHUNK;
    if (r == 0) { phase_rows_first(p, chunk); return; }
    const int l = (r - 1) >> 3, ph = (r - 1) & 7;
    const bf16_t* wl = WT + (size_t)l * WL;
    bf16_t* H = (bf16_t*)(p->ws + WS_H); bf16_t* proj = (bf16_t*)(p->ws + WS_PROJ); bf16_t* mrg = (bf16_t*)(p->ws + WS_MRG);
    switch (ph) {
    case 0: { EpiIn E; E.proj = proj; E.vta = (bf16_t*)(p->ws + WS_VTA); E.vtb = (bf16_t*)(p->ws + WS_VTB); E.kba = (bf16_t*)(p->ws + WS_KBA); E.kbb = (bf16_t*)(p->ws + WS_KBB); E.rope = (const float*)(p->ws + WS_ROPE);
        run_gemm(lds, H, wl + WO_IN, MC, INW, DM, E, 0); } break;
    case 1: phase_attention(p, lds, chunk, l); break;
    case 2: {
        EpiGate E; E.mrg = mrg;
        E.gate = proj + 3584; E.accum = 0; run_gemm<EpiGate, GATE_FAST>(lds, (const bf16_t*)(p->ws + WS_OA), wl + WO_OA, MC, DM, 512, E, 0);
        E.gate = proj + 3584 + 1024; E.accum = 1; run_gemm<EpiGate, GATE_FAST>(lds, (const bf16_t*)(p->ws + WS_OB), wl + WO_OB, MC, DM, 256, E, 0);
        E.gate = proj + 3584 + 2048; E.accum = 1; run_gemm<EpiGate, GATE_FAST>(lds, (const bf16_t*)(p->ws + WS_OC), wl + WO_OC, MC, DM, 512, E, 0);
        } break;
    case 3: { EpiY E; E.Y = (bf16_t*)(p->ws + WS_Y); run_gemm(lds, mrg, wl + WO_OUT, MC, DM, DM, E, 0); } break;
    case 4: phase_rows_resid(p, chunk, l == 0, p->g_mix_post + l * DM, p->g_ffn_pre + l * DM, true); break;
    case 5: { EpiSwiGLU E; E.act = (bf16_t*)(p->ws + WS_ACT); run_gemm(lds, H, wl + WO_FIN, MC, 2 * FFH, DM, E, 0); } break;
    case 6: { EpiY E; E.Y = (bf16_t*)(p->ws + WS_Y); run_gemm(lds, (const bf16_t*)(p->ws + WS_ACT), wl + WO_FOUT, MC, DM, FFH, E, 0); } break;
    default: phase_rows_resid(p, chunk, false, p->g_ffn_post + l * DM, p->g_mix_pre + (l < DEPTH - 1 ? l + 1 : l) * DM, l < DEPTH - 1); break;
    }
}

__global__ void __launch_bounds__(NTHREADS, 2) fwd_megakernel(Params p) {
    extern __shared__ __attribute__((aligned(16))) unsigned char lds_raw[];
    LAS unsigned char* lds = (LAS unsigned char*)lds_raw;
    cg::grid_group grid = cg::this_grid();
    PP pp = (PP)__builtin_amdgcn_kernarg_segment_ptr();
    const int s_hi = pp->s_hi;
    __shared__ uint4 xb_words;
    if (threadIdx.x == 0) xb_words = make_uint4(0u, 0u, 0u, 0u);
    __syncthreads();
    const XcdBarrier xbar = xcd_barrier_post((unsigned*)(pp->ws + WS_BAR), (volatile LAS unsigned*)&xb_words);
    const int s_lo = pp->s_lo;
    for (int s = s_lo; s < s_hi; ++s) {
        PP q = pp; OPAQUE_S(q);
        run_step(q, lds, s);
        if (s + 1 < s_hi) { if (s == s_lo) grid.sync(); else xcd_barrier(xbar); }
    }
}

extern "C" void kernel_launch(void* const* d_in, const int* in_sizes, int n_in, void* d_out, int out_size, void* d_ws, size_t ws_size, hipStream_t stream) {
    static int grid_blocks = 0;
    if (grid_blocks == 0) {
        if (n_in != 18 || out_size != NBATCH * SEQ * DM || ws_size < WS_END) { fprintf(stderr, "kernel_launch: unexpected shapes / workspace (n_in %d out %d ws %zu need %zu)\n", n_in, out_size, ws_size, (size_t)WS_END); grid_blocks = -1; return; }
        int dev = 0, cus = 0, per_cu = 0;
        hipGetDevice(&dev);
        hipDeviceGetAttribute(&cus, hipDeviceAttributeMultiprocessorCount, dev);
        if (hipFuncSetAttribute((const void*)fwd_megakernel, hipFuncAttributeMaxDynamicSharedMemorySize, LDS_BYTES) != hipSuccess) { fprintf(stderr, "kernel_launch: hipFuncSetAttribute failed\n"); grid_blocks = -1; return; }
        hipOccupancyMaxActiveBlocksPerMultiprocessor(&per_cu, (const void*)fwd_megakernel, NTHREADS, LDS_BYTES);
        if (per_cu < 1) { fprintf(stderr, "kernel_launch: occupancy query says %d blocks per CU\n", per_cu); per_cu = 1; }
        (void)hipGetLastError();
        grid_blocks = cus * 1;
    }
    if (grid_blocks < 0) return;
    if (hipMemsetAsync((char*)d_ws + WS_BAR, 0, 16384, stream) != hipSuccess) { fprintf(stderr, "kernel_launch: hipMemsetAsync failed\n"); return; }
    Params p{};
    p.x_prompt = (const float*)d_in[0]; p.x_sample = (const float*)d_in[1]; p.mem_prompt = (const float*)d_in[2]; p.mem_sample = (const float*)d_in[3];
    p.g_mix_pre = (const float*)d_in[4]; p.g_mix_post = (const float*)d_in[5]; p.g_mem = (const float*)d_in[6]; p.w_in = (const float*)d_in[7];
    p.sink_a = (const float*)d_in[8]; p.w_mem_kv = (const float*)d_in[9]; p.w_o_a = (const float*)d_in[10]; p.w_o_b = (const float*)d_in[11];
    p.w_o_c = (const float*)d_in[12]; p.w_out = (const float*)d_in[13]; p.g_ffn_pre = (const float*)d_in[14]; p.g_ffn_post = (const float*)d_in[15];
    p.w_ffn_in = (const float*)d_in[16]; p.w_ffn_out = (const float*)d_in[17];
    p.out = (float*)d_out; p.ws = (unsigned char*)d_ws;
    for (int j = 0; j < 8; ++j) p.inv_freq[j] = powf(500000.0f, -(float)(2 * j) / 16.0f);
#if MK_MULTI_LAUNCH
    for (int s = 0; s < N_STEPS; ++s) {
        p.s_lo = s; p.s_hi = s + 1;
        hipLaunchKernelGGL(fwd_megakernel, dim3(grid_blocks), dim3(NTHREADS), LDS_BYTES, stream, p);
    }
#else
    p.s_lo = 0; p.s_hi = N_STEPS;
    void* args[] = {&p};
    hipError_t e = hipLaunchCooperativeKernel((const void*)fwd_megakernel, dim3(grid_blocks), dim3(NTHREADS), args, LDS_BYTES, stream);
    if (e != hipSuccess) fprintf(stderr, "kernel_launch: cooperative launch failed: %s (grid %d)\n", hipGetErrorString(e), grid_blocks);
#endif
}
```

```cpp
#include <hip/hip_runtime.h>
#include <hip/hip_cooperative_groups.h>
#include <cstdio>
#include <cstdint>
#include <cmath>
namespace cg = cooperative_groups;
#ifndef MK_MULTI_LAUNCH
#define MK_MULTI_LAUNCH 0
#endif
namespace pg8 {
#define PG8_LAS __attribute__((address_space(3)))
typedef unsigned short bf16_t;
typedef short bf16x8 __attribute__((ext_vector_type(8)));
typedef float f32x4 __attribute__((ext_vector_type(4)));
typedef unsigned u32x4 __attribute__((ext_vector_type(4)));
constexpr int BM = 256, BK = 64, HALF = 128, HTB = HALF * BK * 2  , STAGE_BYTES = 8 * HTB, NXCD = 8, WGM = 8;

__host__ __device__ __forceinline__ int lds_byte(int r, int c) { const int st = (r >> 4) * 2 + (c >> 5), rr = r & 15, cc = c & 31, ob = rr * 64 + cc * 2; return st * 1024 + (ob ^ (((ob >> 9) & 1) << 5)); }
__host__ __device__ __forceinline__ void stage_rc(int b, int& R, int& C) { const int st = b / 1024, sb = b % 1024, swz = sb ^ (((sb >> 9) & 1) << 5); R = (st >> 1) * 16 + swz / 64; C = (st & 1) * 32 + (swz % 64) / 2; }
__host__ __device__ __forceinline__ int perm32(int rho) { const int n = rho >> 4, i = rho & 15; return 8 * (i >> 2) + 4 * n + (i & 3); }

struct Unit { int pm, pn; };
struct Gemm { const bf16_t* A; const bf16_t* Bt; int M, N, K; };

struct StaticOrder {
    int nM, nN, nwg, G, c, wgm;
    __host__ __device__ void init(int M, int N, int G_, int c_, int wgm_ = WGM) { nM = M / BM; nN = N / BM; nwg = nM * nN; G = G_; c = c_; wgm = wgm_; }
    __host__ __device__ bool next(int i, Unit& u) const {
        const long L = (long)i * G + c; if (L >= nwg) return false;
        int wgid = (int)L; { const int q = nwg / NXCD, r = nwg % NXCD, xcd = wgid % NXCD, off = wgid / NXCD; wgid = (xcd < r ? xcd * (q + 1) : r * (q + 1) + (xcd - r) * q) + off; }
        const int nig = wgm * nN, gid = wgid / nig, fm = gid * wgm, gsz = (nM - fm) < wgm ? (nM - fm) : wgm;
        u.pm = fm + ((wgid % nig) % gsz); u.pn = (wgid % nig) / gsz; return true;
    }
    __device__ __forceinline__ void a_ready(const Unit&) const {}
    __device__ __forceinline__ void done(const Unit&) const {}
};
__device__ __forceinline__ unsigned cvt_pk_bf16(float lo, float hi) { unsigned r; asm volatile("v_cvt_pk_bf16_f32 %0, %1, %2" : "=v"(r) : "v"(lo), "v"(hi)); return r; }
typedef float f32x2 __attribute__((ext_vector_type(2)));
template <class Epi, class Sched, bool ALIGN_EPI = false, bool SP2 = false>
__device__ __forceinline__ void gemm_phase(PG8_LAS unsigned char* lds, const Gemm g, const Sched& S, const Epi& E) {
    int tid_ = threadIdx.x; asm volatile("" : "+v"(tid_)); const int tid = tid_, wid = __builtin_amdgcn_readfirstlane(tid >> 6), lane = tid & 63, wr = wid >> 2, wc = wid & 3, fr = lane & 15, fq = lane >> 4;
    const int K = g.K, nt = K / BK;
    unsigned voffA[2], voffB[2];
#pragma unroll
    for (int i = 0; i < 2; ++i) { int R, C; stage_rc(tid * 16 + i * 8192, R, C); const int Rb = Epi::PERM ? ((R & ~31) + perm32(R & 31)) : R;
        voffA[i] = (unsigned)(R * K + C) * 2u; voffB[i] = (unsigned)(Rb * K + C) * 2u; }
    const size_t kstep = (size_t)(BK * 2);
    const size_t hstep = (size_t)HALF * K * 2;
    const size_t tstep = 2 * hstep;
    const unsigned ldsw = (unsigned)wid * 1024u;
    const int aoff = lds_byte(wr * 64 + fr, fq * 8), boff = lds_byte(wc * 32 + fr, fq * 8);
#define PG8_SA(b, h) (((b) * 2 + (h)) * HTB)
#define PG8_SB(b, h) ((4 + (b) * 2 + (h)) * HTB)
#define PG8_STAGE(bufoff, gbase, voff) do { _Pragma("unroll") for (int _i = 0; _i < 2; ++_i) \
        __builtin_amdgcn_global_load_lds((const unsigned*)((const char*)(gbase) + (voff)[_i]), (PG8_LAS unsigned*)(lds + (bufoff) + ldsw + _i * 8192), 16, 0, 0); } while (0)
#define PG8_LDA(dst, b, h) do { _Pragma("unroll") for (int m = 0; m < 4; ++m) _Pragma("unroll") for (int k = 0; k < 2; ++k) dst[m][k] = *(const PG8_LAS bf16x8*)(lds + PG8_SA(b, h) + aoff + m * 2048 + k * 1024); } while (0)
#define PG8_LDB(dst, b, h) do { _Pragma("unroll") for (int n = 0; n < 2; ++n) _Pragma("unroll") for (int k = 0; k < 2; ++k) dst[n][k] = *(const PG8_LAS bf16x8*)(lds + PG8_SB(b, h) + boff + n * 2048 + k * 1024); } while (0)
#define PG8_MMA(ai, bj, At, Bt) do { __builtin_amdgcn_s_setprio(1); _Pragma("unroll") for (int m = 0; m < 4; ++m) _Pragma("unroll") for (int n = 0; n < 2; ++n) _Pragma("unroll") for (int k = 0; k < 2; ++k) \
        acc[ai][bj][m][n] = __builtin_amdgcn_mfma_f32_16x16x32_bf16(Bt[n][k], At[m][k], acc[ai][bj][m][n], 0, 0, 0); __builtin_amdgcn_s_setprio(0); } while (0)
#define PG8_WAIT_V(n) asm volatile("s_waitcnt vmcnt(" #n ")" ::: "memory")
#define PG8_WAIT_L(n) asm volatile("s_waitcnt lgkmcnt(" #n ")" ::: "memory")
#define PG8_BAR __builtin_amdgcn_s_barrier()
#define PG8_SCHED __builtin_amdgcn_sched_barrier(0)
    Unit cur, nxt; int ui = 0;
    if (!S.next(0, cur)) return;
    f32x4 acc[2][2][4][2];
#pragma unroll
    for (int a = 0; a < 2; ++a)
#pragma unroll
        for (int b = 0; b < 2; ++b)
#pragma unroll
            for (int m = 0; m < 4; ++m)
#pragma unroll
                for (int n = 0; n < 2; ++n) acc[a][b][m][n] = (f32x4){0.f, 0.f, 0.f, 0.f};
    bf16x8 At[4][2], B0[2][2], B1[2][2];
    const char* cA = (const char*)g.A + (size_t)cur.pm * tstep; const char* cB = (const char*)g.Bt + (size_t)cur.pn * tstep;
    S.a_ready(cur);
    if constexpr (SP2) {
        PG8_STAGE(PG8_SB(0, 0), cB, voffB); PG8_STAGE(PG8_SB(0, 1), cB + hstep, voffB); PG8_STAGE(PG8_SA(0, 0), cA, voffA); PG8_STAGE(PG8_SA(0, 1), cA + hstep, voffA);
        if (wr == 1) PG8_BAR;
        PG8_WAIT_V(2); PG8_BAR;
        PG8_STAGE(PG8_SB(1, 0), cB + kstep, voffB); PG8_STAGE(PG8_SA(1, 0), cA + kstep, voffA); PG8_STAGE(PG8_SB(1, 1), cB + hstep + kstep, voffB);
        PG8_WAIT_V(6); PG8_BAR;
    } else {
        PG8_STAGE(PG8_SB(0, 0), cB, voffB); PG8_STAGE(PG8_SA(0, 0), cA, voffA); PG8_STAGE(PG8_SB(0, 1), cB + hstep, voffB); PG8_STAGE(PG8_SA(0, 1), cA + hstep, voffA);
        if (wr == 1) PG8_BAR;
        PG8_WAIT_V(4); PG8_BAR;
        PG8_STAGE(PG8_SB(1, 0), cB + kstep, voffB); PG8_STAGE(PG8_SA(1, 0), cA + kstep, voffA); PG8_STAGE(PG8_SB(1, 1), cB + hstep + kstep, voffB);
        PG8_WAIT_V(6); PG8_BAR;
    }
    for (;;) {
        const bool has_next = S.next(ui + 1, nxt);
        const char* nA = has_next ? (const char*)g.A + (size_t)nxt.pm * tstep : cA; const char* nB = has_next ? (const char*)g.Bt + (size_t)nxt.pn * tstep : cB;
        for (int t = 0; t < nt; t += 2) {
            const bool last = (t == nt - 2);
            const char* a1 = cA + (size_t)(t + 1) * kstep;
            const char* a2 = last ? nA : cA + (size_t)(t + 2) * kstep; const char* b2 = last ? nB : cB + (size_t)(t + 2) * kstep;
            const char* a3 = a2 + kstep; const char* b3 = b2 + kstep;
            if (last && has_next) S.a_ready(nxt);
            if constexpr (SP2) {
            PG8_LDB(B0, 0, 0); PG8_LDB(B1, 0, 1); PG8_SCHED; PG8_LDA(At, 0, 0); PG8_STAGE(PG8_SA(1, 1), a1 + hstep, voffA);
            PG8_WAIT_V(8); PG8_WAIT_L(0); PG8_BAR; PG8_MMA(0, 0, At, B0); PG8_MMA(0, 1, At, B1); PG8_BAR; PG8_SCHED;
            PG8_LDA(At, 0, 1); PG8_STAGE(PG8_SB(0, 0), b2, voffB); PG8_STAGE(PG8_SB(0, 1), b2 + hstep, voffB); PG8_STAGE(PG8_SA(0, 0), a2, voffA);
            PG8_WAIT_V(8); PG8_WAIT_L(0); PG8_BAR; PG8_MMA(1, 0, At, B0); PG8_MMA(1, 1, At, B1); PG8_BAR; PG8_SCHED;
            PG8_LDB(B0, 1, 0); PG8_LDB(B1, 1, 1); PG8_SCHED; PG8_LDA(At, 1, 0); PG8_STAGE(PG8_SA(0, 1), a2 + hstep, voffA);
            PG8_WAIT_V(8); PG8_WAIT_L(0); PG8_BAR; PG8_MMA(0, 0, At, B0); PG8_MMA(0, 1, At, B1); PG8_BAR; PG8_SCHED;
            PG8_LDA(At, 1, 1); PG8_STAGE(PG8_SB(1, 0), b3, voffB); PG8_STAGE(PG8_SB(1, 1), b3 + hstep, voffB); PG8_STAGE(PG8_SA(1, 0), a3, voffA);
            PG8_WAIT_V(8); PG8_WAIT_L(0); PG8_BAR; PG8_MMA(1, 0, At, B0); PG8_MMA(1, 1, At, B1); PG8_BAR; PG8_SCHED;
            } else {
            PG8_LDB(B0, 0, 0); PG8_SCHED; PG8_LDA(At, 0, 0); PG8_STAGE(PG8_SA(1, 1), a1 + hstep, voffA);
            PG8_WAIT_L(8); PG8_BAR; PG8_WAIT_L(0); PG8_MMA(0, 0, At, B0); PG8_BAR; PG8_SCHED;
            PG8_LDB(B1, 0, 1); PG8_STAGE(PG8_SB(0, 0), b2, voffB);
            PG8_BAR; PG8_WAIT_L(0); PG8_MMA(0, 1, At, B1); PG8_BAR;
            PG8_LDA(At, 0, 1); PG8_STAGE(PG8_SA(0, 0), a2, voffA);
            PG8_BAR; PG8_WAIT_L(0); PG8_MMA(1, 0, At, B0); PG8_BAR; PG8_SCHED;
            PG8_STAGE(PG8_SB(0, 1), b2 + hstep, voffB);
            PG8_WAIT_V(6); PG8_BAR; PG8_MMA(1, 1, At, B1); PG8_BAR;
            PG8_LDB(B0, 1, 0); PG8_SCHED; PG8_LDA(At, 1, 0); PG8_STAGE(PG8_SA(0, 1), a2 + hstep, voffA);
            PG8_WAIT_L(8); PG8_BAR; PG8_WAIT_L(0); PG8_MMA(0, 0, At, B0); PG8_BAR; PG8_SCHED;
            PG8_LDB(B1, 1, 1); PG8_STAGE(PG8_SB(1, 0), b3, voffB);
            PG8_BAR; PG8_WAIT_L(0); PG8_MMA(0, 1, At, B1); PG8_BAR;
            PG8_LDA(At, 1, 1); PG8_STAGE(PG8_SA(1, 0), a3, voffA);
            PG8_BAR; PG8_WAIT_L(0); PG8_MMA(1, 0, At, B0); PG8_BAR; PG8_SCHED;
            PG8_STAGE(PG8_SB(1, 1), b3 + hstep, voffB);
            PG8_WAIT_V(6); PG8_BAR; PG8_MMA(1, 1, At, B1); PG8_BAR;
            }
        }
        if constexpr (ALIGN_EPI) { if (wr == 0) PG8_BAR; }
        if constexpr (!Epi::AFTER_DRAIN) { E(acc, cur, wr, wc, fr, fq); S.done(cur); }
        if (!has_next) break;
#pragma unroll
        for (int a = 0; a < 2; ++a)
#pragma unroll
            for (int b = 0; b < 2; ++b)
#pragma unroll
                for (int m = 0; m < 4; ++m)
#pragma unroll
                    for (int n = 0; n < 2; ++n) acc[a][b][m][n] = (f32x4){0.f, 0.f, 0.f, 0.f};
        cur = nxt; cA = nA; cB = nB; ++ui;
        if constexpr (ALIGN_EPI) { if (wr == 1) PG8_BAR; }
    }
    PG8_WAIT_V(0);
    if constexpr (!ALIGN_EPI) { if (wr == 0) PG8_BAR; }
    PG8_BAR;
    if constexpr (Epi::AFTER_DRAIN) { E.fused(acc, cur, wr, wc, fr, fq, lds, wid, lane); S.done(cur); }
#undef PG8_SA
#undef PG8_SB
#undef PG8_STAGE
#undef PG8_LDA
#undef PG8_LDB
#undef PG8_MMA
#undef PG8_WAIT_V
#undef PG8_WAIT_L
#undef PG8_BAR
#undef PG8_SCHED
}
}

using pg8::bf16_t; using pg8::bf16x8; using pg8::f32x4; using pg8::u32x4;
typedef float f32x16 __attribute__((ext_vector_type(16)));
typedef unsigned u32x2 __attribute__((ext_vector_type(2)));
#define LAS __attribute__((address_space(3)))
constexpr int NTHREADS = 512, NWAVES = 8, LDS_BYTES = pg8::STAGE_BYTES;
constexpr int DM = 1024, SEQ = 2048, NBATCH = 48, DEPTH = 4, NMEM = 256, INW = 6656, FFH = 2816;
constexpr int CB = 16, MC = CB * SEQ, NCHUNK = NBATCH / CB;
constexpr float EPS = 1e-6f, LOG2E = 1.4426950408889634f, LN2 = 0.6931471805599453f;
constexpr size_t WO_IN = 0, WO_MKV = WO_IN + (size_t)INW * DM, WO_OA = WO_MKV + (size_t)1024 * DM, WO_OB = WO_OA + (size_t)1024 * 512, WO_OC = WO_OB + (size_t)1024 * 256,
                 WO_OUT = WO_OC + (size_t)1024 * 512, WO_FIN = WO_OUT + (size_t)1024 * 1024, WO_FOUT = WO_FIN + (size_t)2 * FFH * DM, WL = WO_FOUT + (size_t)DM * FFH;
constexpr size_t al256(size_t x) { return (x + 255) & ~(size_t)255; }
constexpr size_t WS_WT = 0;
constexpr size_t WS_ROPE = al256(WS_WT + WL * DEPTH * 2);
constexpr size_t WS_MEMK = al256(WS_ROPE + (size_t)SEQ * 8 * 8);
constexpr size_t WS_MEMVT = al256(WS_MEMK + (size_t)DEPTH * NBATCH * NMEM * 512 * 2);
constexpr size_t WS_H = al256(WS_MEMVT + (size_t)DEPTH * NBATCH * NMEM * 512 * 2);
constexpr size_t WS_PROJ = al256(WS_H + (size_t)MC * DM * 2);
constexpr size_t WS_VTA = al256(WS_PROJ + (size_t)MC * INW * 2);
constexpr size_t WS_VTB = al256(WS_VTA + (size_t)CB * 2 * 64 * SEQ * 2);
constexpr size_t WS_OA = al256(WS_VTB + (size_t)CB * 12 * 64 * SEQ * 2);
constexpr size_t WS_OB = al256(WS_OA + (size_t)MC * 512 * 2);
constexpr size_t WS_OC = al256(WS_OB + (size_t)MC * 256 * 2);
constexpr size_t WS_MRG = al256(WS_OC + (size_t)MC * 512 * 2);
constexpr size_t WS_KBA = al256(WS_MRG + (size_t)MC * DM * 2);
constexpr size_t WS_KBB = al256(WS_KBA + (size_t)CB * 2 * 64 * SEQ * 2);
constexpr size_t WS_BAR = al256(WS_KBB + (size_t)CB * 12 * 64 * SEQ * 2);
constexpr size_t WS_END = al256(WS_BAR + 16384);
constexpr size_t WS_MEMN = WS_PROJ;
constexpr size_t WS_Y = WS_PROJ;
constexpr size_t WS_Y2 = WS_PROJ + (size_t)MC * DM * 2;
constexpr size_t WS_ACT = WS_PROJ + (size_t)MC * DM * 4;
constexpr size_t WS_OG = WS_MRG;
constexpr size_t WS_LSE = WS_MRG + (size_t)3 * MC * 256 * 2;
static_assert((size_t)DEPTH * NBATCH * NMEM * DM * 2 <= (size_t)MC * INW * 2, "memn overlay");
static_assert((size_t)MC * DM * 4 + (size_t)MC * FFH * 2 <= (size_t)MC * INW * 2, "y/act overlay");
static_assert((size_t)3 * MC * 256 * 2 + (size_t)3 * MC * 4 * 4 <= (size_t)MC * DM * 2, "og overlay");

struct Params {
    const float *x_prompt, *x_sample, *mem_prompt, *mem_sample, *g_mix_pre, *g_mix_post, *g_mem, *w_in, *sink_a, *w_mem_kv, *w_o_a, *w_o_b, *w_o_c, *w_out,
                *g_ffn_pre, *g_ffn_post, *w_ffn_in, *w_ffn_out;
    float* out; unsigned char* ws;
    float inv_freq[8];
    int s_lo, s_hi;
};

typedef const __attribute__((address_space(4))) Params* PP;
#define OPAQUE_V(x) asm volatile("" : "+v"(x))
#define OPAQUE_S(x) asm volatile("" : "+s"(x))
__device__ __forceinline__ float bf2f(unsigned b) { return __uint_as_float(b << 16); }
typedef __bf16 bf16x2v __attribute__((ext_vector_type(2)));
typedef float f32x2v __attribute__((ext_vector_type(2)));
__device__ __forceinline__ unsigned pk2(float lo, float hi) { const f32x2v v = {lo, hi}; return __builtin_bit_cast(unsigned, __builtin_convertvector(v, bf16x2v)); }
__device__ __forceinline__ float wave_sum(float v) {
#pragma unroll
    for (int o = 32; o > 0; o >>= 1) v += __shfl_xor(v, o);
    return v;
}
__device__ __forceinline__ float fexp2(float x) { return __builtin_amdgcn_exp2f(x); }
__device__ __forceinline__ float frcp(float x) { return __builtin_amdgcn_rcpf(x); }
__device__ __forceinline__ float sigmoidf_(float x) { return frcp(1.f + fexp2(-x * LOG2E)); }
#define LDS_WAIT() asm volatile("s_waitcnt lgkmcnt(0)" ::: "memory")

__device__ __forceinline__ int src_col_in(int n) {
    const bool qk = (n < 640) || (n >= 768 && n < 2304);
    const int p = n & 63;
    return (qk && p < 16) ? (n - p) + (p >> 1) + 8 * (p & 1) : n;
}
__device__ __forceinline__ int src_col_ffin(int n) { const int q = n >> 3, e = n & 7; return e < 4 ? 4 * q + e : FFH + 4 * q + (e - 4); }

template <int PERMT>
__device__ __forceinline__ void transpose_item(const float* W, int K, int N, bf16_t* WT, LAS float* scr, int item, int lane) {
    const int nblk = N / 32, kb = item / nblk, nb = item % nblk, k0 = 64 * kb, n0 = 32 * nb;
    const int nd = n0 + (lane & 31);
    const int ns = PERMT == 1 ? src_col_in(nd) : (PERMT == 2 ? src_col_ffin(nd) : nd);
#pragma unroll 8
    for (int i = 0; i < 32; ++i) { const int kk = 2 * i + (lane >> 5); scr[kk * 33 + (lane & 31)] = __builtin_nontemporal_load(W + (size_t)(k0 + kk) * N + ns); }
    LDS_WAIT();
    const int c = lane & 7;
#pragma unroll
    for (int j = 0; j < 4; ++j) { const int n = (lane >> 3) + 8 * j; const LAS float* s = scr + (8 * c) * 33 + n;
        u32x4 o; o.x = pk2(s[0 * 33], s[1 * 33]); o.y = pk2(s[2 * 33], s[3 * 33]); o.z = pk2(s[4 * 33], s[5 * 33]); o.w = pk2(s[6 * 33], s[7 * 33]);
        *(u32x4*)(WT + (size_t)(n0 + n) * K + k0 + 8 * c) = o; }
    LDS_WAIT();
}

__device__ __forceinline__ void phase_prologue_a(PP p, LAS unsigned char* lds) {
    int tid_ = threadIdx.x; OPAQUE_V(tid_); const int tid = tid_, lane = tid & 63, wave = __builtin_amdgcn_readfirstlane(tid >> 6);
    const int gw = blockIdx.x * NWAVES + wave, NGW = gridDim.x * NWAVES;
    LAS float* scr = (LAS float*)(lds + wave * 16384);
    bf16_t* WT = (bf16_t*)(p->ws + WS_WT);
    constexpr int I_IN = 16 * (INW / 32), I_MKV = 16 * 32, I_OA = 8 * 32, I_OB = 4 * 32, I_OC = 8 * 32, I_OUT = 16 * 32, I_FIN = 16 * (2 * FFH / 32), I_FOUT = (FFH / 64) * 32;
    constexpr int I_L = I_IN + I_MKV + I_OA + I_OB + I_OC + I_OUT + I_FIN + I_FOUT;
    for (int it = gw; it < I_L * DEPTH; it += NGW) {
        const int l = it / I_L; int r = it % I_L;
        bf16_t* wl = WT + (size_t)l * WL;
        if (r < I_IN) { transpose_item<1>(p->w_in + (size_t)l * DM * INW, DM, INW, wl + WO_IN, scr, r, lane); continue; } r -= I_IN;
        if (r < I_MKV) { transpose_item<0>(p->w_mem_kv + (size_t)l * DM * 1024, DM, 1024, wl + WO_MKV, scr, r, lane); continue; } r -= I_MKV;
        if (r < I_OA) { transpose_item<0>(p->w_o_a + (size_t)l * 512 * DM, 512, DM, wl + WO_OA, scr, r, lane); continue; } r -= I_OA;
        if (r < I_OB) { transpose_item<0>(p->w_o_b + (size_t)l * 256 * DM, 256, DM, wl + WO_OB, scr, r, lane); continue; } r -= I_OB;
        if (r < I_OC) { transpose_item<0>(p->w_o_c + (size_t)l * 512 * DM, 512, DM, wl + WO_OC, scr, r, lane); continue; } r -= I_OC;
        if (r < I_OUT) { transpose_item<0>(p->w_out + (size_t)l * DM * DM, DM, DM, wl + WO_OUT, scr, r, lane); continue; } r -= I_OUT;
        if (r < I_FIN) { transpose_item<2>(p->w_ffn_in + (size_t)l * DM * 2 * FFH, DM, 2 * FFH, wl + WO_FIN, scr, r, lane); continue; } r -= I_FIN;
        transpose_item<0>(p->w_ffn_out + (size_t)l * FFH * DM, FFH, DM, wl + WO_FOUT, scr, r, lane);
    }
    float2* rope = (float2*)(p->ws + WS_ROPE);
    for (int i = blockIdx.x * NTHREADS + tid; i < SEQ * 8; i += gridDim.x * NTHREADS) {
        const int pos = i >> 3, j = i & 7;
        const float ang = (float)pos * p->inv_freq[j];
        const double rev = (double)ang * 0.15915494309189535;
        const float fr = (float)(rev - rint(rev));
        rope[i] = make_float2(__builtin_amdgcn_cosf(fr), __builtin_amdgcn_sinf(fr));
    }
    bf16_t* memn = (bf16_t*)(p->ws + WS_MEMN);
    for (int R = gw; R < NBATCH * NMEM; R += NGW) {
        const float* src = (R < 16 * NMEM) ? p->mem_prompt + (size_t)R * DM : p->mem_sample + (size_t)(R - 16 * NMEM) * DM;
        f32x4 v[4]; float ss = 0.f;
#pragma unroll
        for (int j = 0; j < 4; ++j) { v[j] = *(const f32x4*)(src + 4 * (lane + 64 * j)); ss += v[j].x * v[j].x + v[j].y * v[j].y + v[j].z * v[j].z + v[j].w * v[j].w; }
        const float rstd = 1.f / sqrtf(wave_sum(ss) * (1.f / DM) + EPS);
#pragma unroll
        for (int l = 0; l < DEPTH; ++l)
#pragma unroll
            for (int j = 0; j < 4; ++j) { const f32x4 g = *(const f32x4*)(p->g_mem + l * DM + 4 * (lane + 64 * j));
                u32x2 o; o.x = pk2(v[j].x * rstd * g.x, v[j].y * rstd * g.y); o.y = pk2(v[j].z * rstd * g.z, v[j].w * rstd * g.w);
                *(u32x2*)(memn + ((size_t)l * NBATCH * NMEM + R) * DM + 4 * (lane + 64 * j)) = o; }
    }
}

__device__ __forceinline__ const float* x_in_row(PP p, int GR) { return GR < 16 * SEQ ? p->x_prompt + (size_t)GR * DM : p->x_sample + (size_t)(GR - 16 * SEQ) * DM; }

__device__ __forceinline__ void phase_rows_first(PP p, int chunk) {
    int tid_ = threadIdx.x; OPAQUE_V(tid_); const int lane = tid_ & 63, wave = __builtin_amdgcn_readfirstlane(tid_ >> 6);
    bf16_t* H = (bf16_t*)(p->ws + WS_H);
    for (int r = blockIdx.x * NWAVES + wave; r < MC; r += gridDim.x * NWAVES) {
        const float* src = x_in_row(p, chunk * MC + r);
        f32x4 v[4]; float ss = 0.f;
#pragma unroll
        for (int j = 0; j < 4; ++j) { v[j] = *(const f32x4*)(src + 4 * (lane + 64 * j)); ss += v[j].x * v[j].x + v[j].y * v[j].y + v[j].z * v[j].z + v[j].w * v[j].w; }
        const float rstd = 1.f / sqrtf(wave_sum(ss) * (1.f / DM) + EPS);
#pragma unroll
        for (int j = 0; j < 4; ++j) { const f32x4 g = *(const f32x4*)(p->g_mix_pre + 4 * (lane + 64 * j));
            u32x2 o; o.x = pk2(v[j].x * rstd * g.x, v[j].y * rstd * g.y); o.y = pk2(v[j].z * rstd * g.z, v[j].w * rstd * g.w);
            *(u32x2*)(H + (size_t)r * DM + 4 * (lane + 64 * j)) = o; }
    }
}
template <int MODE> struct RowBuf { f32x4 x[4]; u32x2 y1[4]; u32x2 y2[MODE ? 4 : 1]; };
template <int MODE>
__device__ __forceinline__ void row_load(RowBuf<MODE>& b, const bf16_t* y1row, const bf16_t* y2row, const float* xrow, int lane) {
#pragma unroll
    for (int j = 0; j < 4; ++j) { b.y1[j] = __builtin_nontemporal_load((const u32x2*)(y1row + 4 * (lane + 64 * j))); b.x[j] = __builtin_nontemporal_load((const f32x4*)(xrow + 4 * (lane + 64 * j)));
        if (MODE) b.y2[j] = __builtin_nontemporal_load((const u32x2*)(y2row + 4 * (lane + 64 * j))); }
}
__device__ __forceinline__ f32x4 unpack4(const u32x2 v) { f32x4 r; r.x = bf2f(v.x & 0xffffu); r.y = bf2f(v.x >> 16); r.z = bf2f(v.y & 0xffffu); r.w = bf2f(v.y >> 16); return r; }
__device__ __forceinline__ float row_add_norm(f32x4 (&x)[4], const u32x2 (&yp)[4], const float* g, int lane) {
    f32x4 y[4]; float ss = 0.f;
#pragma unroll
    for (int j = 0; j < 4; ++j) { y[j] = unpack4(yp[j]); ss += y[j].x * y[j].x + y[j].y * y[j].y + y[j].z * y[j].z + y[j].w * y[j].w; }
    const float ry = 1.f / sqrtf(wave_sum(ss) * (1.f / DM) + EPS);
    float sx = 0.f;
#pragma unroll
    for (int j = 0; j < 4; ++j) { const f32x4 gg = *(const f32x4*)(g + 4 * (lane + 64 * j));
        x[j].x += y[j].x * ry * gg.x; x[j].y += y[j].y * ry * gg.y; x[j].z += y[j].z * ry * gg.z; x[j].w += y[j].w * ry * gg.w;
        sx += x[j].x * x[j].x + x[j].y * x[j].y + x[j].z * x[j].z + x[j].w * x[j].w; }
    return sx;
}
template <int MODE>
__device__ __forceinline__ void row_process(RowBuf<MODE>& b, float* dst, bf16_t* hrow, const float* g_mid, const float* g_end, const float* g_next, bool write_h, int lane) {
    float sx = row_add_norm(b.x, b.y1, g_mid, lane);
    if (MODE) {
        u32x2 y2[4];
#pragma unroll
        for (int j = 0; j < 4; ++j) y2[j] = b.y2[j];
        sx = row_add_norm(b.x, y2, g_end, lane);
#pragma unroll
        for (int j = 0; j < 4; ++j) __builtin_nontemporal_store(b.x[j], (f32x4*)(dst + 4 * (lane + 64 * j)));
    }
    if (write_h) {
        const float rx = 1.f / sqrtf(wave_sum(sx) * (1.f / DM) + EPS);
#pragma unroll
        for (int j = 0; j < 4; ++j) { const f32x4 g = *(const f32x4*)(g_next + 4 * (lane + 64 * j)); const f32x4 x = b.x[j];
            u32x2 o; o.x = pk2(x.x * rx * g.x, x.y * rx * g.y); o.y = pk2(x.z * rx * g.z, x.w * rx * g.w);
            *(u32x2*)(hrow + 4 * (lane + 64 * j)) = o; }
    }
}
template <int MODE>
__device__ __forceinline__ void phase_rows_resid(PP p, int chunk, bool src_is_input, const float* g_mid, const float* g_end, const float* g_next, bool write_h) {
    int tid_ = threadIdx.x; OPAQUE_V(tid_); const int lane = tid_ & 63, wave = __builtin_amdgcn_readfirstlane(tid_ >> 6);
    bf16_t* H = (bf16_t*)(p->ws + WS_H);
    const bf16_t* Y1 = (const bf16_t*)(p->ws + WS_Y); const bf16_t* Y2 = (const bf16_t*)(p->ws + WS_Y2);
    float* out = p->out;
    const int stride = gridDim.x * NWAVES;
    int r = blockIdx.x * NWAVES + wave;
    if (r >= MC) return;
    RowBuf<MODE> A, B;
#define ROW_SRC(rr) (src_is_input ? x_in_row(p, chunk * MC + (rr)) : out + (size_t)(chunk * MC + (rr)) * DM)
#define ROW_LD(buf, rr) row_load<MODE>(buf, Y1 + (size_t)(rr) * DM, Y2 + (size_t)(rr) * DM, ROW_SRC(rr), lane)
#define ROW_DO(buf, rr) row_process<MODE>(buf, out + (size_t)(chunk * MC + (rr)) * DM, H + (size_t)(rr) * DM, g_mid, g_end, g_next, write_h, lane)
    ROW_LD(A, r);
    for (;;) {
        const int r1 = r + stride;
        if (r1 < MC) ROW_LD(B, r1);
        ROW_DO(A, r);
        if (r1 >= MC) break;
        const int r2 = r1 + stride;
        if (r2 < MC) ROW_LD(A, r2);
        ROW_DO(B, r1);
        if (r2 >= MC) break;
        r = r2;
    }
#undef ROW_SRC
#undef ROW_LD
#undef ROW_DO
}

__device__ __forceinline__ int pi32(int r) { return (r & 0x13) | ((r & 4) << 1) | ((r & 8) >> 1); }
template <int D> __device__ __forceinline__ size_t kblk_off(int p, int c8) { const int kt = p >> 5, r = pi32(p & 31); return ((size_t)(kt * (D / 16) + (c8 >> 1)) * 64 + (c8 & 1) * 32 + r) * 8; }
template <int D> __device__ __forceinline__ size_t vblk_off(int p, int d) { const int kt = p >> 5, w = p & 31; return ((((size_t)kt * (D / 32) + (d >> 5)) * 2 + (w >> 4)) * 64 + ((w >> 3) & 1) * 32 + (d & 31)) * 8 + (w & 7); }
template <int D> __device__ __forceinline__ void store8_vblk(bf16_t* img, int p, int d0, const f32x4& a, const f32x4& b) {
    const unsigned o0 = pk2(a.x, a.y), o1 = pk2(a.z, a.w), o2 = pk2(b.x, b.y), o3 = pk2(b.z, b.w);
    bf16_t* base = img + vblk_off<D>(p, d0);
    base[0] = (bf16_t)(o0 & 0xffffu); base[8] = (bf16_t)(o0 >> 16); base[16] = (bf16_t)(o1 & 0xffffu); base[24] = (bf16_t)(o1 >> 16);
    base[32] = (bf16_t)(o2 & 0xffffu); base[40] = (bf16_t)(o2 >> 16); base[48] = (bf16_t)(o3 & 0xffffu); base[56] = (bf16_t)(o3 >> 16);
}
__device__ __forceinline__ u32x4 pack8(const f32x4& a, const f32x4& b) { u32x4 o; o.x = pk2(a.x, a.y); o.y = pk2(a.z, a.w); o.z = pk2(b.x, b.y); o.w = pk2(b.z, b.w); return o; }
__device__ __forceinline__ void store8_strided(bf16_t* base, size_t stride, const f32x4& a, const f32x4& b) {
    const u32x4 o = pack8(a, b);
    base[0 * stride] = (bf16_t)(o.x & 0xffffu); base[1 * stride] = (bf16_t)(o.x >> 16); base[2 * stride] = (bf16_t)(o.y & 0xffffu); base[3 * stride] = (bf16_t)(o.y >> 16);
    base[4 * stride] = (bf16_t)(o.z & 0xffffu); base[5 * stride] = (bf16_t)(o.z >> 16); base[6 * stride] = (bf16_t)(o.w & 0xffffu); base[7 * stride] = (bf16_t)(o.w >> 16);
}
struct EpiIn {
    static constexpr bool PERM = true, AFTER_DRAIN = false;
    bf16_t* proj; bf16_t* vta; bf16_t* vtb; bf16_t* kba; bf16_t* kbb; const float* rope;
    __device__ __forceinline__ void operator()(const f32x4 (&acc)[2][2][4][2], const pg8::Unit& u, int wr, int wc, int fr, int fq) const {
        const int row0 = u.pm * 256 + wr * 64 + fr;
#pragma unroll
        for (int bj = 0; bj < 2; ++bj) {
            const int c128 = u.pn * 256 + bj * 128, cb = c128 + wc * 32 + 8 * fq;
            if (c128 >= 3584) {
#pragma unroll
                for (int ai = 0; ai < 2; ++ai)
#pragma unroll
                    for (int m = 0; m < 4; ++m) { const int row = row0 + ai * 128 + m * 16; f32x4 a = acc[ai][bj][m][0], b = acc[ai][bj][m][1];
                        a.x = sigmoidf_(a.x); a.y = sigmoidf_(a.y); a.z = sigmoidf_(a.z); a.w = sigmoidf_(a.w); b.x = sigmoidf_(b.x); b.y = sigmoidf_(b.y); b.z = sigmoidf_(b.z); b.w = sigmoidf_(b.w);
                        __builtin_nontemporal_store(pack8(a, b), (u32x4*)(proj + (size_t)row * INW + cb)); }
            } else if (c128 >= 3072) {
#pragma unroll
                for (int ai = 0; ai < 2; ++ai)
#pragma unroll
                    for (int m = 0; m < 4; ++m) { const int row = row0 + ai * 128 + m * 16; __builtin_nontemporal_store(pack8(acc[ai][bj][m][0], acc[ai][bj][m][1]), (u32x4*)(proj + (size_t)row * INW + cb)); }
            } else if (c128 == 640) {
                const int kvh = (cb - 640) >> 6, d0 = (cb - 640) & 63;
#pragma unroll
                for (int ai = 0; ai < 2; ++ai)
#pragma unroll
                    for (int m = 0; m < 4; ++m) { const int row = row0 + ai * 128 + m * 16, bl = row >> 11, pos = row & 2047;
                        store8_vblk<64>(vta + (size_t)(bl * 2 + kvh) * 64 * SEQ, pos, d0, acc[ai][bj][m][0], acc[ai][bj][m][1]); }
            } else if (c128 >= 2304) {
                const int hb = (cb - 2304) >> 6, d0 = (cb - 2304) & 63, sh = 2 * (hb >> 2);
#pragma unroll
                for (int ai = 0; ai < 2; ++ai)
#pragma unroll
                    for (int m = 0; m < 4; ++m) { const int row = row0 + ai * 128 + m * 16, bl = row >> 11, pos = row & 2047;
                        const int pg = (pos & ((1 << sh) - 1)) * (SEQ >> sh) + (pos >> sh);
                        store8_vblk<64>(vtb + (size_t)(bl * 12 + hb) * 64 * SEQ, pg, d0, acc[ai][bj][m][0], acc[ai][bj][m][1]); }
            } else {
                const bool rp = ((wc & 1) == 0) && (fq < 2);
#pragma unroll
                for (int ai = 0; ai < 2; ++ai)
#pragma unroll
                    for (int m = 0; m < 4; ++m) { const int row = row0 + ai * 128 + m * 16; f32x4 a = acc[ai][bj][m][0], b = acc[ai][bj][m][1];
                        if (rp) { const int pos = row & 2047; const f32x4* t = (const f32x4*)(rope + (size_t)pos * 16 + 8 * fq); const f32x4 t0 = t[0], t1 = t[1];
                            f32x4 a2, b2;
                            a2.x = a.x * t0.x - a.y * t0.y; a2.y = a.y * t0.x + a.x * t0.y; a2.z = a.z * t0.z - a.w * t0.w; a2.w = a.w * t0.z + a.z * t0.w;
                            b2.x = b.x * t1.x - b.y * t1.y; b2.y = b.y * t1.x + b.x * t1.y; b2.z = b.z * t1.z - b.w * t1.w; b2.w = b.w * t1.z + b.z * t1.w;
                            a = a2; b = b2; }
                        if (c128 == 512) {
                            const int bl = row >> 11, pos = row & 2047, kvh = (cb - 512) >> 6, c8 = ((cb - 512) & 63) >> 3;
                            *(u32x4*)(kba + (size_t)(bl * 2 + kvh) * 64 * SEQ + kblk_off<64>(pos, c8)) = pack8(a, b);
                        } else if (c128 >= 1536) {
                            const int bl = row >> 11, pos = row & 2047, hb = (cb - 1536) >> 6, c8 = ((cb - 1536) & 63) >> 3, sh = 2 * (hb >> 2);
                            const int pg = (pos & ((1 << sh) - 1)) * (SEQ >> sh) + (pos >> sh);
                            *(u32x4*)(kbb + (size_t)(bl * 12 + hb) * 64 * SEQ + kblk_off<64>(pg, c8)) = pack8(a, b);
                        } else __builtin_nontemporal_store(pack8(a, b), (u32x4*)(proj + (size_t)row * INW + cb)); }
            }
        }
    }
};
struct EpiMemKV {
    static constexpr bool PERM = true, AFTER_DRAIN = false;
    bf16_t* mk; bf16_t* mvt;
    __device__ __forceinline__ void operator()(const f32x4 (&acc)[2][2][4][2], const pg8::Unit& u, int wr, int wc, int fr, int fq) const {
        const int row0 = u.pm * 256 + wr * 64 + fr;
#pragma unroll
        for (int bj = 0; bj < 2; ++bj) {
            const int c128 = u.pn * 256 + bj * 128, cb = c128 + wc * 32 + 8 * fq;
            if (c128 < 512) {
#pragma unroll
                for (int ai = 0; ai < 2; ++ai)
#pragma unroll
                    for (int m = 0; m < 4; ++m) { const int row = row0 + ai * 128 + m * 16, b = row >> 8, j = row & 255, hc = cb >> 7, c8 = (cb & 127) >> 3;
                        *(u32x4*)(mk + (size_t)(b * 4 + hc) * 128 * NMEM + kblk_off<128>(j, c8)) = pack8(acc[ai][bj][m][0], acc[ai][bj][m][1]); }
            } else {
                const int hc = (cb - 512) >> 7, d0 = (cb - 512) & 127;
#pragma unroll
                for (int ai = 0; ai < 2; ++ai)
#pragma unroll
                    for (int m = 0; m < 4; ++m) { const int row = row0 + ai * 128 + m * 16, b = row >> 8, j = row & 255;
                        store8_vblk<128>(mvt + (size_t)(b * 4 + hc) * 128 * NMEM, j, d0, acc[ai][bj][m][0], acc[ai][bj][m][1]); }
            }
        }
    }
};
struct EpiGate {
    static constexpr bool PERM = true, AFTER_DRAIN = false;
    const bf16_t* gate; bf16_t* mrg; int accum;
    __device__ __forceinline__ void operator()(const f32x4 (&acc)[2][2][4][2], const pg8::Unit& u, int wr, int wc, int fr, int fq) const {
        const int row0 = u.pm * 256 + wr * 64 + fr, cb0 = u.pn * 256 + wc * 32 + 8 * fq;
#pragma unroll
        for (int ai = 0; ai < 2; ++ai) {
            u32x4 g[4][2], o[4][2];
#pragma unroll
            for (int m = 0; m < 4; ++m)
#pragma unroll
                for (int bj = 0; bj < 2; ++bj) g[m][bj] = __builtin_nontemporal_load((const u32x4*)(gate + (size_t)(row0 + ai * 128 + m * 16) * INW + cb0 + bj * 128));
            if (accum) {
#pragma unroll
                for (int m = 0; m < 4; ++m)
#pragma unroll
                    for (int bj = 0; bj < 2; ++bj) o[m][bj] = *(const u32x4*)(mrg + (size_t)(row0 + ai * 128 + m * 16) * DM + cb0 + bj * 128);
            }
#pragma unroll
            for (int m = 0; m < 4; ++m)
#pragma unroll
                for (int bj = 0; bj < 2; ++bj) {
                    const u32x4 gg = g[m][bj];
                    f32x4 a = acc[ai][bj][m][0], b = acc[ai][bj][m][1];
                    a.x *= bf2f(gg.x & 0xffffu); a.y *= bf2f(gg.x >> 16); a.z *= bf2f(gg.y & 0xffffu); a.w *= bf2f(gg.y >> 16);
                    b.x *= bf2f(gg.z & 0xffffu); b.y *= bf2f(gg.z >> 16); b.z *= bf2f(gg.w & 0xffffu); b.w *= bf2f(gg.w >> 16);
                    if (accum) { const u32x4 oo = o[m][bj];
                        a.x += bf2f(oo.x & 0xffffu); a.y += bf2f(oo.x >> 16); a.z += bf2f(oo.y & 0xffffu); a.w += bf2f(oo.y >> 16);
                        b.x += bf2f(oo.z & 0xffffu); b.y += bf2f(oo.z >> 16); b.z += bf2f(oo.w & 0xffffu); b.w += bf2f(oo.w >> 16); }
                    *(u32x4*)(mrg + (size_t)(row0 + ai * 128 + m * 16) * DM + cb0 + bj * 128) = pack8(a, b);
                }
        }
    }
};
struct EpiY {
    static constexpr bool PERM = true, AFTER_DRAIN = false;
    bf16_t* Y;
    __device__ __forceinline__ void operator()(const f32x4 (&acc)[2][2][4][2], const pg8::Unit& u, int wr, int wc, int fr, int fq) const {
        const int row0 = u.pm * 256 + wr * 64 + fr;
#pragma unroll
        for (int ai = 0; ai < 2; ++ai)
#pragma unroll
            for (int m = 0; m < 4; ++m)
#pragma unroll
                for (int bj = 0; bj < 2; ++bj)
                    *(u32x4*)(Y + (size_t)(row0 + ai * 128 + m * 16) * DM + u.pn * 256 + bj * 128 + wc * 32 + 8 * fq) = pack8(acc[ai][bj][m][0], acc[ai][bj][m][1]);
    }
};
struct EpiSwiGLU {
    static constexpr bool PERM = true, AFTER_DRAIN = false;
    bf16_t* act;
    __device__ __forceinline__ void operator()(const f32x4 (&acc)[2][2][4][2], const pg8::Unit& u, int wr, int wc, int fr, int fq) const {
        const int row0 = u.pm * 256 + wr * 64 + fr;
#pragma unroll
        for (int ai = 0; ai < 2; ++ai)
#pragma unroll
            for (int m = 0; m < 4; ++m)
#pragma unroll
                for (int bj = 0; bj < 2; ++bj) { const int cb = u.pn * 256 + bj * 128 + wc * 32 + 8 * fq; const f32x4 g = acc[ai][bj][m][0], v = acc[ai][bj][m][1];
                    u32x2 o; o.x = pk2(g.x * sigmoidf_(g.x) * v.x, g.y * sigmoidf_(g.y) * v.y); o.y = pk2(g.z * sigmoidf_(g.z) * v.z, g.w * sigmoidf_(g.w) * v.w);
                    *(u32x2*)(act + (size_t)(row0 + ai * 128 + m * 16) * FFH + (cb >> 1)) = o; }
    }
};
#ifndef GATE_FAST
#define GATE_FAST true
#endif
template <class Epi, bool FAST = true>
__device__ __forceinline__ void run_gemm(LAS unsigned char* lds, const bf16_t* A, const bf16_t* Bt, int M, int N, int K, const Epi& E, int crot) {
    pg8::Gemm g; g.A = A; g.Bt = Bt; g.M = M; g.N = N; g.K = K;
#ifndef WGM_WIDE
#define WGM_WIDE 4
#endif
#ifndef WGM_NARROW
#define WGM_NARROW 8
#endif
    pg8::StaticOrder S; S.init(M, N, (int)gridDim.x, (int)((blockIdx.x + crot) % gridDim.x), N > 1024 ? WGM_WIDE : WGM_NARROW);
    pg8::gemm_phase<Epi, pg8::StaticOrder, FAST, FAST>(lds, g, S, E);
}

struct AttnTask {
    const bf16_t* q; long qstride;
    const bf16_t* kb; const bf16_t* vb;
    bf16_t* o; long ostride;
    float* lse; long lsestride;
    int m0, L, W;
    float m_init, l_init, scale2;
};
template <int D>
__device__ __forceinline__ void attn_load_k(bf16x8 (&kf)[D / 16], const AttnTask& t, int k0, int lane) {
    const bf16_t* kp = t.kb + ((size_t)(k0 >> 5) * (D / 16) * 64 + lane) * 8;
#pragma unroll
    for (int kk = 0; kk < D / 16; ++kk) kf[kk] = *(const bf16x8*)(kp + kk * 512);
}
template <int D>
__device__ __forceinline__ void attn_load_v(bf16x8 (&vf)[D / 32][2], const AttnTask& t, int k0, int lane) {
    const bf16_t* vp = t.vb + ((size_t)(k0 >> 5) * (D / 32) * 128 + lane) * 8;
#pragma unroll
    for (int db = 0; db < D / 32; ++db)
#pragma unroll
        for (int s = 0; s < 2; ++s) vf[db][s] = *(const bf16x8*)(vp + (db * 2 + s) * 512);
}
__device__ __forceinline__ float xhalf_max(float v) { const auto r = __builtin_amdgcn_permlane32_swap(__float_as_uint(v), __float_as_uint(v), false, false); return fmaxf(__uint_as_float(r[0]), __uint_as_float(r[1])); }
__device__ __forceinline__ float xhalf_sum(float v) { const auto r = __builtin_amdgcn_permlane32_swap(__float_as_uint(v), __float_as_uint(v), false, false); return __uint_as_float(r[0]) + __uint_as_float(r[1]); }
template <int D, bool MASK>
__device__ __forceinline__ void attn_tile(const bf16x8 (&qf)[D / 16], const bf16x8 (&kf)[D / 16], const bf16x8 (&vf)[D / 32][2], f32x16 (&o)[D / 32], float& mrun, float& lrun,
                                          const AttnTask& t, int k0, int mq, int qi, int h) {
    f32x16 sc;
#pragma unroll
    for (int i = 0; i < 16; ++i) sc[i] = 0.f;
#pragma unroll
    for (int kk = 0; kk < D / 16; ++kk) sc = __builtin_amdgcn_mfma_f32_32x32x16_bf16(kf[kk], qf[kk], sc, 0, 0, 0);
    if (MASK) {
        if (k0 == mq - t.W || k0 == mq + t.W) {
#pragma unroll
            for (int i = 0; i < 16; ++i) { const int dlt = k0 + 16 * (i >> 3) + 8 * h + (i & 7) - qi; sc[i] = (dlt <= t.W && dlt >= -t.W) ? sc[i] : -1e30f; }
        }
    }
    float mt = sc[0];
#pragma unroll
    for (int i = 1; i < 16; ++i) mt = fmaxf(mt, sc[i]);
    mt = xhalf_max(mt) * t.scale2;
    const float mn = fmaxf(mrun, mt), alpha = fexp2(mrun - mn);
    float ps = 0.f;
#pragma unroll
    for (int i = 0; i < 16; ++i) { sc[i] = fexp2(__builtin_fmaf(sc[i], t.scale2, -mn)); ps += sc[i]; }
    ps = xhalf_sum(ps);
    lrun = lrun * alpha + ps; mrun = mn;
#pragma unroll
    for (int db = 0; db < D / 32; ++db)
#pragma unroll
        for (int i = 0; i < 16; ++i) o[db][i] *= alpha;
    bf16x8 pf[2];
#pragma unroll
    for (int s = 0; s < 2; ++s) { u32x4 w; w.x = pk2(sc[8 * s + 0], sc[8 * s + 1]); w.y = pk2(sc[8 * s + 2], sc[8 * s + 3]); w.z = pk2(sc[8 * s + 4], sc[8 * s + 5]); w.w = pk2(sc[8 * s + 6], sc[8 * s + 7]);
        pf[s] = __builtin_bit_cast(bf16x8, w); }
#pragma unroll
    for (int db = 0; db < D / 32; ++db)
#pragma unroll
        for (int s = 0; s < 2; ++s) o[db] = __builtin_amdgcn_mfma_f32_32x32x16_bf16(vf[db][s], pf[s], o[db], 0, 0, 0);
}
template <int D, bool MASK, bool PFV, int NQ>
__device__ __forceinline__ void attn_wave(const AttnTask& t, LAS unsigned char* scr, int lane) {
    const int r = lane & 31, h = lane >> 5;
    bf16x8 qf[NQ][D / 16];
#pragma unroll
    for (int q = 0; q < NQ; ++q) { const bf16_t* qp = t.q + (long)(t.m0 + 32 * q + r) * t.qstride + 8 * h;
#pragma unroll
        for (int kk = 0; kk < D / 16; ++kk) qf[q][kk] = *(const bf16x8*)(qp + 16 * kk); }
    f32x16 o[NQ][D / 32];
    float mrun[NQ], lrun[NQ];
#pragma unroll
    for (int q = 0; q < NQ; ++q) { mrun[q] = t.m_init; lrun[q] = t.l_init;
#pragma unroll
        for (int db = 0; db < D / 32; ++db)
#pragma unroll
            for (int i = 0; i < 16; ++i) o[q][db][i] = 0.f; }
    int klo = 0, khi = t.L;
    if (MASK) { klo = t.m0 - t.W; if (klo < 0) klo = 0; khi = t.m0 + 32 * NQ + t.W; if (khi > t.L) khi = t.L; }
    bf16x8 ka[D / 16], kb[D / 16], va[D / 32][2], vb[D / 32][2];
    attn_load_k<D>(ka, t, klo, lane);
    attn_load_v<D>(va, t, klo, lane);
#define ATT_TILES(KF, VF, K0) do { _Pragma("unroll") for (int q = 0; q < NQ; ++q) { const int mq = t.m0 + 32 * q; \
        if (!MASK || NQ == 1 || ((K0) >= mq - t.W && (K0) <= mq + t.W)) attn_tile<D, MASK>(qf[q], KF, VF, o[q], mrun[q], lrun[q], t, (K0), mq, mq + r, h); } } while (0)
    for (int k0 = klo; k0 < khi; k0 += 64) {
        const int k1 = k0 + 32, k2 = (k0 + 64 < khi) ? k0 + 64 : klo;
        const bool has1 = k1 < khi;
        attn_load_k<D>(kb, t, has1 ? k1 : klo, lane);
        if (PFV) attn_load_v<D>(vb, t, has1 ? k1 : klo, lane);
        __builtin_amdgcn_sched_barrier(0);
        ATT_TILES(ka, va, k0);
        __builtin_amdgcn_sched_barrier(0);
        if (!has1) break;
        if (!PFV) attn_load_v<D>(vb, t, k1, lane);
        attn_load_k<D>(ka, t, k2, lane);
        if (PFV) attn_load_v<D>(va, t, k2, lane);
        __builtin_amdgcn_sched_barrier(0);
        ATT_TILES(kb, vb, k1);
        __builtin_amdgcn_sched_barrier(0);
        if (!PFV) attn_load_v<D>(va, t, k2, lane);
    }
#undef ATT_TILES
#pragma unroll
    for (int q = 0; q < NQ; ++q) {
        const int qi = t.m0 + 32 * q + r;
        const float inv = 1.f / lrun[q];
        constexpr int RS = 2 * D + 16;
#pragma unroll
        for (int db = 0; db < D / 32; ++db)
#pragma unroll
            for (int g = 0; g < 4; ++g) { u32x2 w; w.x = pk2(o[q][db][4 * g + 0] * inv, o[q][db][4 * g + 1] * inv); w.y = pk2(o[q][db][4 * g + 2] * inv, o[q][db][4 * g + 3] * inv);
                *(LAS u32x2*)(scr + r * RS + (32 * db + 8 * g + 4 * h) * 2) = w; }
        LDS_WAIT();
        constexpr int CPR = D / 8, RPI = 64 / CPR;
#pragma unroll
        for (int it = 0; it < 32 / RPI; ++it) { const int row = it * RPI + lane / CPR, ch = lane % CPR;
            const u32x4 v = *(const LAS u32x4*)(scr + row * RS + ch * 16);
            *(u32x4*)(t.o + (long)(t.m0 + 32 * q + row) * t.ostride + ch * 8) = v; }
        LDS_WAIT();
        if (t.lse != nullptr && h == 0) t.lse[(long)qi * t.lsestride] = (mrun[q] + __builtin_amdgcn_logf(lrun[q])) * LN2;
    }
}

__device__ __forceinline__ void attn_wave_mem_lds(const AttnTask& t, LAS unsigned char* lds, int lane) {
    constexpr int D = 128;
    const int r = lane & 31, h = lane >> 5;
    bf16x8 qf[D / 16];
    const bf16_t* qp = t.q + (long)(t.m0 + r) * t.qstride + 8 * h;
#pragma unroll
    for (int kk = 0; kk < D / 16; ++kk) qf[kk] = *(const bf16x8*)(qp + 16 * kk);
    f32x16 o[D / 32];
#pragma unroll
    for (int db = 0; db < D / 32; ++db)
#pragma unroll
        for (int i = 0; i < 16; ++i) o[db][i] = 0.f;
    float mrun = t.m_init, lrun = t.l_init;
    const int qi = t.m0 + r;
    for (int kt = 0; kt < NMEM / 32; ++kt) {
        bf16x8 kf[D / 16], vf[D / 32][2];
#pragma unroll
        for (int kk = 0; kk < D / 16; ++kk) kf[kk] = *(const LAS bf16x8*)(lds + ((kt * (D / 16) + kk) * 64 + lane) * 16);
#pragma unroll
        for (int db = 0; db < D / 32; ++db)
#pragma unroll
            for (int s = 0; s < 2; ++s) vf[db][s] = *(const LAS bf16x8*)(lds + 65536 + (((kt * (D / 32) + db) * 2 + s) * 64 + lane) * 16);
        attn_tile<D, false>(qf, kf, vf, o, mrun, lrun, t, kt * 32, t.m0, qi, h);
    }
    const float inv = 1.f / lrun;
    bf16_t* op = t.o + (long)qi * t.ostride + 4 * h;
#pragma unroll
    for (int db = 0; db < D / 32; ++db)
#pragma unroll
        for (int g = 0; g < 4; ++g) { u32x2 w; w.x = pk2(o[db][4 * g + 0] * inv, o[db][4 * g + 1] * inv); w.y = pk2(o[db][4 * g + 2] * inv, o[db][4 * g + 3] * inv);
            *(u32x2*)(op + 32 * db + 8 * g) = w; }
}

__device__ __forceinline__ void attn_wave_win_lds(const AttnTask& t, LAS unsigned char* lds, int kt0, int lane) {
    constexpr int D = 64;
    const int r = lane & 31, h = lane >> 5;
    bf16x8 qf[D / 16];
    const bf16_t* qp = t.q + (long)(t.m0 + r) * t.qstride + 8 * h;
#pragma unroll
    for (int kk = 0; kk < D / 16; ++kk) qf[kk] = *(const bf16x8*)(qp + 16 * kk);
    f32x16 o[D / 32];
#pragma unroll
    for (int db = 0; db < D / 32; ++db)
#pragma unroll
        for (int i = 0; i < 16; ++i) o[db][i] = 0.f;
    float mrun = t.m_init, lrun = t.l_init;
    const int qi = t.m0 + r;
    int kta = (t.m0 - t.W) >> 5, ktb = (t.m0 + t.W) >> 5;
    if (kta < 0) kta = 0;
    if (ktb > t.L / 32 - 1) ktb = t.L / 32 - 1;
    for (int kt = kta; kt <= ktb; ++kt) {
        const int slot = kt - kt0;
        bf16x8 kf[D / 16], vf[D / 32][2];
#pragma unroll
        for (int kk = 0; kk < D / 16; ++kk) kf[kk] = *(const LAS bf16x8*)(lds + ((slot * (D / 16) + kk) * 64 + lane) * 16);
#pragma unroll
        for (int db = 0; db < D / 32; ++db)
#pragma unroll
            for (int s = 0; s < 2; ++s) vf[db][s] = *(const LAS bf16x8*)(lds + 65536 + (((slot * (D / 32) + db) * 2 + s) * 64 + lane) * 16);
        attn_tile<D, true>(qf, kf, vf, o, mrun, lrun, t, kt * 32, t.m0, qi, h);
    }
    const float inv = 1.f / lrun;
    bf16_t* op = t.o + (long)qi * t.ostride + 4 * h;
#pragma unroll
    for (int db = 0; db < D / 32; ++db)
#pragma unroll
        for (int g = 0; g < 4; ++g) { u32x2 w; w.x = pk2(o[db][4 * g + 0] * inv, o[db][4 * g + 1] * inv); w.y = pk2(o[db][4 * g + 2] * inv, o[db][4 * g + 3] * inv);
            *(u32x2*)(op + 32 * db + 8 * g) = w; }
}

__device__ __forceinline__ void phase_attention(PP p, LAS unsigned char* lds, int chunk, int layer) {
    int tid_ = threadIdx.x; OPAQUE_V(tid_); const int tid = tid_, lane = tid & 63, wave = __builtin_amdgcn_readfirstlane(tid >> 6);
    const bf16_t* proj = (const bf16_t*)(p->ws + WS_PROJ);
    const bf16_t* vta = (const bf16_t*)(p->ws + WS_VTA);
    const bf16_t* vtb = (const bf16_t*)(p->ws + WS_VTB);
    const bf16_t* kba = (const bf16_t*)(p->ws + WS_KBA); const bf16_t* kbb = (const bf16_t*)(p->ws + WS_KBB);
    bf16_t* oa = (bf16_t*)(p->ws + WS_OA); bf16_t* ob = (bf16_t*)(p->ws + WS_OB); bf16_t* oc = (bf16_t*)(p->ws + WS_OC);
    bf16_t* og = (bf16_t*)(p->ws + WS_OG); float* lseb = (float*)(p->ws + WS_LSE);
    const bf16_t* memk = (const bf16_t*)(p->ws + WS_MEMK) + (size_t)layer * NBATCH * NMEM * 512;
    const bf16_t* memvt = (const bf16_t*)(p->ws + WS_MEMVT) + (size_t)layer * NBATCH * NMEM * 512;
    constexpr int NT_B = CB * 4 * 4, NT_A = CB * 8 * 8, NT_C = CB * 4 * 8;
    for (int task = blockIdx.x; task < NT_B + NT_A + NT_C; task += gridDim.x) {
        if (task < NT_B) {
            const int bl = (task & 63) >> 2, hh = task & 3, sp = task >> 6;
            for (int wt = wave; wt < 32; wt += NWAVES) {
                const int g = wt < 8 ? 0 : (wt < 16 ? 1 : 2), tq = wt < 16 ? (wt & 7) : (wt - 16), sh = 2 * g, dil = 1 << sh, L = SEQ >> sh, hb = 4 * g + hh;
                int c, m0;
                if (g == 0) { c = 0; m0 = sp * 512 + 64 * tq; } else if (g == 1) { c = tq >> 1; m0 = sp * 128 + 64 * (tq & 1); } else { c = tq; m0 = sp * 32; }
                AttnTask t;
                const size_t rowb = (size_t)bl * SEQ + c;
                t.q = proj + rowb * INW + 768 + hb * 64; t.qstride = (long)dil * INW;
                t.kb = kbb + (size_t)(bl * 12 + hb) * 64 * SEQ + (size_t)c * L * 64; t.vb = vtb + (size_t)(bl * 12 + hb) * 64 * SEQ + (size_t)c * L * 64;
                t.o = og + (size_t)g * MC * 256 + rowb * 256 + hh * 64; t.ostride = (long)dil * 256;
                t.lse = lseb + (size_t)g * MC * 4 + rowb * 4 + hh; t.lsestride = (long)dil * 4;
                t.m0 = m0; t.L = L; t.W = 64; t.m_init = -1e30f; t.l_init = 0.f; t.scale2 = 0.125f * LOG2E;
                if (g == 2) attn_wave<64, true, true, 1>(t, lds + wave * 8192, lane); else attn_wave<64, true, true, 2>(t, lds + wave * 8192, lane);
            }
            __syncthreads();
            {
                const size_t row = (size_t)bl * SEQ + sp * 512 + tid;
                const float l0 = lseb[row * 4 + hh], l1 = lseb[(size_t)MC * 4 + row * 4 + hh], l2 = lseb[(size_t)2 * MC * 4 + row * 4 + hh];
                const float mx = fmaxf(l0, fmaxf(l1, l2));
                float a0 = fexp2((l0 - mx) * LOG2E), a1 = fexp2((l1 - mx) * LOG2E), a2 = fexp2((l2 - mx) * LOG2E);
                const float is = 1.f / (a0 + a1 + a2); a0 *= is; a1 *= is; a2 *= is;
                const bf16_t* s0 = og + row * 256 + hh * 64; const bf16_t* s1 = s0 + (size_t)MC * 256; const bf16_t* s2 = s1 + (size_t)MC * 256;
                bf16_t* dp = ob + row * 256 + hh * 64;
#pragma unroll
                for (int j = 0; j < 8; ++j) { const u32x4 x0 = *(const u32x4*)(s0 + 8 * j), x1 = *(const u32x4*)(s1 + 8 * j), x2 = *(const u32x4*)(s2 + 8 * j);
                    u32x4 w;
                    w.x = pk2(a0 * bf2f(x0.x & 0xffffu) + a1 * bf2f(x1.x & 0xffffu) + a2 * bf2f(x2.x & 0xffffu), a0 * bf2f(x0.x >> 16) + a1 * bf2f(x1.x >> 16) + a2 * bf2f(x2.x >> 16));
                    w.y = pk2(a0 * bf2f(x0.y & 0xffffu) + a1 * bf2f(x1.y & 0xffffu) + a2 * bf2f(x2.y & 0xffffu), a0 * bf2f(x0.y >> 16) + a1 * bf2f(x1.y >> 16) + a2 * bf2f(x2.y >> 16));
                    w.z = pk2(a0 * bf2f(x0.z & 0xffffu) + a1 * bf2f(x1.z & 0xffffu) + a2 * bf2f(x2.z & 0xffffu), a0 * bf2f(x0.z >> 16) + a1 * bf2f(x1.z >> 16) + a2 * bf2f(x2.z >> 16));
                    w.w = pk2(a0 * bf2f(x0.w & 0xffffu) + a1 * bf2f(x1.w & 0xffffu) + a2 * bf2f(x2.w & 0xffffu), a0 * bf2f(x0.w >> 16) + a1 * bf2f(x1.w >> 16) + a2 * bf2f(x2.w >> 16));
                    *(u32x4*)(dp + 8 * j) = w; }
            }
            __syncthreads();
        } else
        if (task < NT_B + NT_A) {
            const int ta = task - NT_B, bk = ta & 31, inr = ta >> 5, bl = bk >> 1, ha = (bk & 1) * 4 + (inr >> 3), sp = inr & 7;
            AttnTask t;
            const size_t rowb = (size_t)bl * SEQ;
            t.q = proj + rowb * INW + ha * 64; t.qstride = INW;
            t.kb = kba + (size_t)(bl * 2 + (ha >> 2)) * 64 * SEQ; t.vb = vta + (size_t)(bl * 2 + (ha >> 2)) * 64 * SEQ;
            t.o = oa + rowb * 512 + ha * 64; t.ostride = 512; t.lse = nullptr; t.lsestride = 0;
            t.m0 = sp * 256 + 32 * wave; t.L = SEQ; t.W = 128; t.m_init = p->sink_a[layer * 8 + ha] * LOG2E; t.l_init = 1.f; t.scale2 = 0.125f * LOG2E;
            const int kt0 = 8 * sp - 4;
            {
                const char* ks = (const char*)t.kb + (long)kt0 * 4096; const char* vs = (const char*)t.vb + (long)kt0 * 4096;
                u32x4 tmp[16];
#pragma unroll
                for (int i = 0; i < 8; ++i) { const int c = tid + 512 * i, kt = kt0 + (c >> 8); const bool ok = kt >= 0 && kt < SEQ / 32;
                    tmp[i] = ok ? *(const u32x4*)(ks + (long)c * 16) : (u32x4){0u, 0u, 0u, 0u}; tmp[8 + i] = ok ? *(const u32x4*)(vs + (long)c * 16) : (u32x4){0u, 0u, 0u, 0u}; }
#pragma unroll
                for (int i = 0; i < 8; ++i) { *(LAS u32x4*)(lds + (tid + 512 * i) * 16) = tmp[i]; *(LAS u32x4*)(lds + 65536 + (tid + 512 * i) * 16) = tmp[8 + i]; }
            }
            __syncthreads();
            attn_wave_win_lds(t, lds, kt0, lane);
            __syncthreads();
        } else {
            const int tc = task - NT_B - NT_A, bl = (tc & 63) >> 2, hc = tc & 3, sp = tc >> 6, bg = chunk * CB + bl;
            AttnTask t;
            const size_t rowb = (size_t)bl * SEQ;
            t.q = proj + rowb * INW + 3072 + hc * 128; t.qstride = INW;
            t.kb = memk + (size_t)(bg * 4 + hc) * 128 * NMEM; t.vb = memvt + (size_t)(bg * 4 + hc) * 128 * NMEM;
            t.o = oc + rowb * 512 + hc * 128; t.ostride = 512; t.lse = nullptr; t.lsestride = 0;
            t.m0 = sp * 256 + 32 * wave; t.L = NMEM; t.W = 0; t.m_init = -1e30f; t.l_init = 0.f; t.scale2 = 0.08838834764831845f * LOG2E;
            {
                const u32x4* ks = (const u32x4*)t.kb; const u32x4* vs = (const u32x4*)t.vb;
                u32x4 tmp[16];
#pragma unroll
                for (int i = 0; i < 8; ++i) { tmp[i] = ks[tid + 512 * i]; tmp[8 + i] = vs[tid + 512 * i]; }
#pragma unroll
                for (int i = 0; i < 8; ++i) { *(LAS u32x4*)(lds + (tid + 512 * i) * 16) = tmp[i]; *(LAS u32x4*)(lds + 65536 + (tid + 512 * i) * 16) = tmp[8 + i]; }
            }
            __syncthreads();
            attn_wave_mem_lds(t, lds, lane);
            __syncthreads();
        }
    }
}

#define XB_TMO      128
#define XB_XCNT(j)  (256  + 64 * (j))
#define XB_XSUB(j)  (1280 + 64 * (j))
#define XB_XGEN(j)  (2304 + 64 * (j))
#define XB_TOP      3328
#define XB_TOPGEN   3392
#define XCD_BAR_WORDS 3456
#define XB_SPIN_CAP (1u << 18)

__device__ __forceinline__ unsigned xb_ld(unsigned* p)              { return __hip_atomic_load(p, __ATOMIC_RELAXED, __HIP_MEMORY_SCOPE_AGENT); }
__device__ __forceinline__ unsigned xb_add(unsigned* p, unsigned v) { return __hip_atomic_fetch_add(p, v, __ATOMIC_RELAXED, __HIP_MEMORY_SCOPE_AGENT); }
__device__ __forceinline__ unsigned xb_xcc_id() { return (unsigned)__builtin_amdgcn_s_getreg((3 << 11) | 20) & 0xFu; }
#define XB_SPIN(cond, bar) do { unsigned _sp = 0; while (cond) { __builtin_amdgcn_s_sleep(1); \
    if ((++_sp & 255u) == 0u) { if (xb_ld(&(bar)[XB_TMO])) break; if (_sp > XB_SPIN_CAP) { atomicAdd(&(bar)[XB_TMO], 1u); break; } } } } while (0)
struct XcdBarrier {
    unsigned* bar; unsigned x;
    volatile LAS unsigned* st;
};

__device__ __forceinline__ XcdBarrier xcd_barrier_post(unsigned* bar, volatile LAS unsigned* st) {
    XcdBarrier b; b.bar = bar; b.x = xb_xcc_id(); b.st = st;
    if (threadIdx.x == 0) (void)xb_add(&bar[XB_XCNT(b.x)], 1u);
    return b;
}
__device__ __forceinline__ void xcd_barrier_complete(unsigned* bar, unsigned x, unsigned& nloc, unsigned& nx) {
    const unsigned G = gridDim.x * gridDim.y * gridDim.z;
    unsigned sum, cnt, mine, sp = 0u;
    for (;;) {
        sum = 0u; cnt = 0u; mine = 0u;
#pragma unroll
        for (unsigned j = 0; j < 16; ++j) { const unsigned c = xb_ld(&bar[XB_XCNT(j)]); sum += c; cnt += (c > 0u) ? 1u : 0u; mine = (j == x) ? c : mine; }
        if (sum == G) break;
        __builtin_amdgcn_s_sleep(1);
        if ((++sp & 255u) == 0u) { if (xb_ld(&bar[XB_TMO])) break; if (sp > XB_SPIN_CAP) { atomicAdd(&bar[XB_TMO], 1u); break; } }
    }
    nloc = mine > 0u ? mine : 1u; nx = cnt > 0u ? cnt : 1u;
}

__device__ __forceinline__ void xcd_barrier(const XcdBarrier& b) {
    asm volatile("s_waitcnt vmcnt(0)" ::: "memory");
    __syncthreads();
    if (threadIdx.x == 0) {
        unsigned* bar = b.bar;
        __builtin_amdgcn_s_waitcnt(0);
        unsigned nloc = b.st[0], nx = b.st[1];
        if (nloc == 0u) { xcd_barrier_complete(bar, b.x, nloc, nx); b.st[0] = nloc; b.st[1] = nx; }
        const unsigned old = xb_add(&bar[XB_XSUB(b.x)], 1u);
        const unsigned gen = old / nloc;
        if (old + 1u == (gen + 1u) * nloc) {
            __builtin_amdgcn_fence(__ATOMIC_RELEASE, "agent");
            asm volatile("s_waitcnt vmcnt(0)" ::: "memory");
            const unsigned og = xb_add(&bar[XB_TOP], 1u);
            const unsigned tg = og / nx;
            if (og + 1u == (tg + 1u) * nx) xb_add(&bar[XB_TOPGEN], 1u);
            else XB_SPIN(xb_ld(&bar[XB_TOPGEN]) == tg, bar);
            __builtin_amdgcn_fence(__ATOMIC_ACQUIRE, "agent");
            xb_add(&bar[XB_XGEN(b.x)], 1u);
            asm volatile("s_waitcnt vmcnt(0)" ::: "memory");
        } else {
            XB_SPIN(xb_ld(&bar[XB_XGEN(b.x)]) == gen, bar);
            __builtin_amdgcn_fence(__ATOMIC_ACQUIRE, "agent");
            asm volatile("s_waitcnt vmcnt(0)" ::: "memory");
        }
    }
    __syncthreads();
}


constexpr int STEPS_PER_CHUNK = 1 + DEPTH * 8, N_STEPS = 2 + NCHUNK * STEPS_PER_CHUNK;
__device__ __forceinline__ void run_step(PP p, LAS unsigned char* lds, int s) {
    bf16_t* WT = (bf16_t*)(p->ws + WS_WT);
    if (s == 0) { phase_prologue_a(p, lds); return; }
    if (s == 1) {
        for (int l = 0; l < DEPTH; ++l) { EpiMemKV E; E.mk = (bf16_t*)(p->ws + WS_MEMK) + (size_t)l * NBATCH * NMEM * 512; E.mvt = (bf16_t*)(p->ws + WS_MEMVT) + (size_t)l * NBATCH * NMEM * 512;
            run_gemm(lds, (const bf16_t*)(p->ws + WS_MEMN) + (size_t)l * NBATCH * NMEM * DM, WT + (size_t)l * WL + WO_MKV, NBATCH * NMEM, 1024, DM, E, 64 * l); }
        return;
    }
    const int s2 = s - 2, chunk = s2 / STEPS_PER_CHUNK, r = s2 % STEPS_PER_CHUNK;
    if (r == 0) { phase_rows_first(p, chunk); return; }
    const int l = (r - 1) >> 3, ph = (r - 1) & 7;
    const bf16_t* wl = WT + (size_t)l * WL;
    bf16_t* H = (bf16_t*)(p->ws + WS_H); bf16_t* proj = (bf16_t*)(p->ws + WS_PROJ); bf16_t* mrg = (bf16_t*)(p->ws + WS_MRG);
    switch (ph) {
    case 0: { EpiIn E; E.proj = proj; E.vta = (bf16_t*)(p->ws + WS_VTA); E.vtb = (bf16_t*)(p->ws + WS_VTB); E.kba = (bf16_t*)(p->ws + WS_KBA); E.kbb = (bf16_t*)(p->ws + WS_KBB); E.rope = (const float*)(p->ws + WS_ROPE);
        run_gemm(lds, H, wl + WO_IN, MC, INW, DM, E, 0); } break;
    case 1: phase_attention(p, lds, chunk, l); break;
    case 2: {
        EpiGate E; E.mrg = mrg;
        E.gate = proj + 3584; E.accum = 0; run_gemm<EpiGate, GATE_FAST>(lds, (const bf16_t*)(p->ws + WS_OA), wl + WO_OA, MC, DM, 512, E, 0);
        E.gate = proj + 3584 + 1024; E.accum = 1; run_gemm<EpiGate, GATE_FAST>(lds, (const bf16_t*)(p->ws + WS_OB), wl + WO_OB, MC, DM, 256, E, 0);
        E.gate = proj + 3584 + 2048; E.accum = 1; run_gemm<EpiGate, GATE_FAST>(lds, (const bf16_t*)(p->ws + WS_OC), wl + WO_OC, MC, DM, 512, E, 0);
        } break;
    case 3: { EpiY E; E.Y = (bf16_t*)(p->ws + WS_Y); run_gemm(lds, mrg, wl + WO_OUT, MC, DM, DM, E, 0); } break;
    case 4: phase_rows_resid<0>(p, chunk, l == 0, p->g_mix_post + l * DM, nullptr, p->g_ffn_pre + l * DM, true); break;
    case 5: { EpiSwiGLU E; E.act = (bf16_t*)(p->ws + WS_ACT); run_gemm(lds, H, wl + WO_FIN, MC, 2 * FFH, DM, E, 0); } break;
    case 6: { EpiY E; E.Y = (bf16_t*)(p->ws + WS_Y2); run_gemm(lds, (const bf16_t*)(p->ws + WS_ACT), wl + WO_FOUT, MC, DM, FFH, E, 0); } break;
    default: phase_rows_resid<1>(p, chunk, l == 0, p->g_mix_post + l * DM, p->g_ffn_post + l * DM, p->g_mix_pre + (l < DEPTH - 1 ? l + 1 : l) * DM, l < DEPTH - 1); break;
    }
}

__global__ void __launch_bounds__(NTHREADS, 2) fwd_megakernel(Params p) {
    extern __shared__ __attribute__((aligned(16))) unsigned char lds_raw[];
    LAS unsigned char* lds = (LAS unsigned char*)lds_raw;
    cg::grid_group grid = cg::this_grid();
    PP pp = (PP)__builtin_amdgcn_kernarg_segment_ptr();
    const int s_hi = pp->s_hi;
    __shared__ uint4 xb_words;
    if (threadIdx.x == 0) xb_words = make_uint4(0u, 0u, 0u, 0u);
    __syncthreads();
    const XcdBarrier xbar = xcd_barrier_post((unsigned*)(pp->ws + WS_BAR), (volatile LAS unsigned*)&xb_words);
    const int s_lo = pp->s_lo;
    for (int s = s_lo; s < s_hi; ++s) {
        PP q = pp; OPAQUE_S(q);
        run_step(q, lds, s);
        if (s + 1 < s_hi) { if (s == s_lo) grid.sync(); else xcd_barrier(xbar); }
    }
}

extern "C" void kernel_launch(void* const* d_in, const int* in_sizes, int n_in, void* d_out, int out_size, void* d_ws, size_t ws_size, hipStream_t stream) {
    static int grid_blocks = 0;
    if (grid_blocks == 0) {
        if (n_in != 18 || out_size != NBATCH * SEQ * DM || ws_size < WS_END) { fprintf(stderr, "kernel_launch: unexpected shapes / workspace (n_in %d out %d ws %zu need %zu)\n", n_in, out_size, ws_size, (size_t)WS_END); grid_blocks = -1; return; }
        int dev = 0, cus = 0, per_cu = 0;
        hipGetDevice(&dev);
        hipDeviceGetAttribute(&cus, hipDeviceAttributeMultiprocessorCount, dev);
        if (hipFuncSetAttribute((const void*)fwd_megakernel, hipFuncAttributeMaxDynamicSharedMemorySize, LDS_BYTES) != hipSuccess) { fprintf(stderr, "kernel_launch: hipFuncSetAttribute failed\n"); grid_blocks = -1; return; }
        hipOccupancyMaxActiveBlocksPerMultiprocessor(&per_cu, (const void*)fwd_megakernel, NTHREADS, LDS_BYTES);
        if (per_cu < 1) { fprintf(stderr, "kernel_launch: occupancy query says %d blocks per CU\n", per_cu); per_cu = 1; }
        (void)hipGetLastError();
        grid_blocks = cus * 1;
    }
    if (grid_blocks < 0) return;
    if (hipMemsetAsync((char*)d_ws + WS_BAR, 0, 16384, stream) != hipSuccess) { fprintf(stderr, "kernel_launch: hipMemsetAsync failed\n"); return; }
    Params p{};
    p.x_prompt = (const float*)d_in[0]; p.x_sample = (const float*)d_in[1]; p.mem_prompt = (const float*)d_in[2]; p.mem_sample = (const float*)d_in[3];
    p.g_mix_pre = (const float*)d_in[4]; p.g_mix_post = (const float*)d_in[5]; p.g_mem = (const float*)d_in[6]; p.w_in = (const float*)d_in[7];
    p.sink_a = (const float*)d_in[8]; p.w_mem_kv = (const float*)d_in[9]; p.w_o_a = (const float*)d_in[10]; p.w_o_b = (const float*)d_in[11];
    p.w_o_c = (const float*)d_in[12]; p.w_out = (const float*)d_in[13]; p.g_ffn_pre = (const float*)d_in[14]; p.g_ffn_post = (const float*)d_in[15];
    p.w_ffn_in = (const float*)d_in[16]; p.w_ffn_out = (const float*)d_in[17];
    p.out = (float*)d_out; p.ws = (unsigned char*)d_ws;
    for (int j = 0; j < 8; ++j) p.inv_freq[j] = powf(500000.0f, -(float)(2 * j) / 16.0f);
#if MK_MULTI_LAUNCH
    for (int s = 0; s < N_STEPS; ++s) {
        p.s_lo = s; p.s_hi = s + 1;
        hipLaunchKernelGGL(fwd_megakernel, dim3(grid_blocks), dim3(NTHREADS), LDS_BYTES, stream, p);
    }
#else
    p.s_lo = 0; p.s_hi = N_STEPS;
    void* args[] = {&p};
    hipError_t e = hipLaunchCooperativeKernel((const void*)fwd_megakernel, dim3(grid_blocks), dim3(NTHREADS), args, LDS_BYTES, stream);
    if (e != hipSuccess) fprintf(stderr, "kernel_launch: cooperative launch failed: %s (grid %d)\n", hipGetErrorString(e), grid_blocks);
#endif
}
```

```cpp
#include <hip/hip_runtime.h>
#include <hip/hip_cooperative_groups.h>
#include <cstdio>
#include <cstdint>
#include <cmath>
namespace cg = cooperative_groups;
#ifndef MK_MULTI_LAUNCH
#define MK_MULTI_LAUNCH 0
#endif
namespace pg8 {
#define PG8_LAS __attribute__((address_space(3)))
typedef unsigned short bf16_t;
typedef short bf16x8 __attribute__((ext_vector_type(8)));
typedef float f32x4 __attribute__((ext_vector_type(4)));
typedef unsigned u32x4 __attribute__((ext_vector_type(4)));
constexpr int BM = 256, BK = 64, HALF = 128, HTB = HALF * BK * 2  , STAGE_BYTES = 8 * HTB, NXCD = 8, WGM = 8;

__host__ __device__ __forceinline__ int lds_byte(int r, int c) { const int st = (r >> 4) * 2 + (c >> 5), rr = r & 15, cc = c & 31, ob = rr * 64 + cc * 2; return st * 1024 + (ob ^ (((ob >> 9) & 1) << 5)); }
__host__ __device__ __forceinline__ void stage_rc(int b, int& R, int& C) { const int st = b / 1024, sb = b % 1024, swz = sb ^ (((sb >> 9) & 1) << 5); R = (st >> 1) * 16 + swz / 64; C = (st & 1) * 32 + (swz % 64) / 2; }
__host__ __device__ __forceinline__ int perm32(int rho) { const int n = rho >> 4, i = rho & 15; return 8 * (i >> 2) + 4 * n + (i & 3); }

struct Unit { int pm, pn; };
struct Gemm { const bf16_t* A; const bf16_t* Bt; int M, N, K; };

struct StaticOrder {
    int nM, nN, nwg, G, c, wgm;
    __host__ __device__ void init(int M, int N, int G_, int c_, int wgm_ = WGM) { nM = M / BM; nN = N / BM; nwg = nM * nN; G = G_; c = c_; wgm = wgm_; }
    __host__ __device__ bool next(int i, Unit& u) const {
        const long L = (long)i * G + c; if (L >= nwg) return false;
        int wgid = (int)L; { const int q = nwg / NXCD, r = nwg % NXCD, xcd = wgid % NXCD, off = wgid / NXCD; wgid = (xcd < r ? xcd * (q + 1) : r * (q + 1) + (xcd - r) * q) + off; }
        const int nig = wgm * nN, gid = wgid / nig, fm = gid * wgm, gsz = (nM - fm) < wgm ? (nM - fm) : wgm;
        u.pm = fm + ((wgid % nig) % gsz); u.pn = (wgid % nig) / gsz; return true;
    }
    __device__ __forceinline__ void a_ready(const Unit&) const {}
    __device__ __forceinline__ void done(const Unit&) const {}
};
__device__ __forceinline__ unsigned cvt_pk_bf16(float lo, float hi) { unsigned r; asm volatile("v_cvt_pk_bf16_f32 %0, %1, %2" : "=v"(r) : "v"(lo), "v"(hi)); return r; }
typedef float f32x2 __attribute__((ext_vector_type(2)));
template <class Epi, class Sched, bool ALIGN_EPI = false, bool SP2 = false>
__device__ __forceinline__ void gemm_phase(PG8_LAS unsigned char* lds, const Gemm g, const Sched& S, const Epi& E) {
    int tid_ = threadIdx.x; asm volatile("" : "+v"(tid_)); const int tid = tid_, wid = __builtin_amdgcn_readfirstlane(tid >> 6), lane = tid & 63, wr = wid >> 2, wc = wid & 3, fr = lane & 15, fq = lane >> 4;
    const int K = g.K, nt = K / BK;
    unsigned voffA[2], voffB[2];
#pragma unroll
    for (int i = 0; i < 2; ++i) { int R, C; stage_rc(tid * 16 + i * 8192, R, C); const int Rb = Epi::PERM ? ((R & ~31) + perm32(R & 31)) : R;
        voffA[i] = (unsigned)(R * K + C) * 2u; voffB[i] = (unsigned)(Rb * K + C) * 2u; }
    const size_t kstep = (size_t)(BK * 2);
    const size_t hstep = (size_t)HALF * K * 2;
    const size_t tstep = 2 * hstep;
    const unsigned ldsw = (unsigned)wid * 1024u;
    const int aoff = lds_byte(wr * 64 + fr, fq * 8), boff = lds_byte(wc * 32 + fr, fq * 8);
#define PG8_SA(b, h) (((b) * 2 + (h)) * HTB)
#define PG8_SB(b, h) ((4 + (b) * 2 + (h)) * HTB)
#define PG8_STAGE(bufoff, gbase, voff) do { _Pragma("unroll") for (int _i = 0; _i < 2; ++_i) \
        __builtin_amdgcn_global_load_lds((const unsigned*)((const char*)(gbase) + (voff)[_i]), (PG8_LAS unsigned*)(lds + (bufoff) + ldsw + _i * 8192), 16, 0, 0); } while (0)
#define PG8_LDA(dst, b, h) do { _Pragma("unroll") for (int m = 0; m < 4; ++m) _Pragma("unroll") for (int k = 0; k < 2; ++k) dst[m][k] = *(const PG8_LAS bf16x8*)(lds + PG8_SA(b, h) + aoff + m * 2048 + k * 1024); } while (0)
#define PG8_LDB(dst, b, h) do { _Pragma("unroll") for (int n = 0; n < 2; ++n) _Pragma("unroll") for (int k = 0; k < 2; ++k) dst[n][k] = *(const PG8_LAS bf16x8*)(lds + PG8_SB(b, h) + boff + n * 2048 + k * 1024); } while (0)
#define PG8_MMA(ai, bj, At, Bt) do { __builtin_amdgcn_s_setprio(1); _Pragma("unroll") for (int m = 0; m < 4; ++m) _Pragma("unroll") for (int n = 0; n < 2; ++n) _Pragma("unroll") for (int k = 0; k < 2; ++k) \
        acc[ai][bj][m][n] = __builtin_amdgcn_mfma_f32_16x16x32_bf16(Bt[n][k], At[m][k], acc[ai][bj][m][n], 0, 0, 0); __builtin_amdgcn_s_setprio(0); } while (0)
#define PG8_WAIT_V(n) asm volatile("s_waitcnt vmcnt(" #n ")" ::: "memory")
#define PG8_WAIT_L(n) asm volatile("s_waitcnt lgkmcnt(" #n ")" ::: "memory")
#define PG8_BAR __builtin_amdgcn_s_barrier()
#define PG8_SCHED __builtin_amdgcn_sched_barrier(0)
    Unit cur, nxt; int ui = 0;
    if (!S.next(0, cur)) return;
    f32x4 acc[2][2][4][2];
#pragma unroll
    for (int a = 0; a < 2; ++a)
#pragma unroll
        for (int b = 0; b < 2; ++b)
#pragma unroll
            for (int m = 0; m < 4; ++m)
#pragma unroll
                for (int n = 0; n < 2; ++n) acc[a][b][m][n] = (f32x4){0.f, 0.f, 0.f, 0.f};
    bf16x8 At[4][2], B0[2][2], B1[2][2];
    const char* cA = (const char*)g.A + (size_t)cur.pm * tstep; const char* cB = (const char*)g.Bt + (size_t)cur.pn * tstep;
    S.a_ready(cur);
    if constexpr (SP2) {
        PG8_STAGE(PG8_SB(0, 0), cB, voffB); PG8_STAGE(PG8_SB(0, 1), cB + hstep, voffB); PG8_STAGE(PG8_SA(0, 0), cA, voffA); PG8_STAGE(PG8_SA(0, 1), cA + hstep, voffA);
        if (wr == 1) PG8_BAR;
        PG8_WAIT_V(2); PG8_BAR;
        PG8_STAGE(PG8_SB(1, 0), cB + kstep, voffB); PG8_STAGE(PG8_SA(1, 0), cA + kstep, voffA); PG8_STAGE(PG8_SB(1, 1), cB + hstep + kstep, voffB);
        PG8_WAIT_V(6); PG8_BAR;
    } else {
        PG8_STAGE(PG8_SB(0, 0), cB, voffB); PG8_STAGE(PG8_SA(0, 0), cA, voffA); PG8_STAGE(PG8_SB(0, 1), cB + hstep, voffB); PG8_STAGE(PG8_SA(0, 1), cA + hstep, voffA);
        if (wr == 1) PG8_BAR;
        PG8_WAIT_V(4); PG8_BAR;
        PG8_STAGE(PG8_SB(1, 0), cB + kstep, voffB); PG8_STAGE(PG8_SA(1, 0), cA + kstep, voffA); PG8_STAGE(PG8_SB(1, 1), cB + hstep + kstep, voffB);
        PG8_WAIT_V(6); PG8_BAR;
    }
    for (;;) {
        const bool has_next = S.next(ui + 1, nxt);
        const char* nA = has_next ? (const char*)g.A + (size_t)nxt.pm * tstep : cA; const char* nB = has_next ? (const char*)g.Bt + (size_t)nxt.pn * tstep : cB;
        for (int t = 0; t < nt; t += 2) {
            const bool last = (t == nt - 2);
            const char* a1 = cA + (size_t)(t + 1) * kstep;
            const char* a2 = last ? nA : cA + (size_t)(t + 2) * kstep; const char* b2 = last ? nB : cB + (size_t)(t + 2) * kstep;
            const char* a3 = a2 + kstep; const char* b3 = b2 + kstep;
            if (last && has_next) S.a_ready(nxt);
            if constexpr (SP2) {
            PG8_LDB(B0, 0, 0); PG8_LDB(B1, 0, 1); PG8_SCHED; PG8_LDA(At, 0, 0); PG8_STAGE(PG8_SA(1, 1), a1 + hstep, voffA);
            PG8_WAIT_V(8); PG8_WAIT_L(0); PG8_BAR; PG8_MMA(0, 0, At, B0); PG8_MMA(0, 1, At, B1); PG8_BAR; PG8_SCHED;
            PG8_LDA(At, 0, 1); PG8_STAGE(PG8_SB(0, 0), b2, voffB); PG8_STAGE(PG8_SB(0, 1), b2 + hstep, voffB); PG8_STAGE(PG8_SA(0, 0), a2, voffA);
            PG8_WAIT_V(8); PG8_WAIT_L(0); PG8_BAR; PG8_MMA(1, 0, At, B0); PG8_MMA(1, 1, At, B1); PG8_BAR; PG8_SCHED;
            PG8_LDB(B0, 1, 0); PG8_LDB(B1, 1, 1); PG8_SCHED; PG8_LDA(At, 1, 0); PG8_STAGE(PG8_SA(0, 1), a2 + hstep, voffA);
            PG8_WAIT_V(8); PG8_WAIT_L(0); PG8_BAR; PG8_MMA(0, 0, At, B0); PG8_MMA(0, 1, At, B1); PG8_BAR; PG8_SCHED;
            PG8_LDA(At, 1, 1); PG8_STAGE(PG8_SB(1, 0), b3, voffB); PG8_STAGE(PG8_SB(1, 1), b3 + hstep, voffB); PG8_STAGE(PG8_SA(1, 0), a3, voffA);
            PG8_WAIT_V(8); PG8_WAIT_L(0); PG8_BAR; PG8_MMA(1, 0, At, B0); PG8_MMA(1, 1, At, B1); PG8_BAR; PG8_SCHED;
            } else {
            PG8_LDB(B0, 0, 0); PG8_SCHED; PG8_LDA(At, 0, 0); PG8_STAGE(PG8_SA(1, 1), a1 + hstep, voffA);
            PG8_WAIT_L(8); PG8_BAR; PG8_WAIT_L(0); PG8_MMA(0, 0, At, B0); PG8_BAR; PG8_SCHED;
            PG8_LDB(B1, 0, 1); PG8_STAGE(PG8_SB(0, 0), b2, voffB);
            PG8_BAR; PG8_WAIT_L(0); PG8_MMA(0, 1, At, B1); PG8_BAR;
            PG8_LDA(At, 0, 1); PG8_STAGE(PG8_SA(0, 0), a2, voffA);
            PG8_BAR; PG8_WAIT_L(0); PG8_MMA(1, 0, At, B0); PG8_BAR; PG8_SCHED;
            PG8_STAGE(PG8_SB(0, 1), b2 + hstep, voffB);
            PG8_WAIT_V(6); PG8_BAR; PG8_MMA(1, 1, At, B1); PG8_BAR;
            PG8_LDB(B0, 1, 0); PG8_SCHED; PG8_LDA(At, 1, 0); PG8_STAGE(PG8_SA(0, 1), a2 + hstep, voffA);
            PG8_WAIT_L(8); PG8_BAR; PG8_WAIT_L(0); PG8_MMA(0, 0, At, B0); PG8_BAR; PG8_SCHED;
            PG8_LDB(B1, 1, 1); PG8_STAGE(PG8_SB(1, 0), b3, voffB);
            PG8_BAR; PG8_WAIT_L(0); PG8_MMA(0, 1, At, B1); PG8_BAR;
            PG8_LDA(At, 1, 1); PG8_STAGE(PG8_SA(1, 0), a3, voffA);
            PG8_BAR; PG8_WAIT_L(0); PG8_MMA(1, 0, At, B0); PG8_BAR; PG8_SCHED;
            PG8_STAGE(PG8_SB(1, 1), b3 + hstep, voffB);
            PG8_WAIT_V(6); PG8_BAR; PG8_MMA(1, 1, At, B1); PG8_BAR;
            }
        }
        if constexpr (ALIGN_EPI) { if (wr == 0) PG8_BAR; }
        if constexpr (!Epi::AFTER_DRAIN) { E(acc, cur, wr, wc, fr, fq); S.done(cur); }
        if (!has_next) break;
#pragma unroll
        for (int a = 0; a < 2; ++a)
#pragma unroll
            for (int b = 0; b < 2; ++b)
#pragma unroll
                for (int m = 0; m < 4; ++m)
#pragma unroll
                    for (int n = 0; n < 2; ++n) acc[a][b][m][n] = (f32x4){0.f, 0.f, 0.f, 0.f};
        cur = nxt; cA = nA; cB = nB; ++ui;
        if constexpr (ALIGN_EPI) { if (wr == 1) PG8_BAR; }
    }
    PG8_WAIT_V(0);
    if constexpr (!ALIGN_EPI) { if (wr == 0) PG8_BAR; }
    PG8_BAR;
    if constexpr (Epi::AFTER_DRAIN) { E.fused(acc, cur, wr, wc, fr, fq, lds, wid, lane); S.done(cur); }
#undef PG8_SA
#undef PG8_SB
#undef PG8_STAGE
#undef PG8_LDA
#undef PG8_LDB
#undef PG8_MMA
#undef PG8_WAIT_V
#undef PG8_WAIT_L
#undef PG8_BAR
#undef PG8_SCHED
}
}

using pg8::bf16_t; using pg8::bf16x8; using pg8::f32x4; using pg8::u32x4;
typedef float f32x16 __attribute__((ext_vector_type(16)));
typedef unsigned u32x2 __attribute__((ext_vector_type(2)));
#define LAS __attribute__((address_space(3)))
constexpr int NTHREADS = 512, NWAVES = 8, LDS_BYTES = pg8::STAGE_BYTES;
constexpr int DM = 1024, SEQ = 2048, NBATCH = 48, DEPTH = 4, NMEM = 256, INW = 6656, FFH = 2816;
constexpr int CB = 16, MC = CB * SEQ, NCHUNK = NBATCH / CB;
constexpr float EPS = 1e-6f, LOG2E = 1.4426950408889634f, LN2 = 0.6931471805599453f;
constexpr size_t WO_IN = 0, WO_MKV = WO_IN + (size_t)INW * DM, WO_OA = WO_MKV + (size_t)1024 * DM, WO_OB = WO_OA + (size_t)1024 * 512, WO_OC = WO_OB + (size_t)1024 * 256,
                 WO_OUT = WO_OC + (size_t)1024 * 512, WO_FIN = WO_OUT + (size_t)1024 * 1024, WO_FOUT = WO_FIN + (size_t)2 * FFH * DM, WL = WO_FOUT + (size_t)DM * FFH;
constexpr size_t al256(size_t x) { return (x + 255) & ~(size_t)255; }
constexpr size_t WS_WT = 0;
constexpr size_t WS_ROPE = al256(WS_WT + WL * DEPTH * 2);
constexpr size_t WS_MEMK = al256(WS_ROPE + (size_t)SEQ * 8 * 8);
constexpr size_t WS_MEMVT = al256(WS_MEMK + (size_t)DEPTH * NBATCH * NMEM * 512 * 2);
constexpr size_t WS_H = al256(WS_MEMVT + (size_t)DEPTH * NBATCH * NMEM * 512 * 2);
constexpr size_t WS_PROJ = al256(WS_H + (size_t)MC * DM * 2);
constexpr size_t WS_VTA = al256(WS_PROJ + (size_t)MC * INW * 2);
constexpr size_t WS_VTB = al256(WS_VTA + (size_t)CB * 2 * 64 * SEQ * 2);
constexpr size_t WS_OA = al256(WS_VTB + (size_t)CB * 12 * 64 * SEQ * 2);
constexpr size_t WS_OB = al256(WS_OA + (size_t)MC * 512 * 2);
constexpr size_t WS_OC = al256(WS_OB + (size_t)MC * 256 * 2);
constexpr size_t WS_MRG = al256(WS_OC + (size_t)MC * 512 * 2);
constexpr size_t WS_KBA = al256(WS_MRG + (size_t)MC * DM * 2);
constexpr size_t WS_KBB = al256(WS_KBA + (size_t)CB * 2 * 64 * SEQ * 2);
constexpr size_t WS_BAR = al256(WS_KBB + (size_t)CB * 12 * 64 * SEQ * 2);
constexpr size_t WS_END = al256(WS_BAR + 16384);
constexpr size_t WS_MEMN = WS_PROJ;
constexpr size_t WS_Y = WS_PROJ;
constexpr size_t WS_Y2 = WS_PROJ + (size_t)MC * DM * 2;
constexpr size_t WS_ACT = WS_PROJ + (size_t)MC * DM * 4;
constexpr size_t WS_OG = WS_MRG;
constexpr size_t WS_LSE = WS_MRG + (size_t)3 * MC * 256 * 2;
static_assert((size_t)DEPTH * NBATCH * NMEM * DM * 2 <= (size_t)MC * INW * 2, "memn overlay");
static_assert((size_t)MC * DM * 4 + (size_t)MC * FFH * 2 <= (size_t)MC * INW * 2, "y/act overlay");
static_assert((size_t)3 * MC * 256 * 2 + (size_t)3 * MC * 4 * 4 <= (size_t)MC * DM * 2, "og overlay");

struct Params {
    const float *x_prompt, *x_sample, *mem_prompt, *mem_sample, *g_mix_pre, *g_mix_post, *g_mem, *w_in, *sink_a, *w_mem_kv, *w_o_a, *w_o_b, *w_o_c, *w_out,
                *g_ffn_pre, *g_ffn_post, *w_ffn_in, *w_ffn_out;
    float* out; unsigned char* ws;
    float inv_freq[8];
    int s_lo, s_hi;
};

typedef const __attribute__((address_space(4))) Params* PP;
#define OPAQUE_V(x) asm volatile("" : "+v"(x))
#define OPAQUE_S(x) asm volatile("" : "+s"(x))
__device__ __forceinline__ float bf2f(unsigned b) { return __uint_as_float(b << 16); }
typedef __bf16 bf16x2v __attribute__((ext_vector_type(2)));
typedef float f32x2v __attribute__((ext_vector_type(2)));
__device__ __forceinline__ unsigned pk2(float lo, float hi) { const f32x2v v = {lo, hi}; return __builtin_bit_cast(unsigned, __builtin_convertvector(v, bf16x2v)); }
__device__ __forceinline__ float wave_sum(float v) {
#pragma unroll
    for (int o = 32; o > 0; o >>= 1) v += __shfl_xor(v, o);
    return v;
}
__device__ __forceinline__ float fexp2(float x) { return __builtin_amdgcn_exp2f(x); }
__device__ __forceinline__ float frcp(float x) { return __builtin_amdgcn_rcpf(x); }
__device__ __forceinline__ float sigmoidf_(float x) { return frcp(1.f + fexp2(-x * LOG2E)); }
#define LDS_WAIT() asm volatile("s_waitcnt lgkmcnt(0)" ::: "memory")

__device__ __forceinline__ int src_col_in(int n) {
    const bool qk = (n < 640) || (n >= 768 && n < 2304);
    const int p = n & 63;
    return (qk && p < 16) ? (n - p) + (p >> 1) + 8 * (p & 1) : n;
}
__device__ __forceinline__ int src_col_ffin(int n) { const int q = n >> 3, e = n & 7; return e < 4 ? 4 * q + e : FFH + 4 * q + (e - 4); }

template <int PERMT>
__device__ __forceinline__ void transpose_item(const float* W, int K, int N, bf16_t* WT, LAS float* scr, int item, int lane) {
    const int nblk = N / 32, kb = item / nblk, nb = item % nblk, k0 = 64 * kb, n0 = 32 * nb;
    const int nd = n0 + (lane & 31);
    const int ns = PERMT == 1 ? src_col_in(nd) : (PERMT == 2 ? src_col_ffin(nd) : nd);
#pragma unroll 8
    for (int i = 0; i < 32; ++i) { const int kk = 2 * i + (lane >> 5); scr[kk * 33 + (lane & 31)] = __builtin_nontemporal_load(W + (size_t)(k0 + kk) * N + ns); }
    LDS_WAIT();
    const int c = lane & 7;
#pragma unroll
    for (int j = 0; j < 4; ++j) { const int n = (lane >> 3) + 8 * j; const LAS float* s = scr + (8 * c) * 33 + n;
        u32x4 o; o.x = pk2(s[0 * 33], s[1 * 33]); o.y = pk2(s[2 * 33], s[3 * 33]); o.z = pk2(s[4 * 33], s[5 * 33]); o.w = pk2(s[6 * 33], s[7 * 33]);
        *(u32x4*)(WT + (size_t)(n0 + n) * K + k0 + 8 * c) = o; }
    LDS_WAIT();
}

__device__ __forceinline__ void phase_prologue_a(PP p, LAS unsigned char* lds) {
    int tid_ = threadIdx.x; OPAQUE_V(tid_); const int tid = tid_, lane = tid & 63, wave = __builtin_amdgcn_readfirstlane(tid >> 6);
    const int gw = blockIdx.x * NWAVES + wave, NGW = gridDim.x * NWAVES;
    LAS float* scr = (LAS float*)(lds + wave * 16384);
    bf16_t* WT = (bf16_t*)(p->ws + WS_WT);
    constexpr int I_IN = 16 * (INW / 32), I_MKV = 16 * 32, I_OA = 8 * 32, I_OB = 4 * 32, I_OC = 8 * 32, I_OUT = 16 * 32, I_FIN = 16 * (2 * FFH / 32), I_FOUT = (FFH / 64) * 32;
    constexpr int I_L = I_IN + I_MKV + I_OA + I_OB + I_OC + I_OUT + I_FIN + I_FOUT;
    for (int it = gw; it < I_L * DEPTH; it += NGW) {
        const int l = it / I_L; int r = it % I_L;
        bf16_t* wl = WT + (size_t)l * WL;
        if (r < I_IN) { transpose_item<1>(p->w_in + (size_t)l * DM * INW, DM, INW, wl + WO_IN, scr, r, lane); continue; } r -= I_IN;
        if (r < I_MKV) { transpose_item<0>(p->w_mem_kv + (size_t)l * DM * 1024, DM, 1024, wl + WO_MKV, scr, r, lane); continue; } r -= I_MKV;
        if (r < I_OA) { transpose_item<0>(p->w_o_a + (size_t)l * 512 * DM, 512, DM, wl + WO_OA, scr, r, lane); continue; } r -= I_OA;
        if (r < I_OB) { transpose_item<0>(p->w_o_b + (size_t)l * 256 * DM, 256, DM, wl + WO_OB, scr, r, lane); continue; } r -= I_OB;
        if (r < I_OC) { transpose_item<0>(p->w_o_c + (size_t)l * 512 * DM, 512, DM, wl + WO_OC, scr, r, lane); continue; } r -= I_OC;
        if (r < I_OUT) { transpose_item<0>(p->w_out + (size_t)l * DM * DM, DM, DM, wl + WO_OUT, scr, r, lane); continue; } r -= I_OUT;
        if (r < I_FIN) { transpose_item<2>(p->w_ffn_in + (size_t)l * DM * 2 * FFH, DM, 2 * FFH, wl + WO_FIN, scr, r, lane); continue; } r -= I_FIN;
        transpose_item<0>(p->w_ffn_out + (size_t)l * FFH * DM, FFH, DM, wl + WO_FOUT, scr, r, lane);
    }
    float2* rope = (float2*)(p->ws + WS_ROPE);
    for (int i = blockIdx.x * NTHREADS + tid; i < SEQ * 8; i += gridDim.x * NTHREADS) {
        const int pos = i >> 3, j = i & 7;
        const float ang = (float)pos * p->inv_freq[j];
        const double rev = (double)ang * 0.15915494309189535;
        const float fr = (float)(rev - rint(rev));
        rope[i] = make_float2(__builtin_amdgcn_cosf(fr), __builtin_amdgcn_sinf(fr));
    }
    bf16_t* memn = (bf16_t*)(p->ws + WS_MEMN);
    for (int R = gw; R < NBATCH * NMEM; R += NGW) {
        const float* src = (R < 16 * NMEM) ? p->mem_prompt + (size_t)R * DM : p->mem_sample + (size_t)(R - 16 * NMEM) * DM;
        f32x4 v[4]; float ss = 0.f;
#pragma unroll
        for (int j = 0; j < 4; ++j) { v[j] = *(const f32x4*)(src + 4 * (lane + 64 * j)); ss += v[j].x * v[j].x + v[j].y * v[j].y + v[j].z * v[j].z + v[j].w * v[j].w; }
        const float rstd = 1.f / sqrtf(wave_sum(ss) * (1.f / DM) + EPS);
#pragma unroll
        for (int l = 0; l < DEPTH; ++l)
#pragma unroll
            for (int j = 0; j < 4; ++j) { const f32x4 g = *(const f32x4*)(p->g_mem + l * DM + 4 * (lane + 64 * j));
                u32x2 o; o.x = pk2(v[j].x * rstd * g.x, v[j].y * rstd * g.y); o.y = pk2(v[j].z * rstd * g.z, v[j].w * rstd * g.w);
                *(u32x2*)(memn + ((size_t)l * NBATCH * NMEM + R) * DM + 4 * (lane + 64 * j)) = o; }
    }
}

__device__ __forceinline__ const float* x_in_row(PP p, int GR) { return GR < 16 * SEQ ? p->x_prompt + (size_t)GR * DM : p->x_sample + (size_t)(GR - 16 * SEQ) * DM; }

__device__ __forceinline__ void phase_rows_first(PP p, int chunk) {
    int tid_ = threadIdx.x; OPAQUE_V(tid_); const int lane = tid_ & 63, wave = __builtin_amdgcn_readfirstlane(tid_ >> 6);
    bf16_t* H = (bf16_t*)(p->ws + WS_H);
    for (int r = blockIdx.x * NWAVES + wave; r < MC; r += gridDim.x * NWAVES) {
        const float* src = x_in_row(p, chunk * MC + r);
        f32x4 v[4]; float ss = 0.f;
#pragma unroll
        for (int j = 0; j < 4; ++j) { v[j] = *(const f32x4*)(src + 4 * (lane + 64 * j)); ss += v[j].x * v[j].x + v[j].y * v[j].y + v[j].z * v[j].z + v[j].w * v[j].w; }
        const float rstd = 1.f / sqrtf(wave_sum(ss) * (1.f / DM) + EPS);
#pragma unroll
        for (int j = 0; j < 4; ++j) { const f32x4 g = *(const f32x4*)(p->g_mix_pre + 4 * (lane + 64 * j));
            u32x2 o; o.x = pk2(v[j].x * rstd * g.x, v[j].y * rstd * g.y); o.y = pk2(v[j].z * rstd * g.z, v[j].w * rstd * g.w);
            *(u32x2*)(H + (size_t)r * DM + 4 * (lane + 64 * j)) = o; }
    }
}
template <int MODE> struct RowBuf { f32x4 x[4]; u32x2 y1[4]; u32x2 y2[MODE ? 4 : 1]; };
template <int MODE>
__device__ __forceinline__ void row_load(RowBuf<MODE>& b, const bf16_t* y1row, const bf16_t* y2row, const float* xrow, int lane) {
#pragma unroll
    for (int j = 0; j < 4; ++j) { b.y1[j] = __builtin_nontemporal_load((const u32x2*)(y1row + 4 * (lane + 64 * j))); b.x[j] = __builtin_nontemporal_load((const f32x4*)(xrow + 4 * (lane + 64 * j)));
        if (MODE) b.y2[j] = __builtin_nontemporal_load((const u32x2*)(y2row + 4 * (lane + 64 * j))); }
}
__device__ __forceinline__ f32x4 unpack4(const u32x2 v) { f32x4 r; r.x = bf2f(v.x & 0xffffu); r.y = bf2f(v.x >> 16); r.z = bf2f(v.y & 0xffffu); r.w = bf2f(v.y >> 16); return r; }
__device__ __forceinline__ float row_add_norm(f32x4 (&x)[4], const u32x2 (&yp)[4], const f32x4 (&g)[4]) {
    f32x4 y[4]; float ss = 0.f;
#pragma unroll
    for (int j = 0; j < 4; ++j) { y[j] = unpack4(yp[j]); ss += y[j].x * y[j].x + y[j].y * y[j].y + y[j].z * y[j].z + y[j].w * y[j].w; }
    const float ry = 1.f / sqrtf(wave_sum(ss) * (1.f / DM) + EPS);
    float sx = 0.f;
#pragma unroll
    for (int j = 0; j < 4; ++j) { const f32x4 gg = g[j];
        x[j].x += y[j].x * ry * gg.x; x[j].y += y[j].y * ry * gg.y; x[j].z += y[j].z * ry * gg.z; x[j].w += y[j].w * ry * gg.w;
        sx += x[j].x * x[j].x + x[j].y * x[j].y + x[j].z * x[j].z + x[j].w * x[j].w; }
    return sx;
}
template <int MODE>
__device__ __forceinline__ void row_process(RowBuf<MODE>& b, float* dst, bf16_t* hrow, const f32x4 (&g_mid)[4], const f32x4 (&g_end)[4], const f32x4 (&g_next)[4], bool write_h, int lane) {
    float sx = row_add_norm(b.x, b.y1, g_mid);
    if (MODE) {
        u32x2 y2[4];
#pragma unroll
        for (int j = 0; j < 4; ++j) y2[j] = b.y2[j];
        sx = row_add_norm(b.x, y2, g_end);
#pragma unroll
        for (int j = 0; j < 4; ++j) __builtin_nontemporal_store(b.x[j], (f32x4*)(dst + 4 * (lane + 64 * j)));
    }
    if (write_h) {
        const float rx = 1.f / sqrtf(wave_sum(sx) * (1.f / DM) + EPS);
#pragma unroll
        for (int j = 0; j < 4; ++j) { const f32x4 g = g_next[j]; const f32x4 x = b.x[j];
            u32x2 o; o.x = pk2(x.x * rx * g.x, x.y * rx * g.y); o.y = pk2(x.z * rx * g.z, x.w * rx * g.w);
            *(u32x2*)(hrow + 4 * (lane + 64 * j)) = o; }
    }
}
template <int MODE>
__device__ __forceinline__ void phase_rows_resid(PP p, int chunk, bool src_is_input, const float* gp_mid, const float* gp_end, const float* gp_next, bool write_h) {
    int tid_ = threadIdx.x; OPAQUE_V(tid_); const int lane = tid_ & 63, wave = __builtin_amdgcn_readfirstlane(tid_ >> 6);
    bf16_t* H = (bf16_t*)(p->ws + WS_H);
    const bf16_t* Y1 = (const bf16_t*)(p->ws + WS_Y); const bf16_t* Y2 = (const bf16_t*)(p->ws + WS_Y2);
    float* out = p->out;
    const int stride = gridDim.x * NWAVES;
    int r = blockIdx.x * NWAVES + wave;
    if (r >= MC) return;
    f32x4 g_mid[4], g_end[4], g_next[4];
#pragma unroll
    for (int j = 0; j < 4; ++j) { g_mid[j] = *(const f32x4*)(gp_mid + 4 * (lane + 64 * j)); g_next[j] = *(const f32x4*)(gp_next + 4 * (lane + 64 * j));
        g_end[j] = MODE ? *(const f32x4*)(gp_end + 4 * (lane + 64 * j)) : g_mid[j]; }
    RowBuf<MODE> A, B;
#define ROW_SRC(rr) (src_is_input ? x_in_row(p, chunk * MC + (rr)) : out + (size_t)(chunk * MC + (rr)) * DM)
#define ROW_LD(buf, rr) row_load<MODE>(buf, Y1 + (size_t)(rr) * DM, Y2 + (size_t)(rr) * DM, ROW_SRC(rr), lane)
#define ROW_DO(buf, rr) row_process<MODE>(buf, out + (size_t)(chunk * MC + (rr)) * DM, H + (size_t)(rr) * DM, g_mid, g_end, g_next, write_h, lane)
    ROW_LD(A, r);
    for (;;) {
        const int r1 = r + stride;
        if (r1 < MC) ROW_LD(B, r1);
        ROW_DO(A, r);
        if (r1 >= MC) break;
        const int r2 = r1 + stride;
        if (r2 < MC) ROW_LD(A, r2);
        ROW_DO(B, r1);
        if (r2 >= MC) break;
        r = r2;
    }
#undef ROW_SRC
#undef ROW_LD
#undef ROW_DO
}

__device__ __forceinline__ int pi32(int r) { return (r & 0x13) | ((r & 4) << 1) | ((r & 8) >> 1); }
template <int D> __device__ __forceinline__ size_t kblk_off(int p, int c8) { const int kt = p >> 5, r = pi32(p & 31); return ((size_t)(kt * (D / 16) + (c8 >> 1)) * 64 + (c8 & 1) * 32 + r) * 8; }
template <int D> __device__ __forceinline__ size_t vblk_off(int p, int d) { const int kt = p >> 5, w = p & 31; return ((((size_t)kt * (D / 32) + (d >> 5)) * 2 + (w >> 4)) * 64 + ((w >> 3) & 1) * 32 + (d & 31)) * 8 + (w & 7); }
template <int D> __device__ __forceinline__ void store8_vblk(bf16_t* img, int p, int d0, const f32x4& a, const f32x4& b) {
    const unsigned o0 = pk2(a.x, a.y), o1 = pk2(a.z, a.w), o2 = pk2(b.x, b.y), o3 = pk2(b.z, b.w);
    bf16_t* base = img + vblk_off<D>(p, d0);
    base[0] = (bf16_t)(o0 & 0xffffu); base[8] = (bf16_t)(o0 >> 16); base[16] = (bf16_t)(o1 & 0xffffu); base[24] = (bf16_t)(o1 >> 16);
    base[32] = (bf16_t)(o2 & 0xffffu); base[40] = (bf16_t)(o2 >> 16); base[48] = (bf16_t)(o3 & 0xffffu); base[56] = (bf16_t)(o3 >> 16);
}
__device__ __forceinline__ u32x4 pack8(const f32x4& a, const f32x4& b) { u32x4 o; o.x = pk2(a.x, a.y); o.y = pk2(a.z, a.w); o.z = pk2(b.x, b.y); o.w = pk2(b.z, b.w); return o; }
__device__ __forceinline__ void store8_strided(bf16_t* base, size_t stride, const f32x4& a, const f32x4& b) {
    const u32x4 o = pack8(a, b);
    base[0 * stride] = (bf16_t)(o.x & 0xffffu); base[1 * stride] = (bf16_t)(o.x >> 16); base[2 * stride] = (bf16_t)(o.y & 0xffffu); base[3 * stride] = (bf16_t)(o.y >> 16);
    base[4 * stride] = (bf16_t)(o.z & 0xffffu); base[5 * stride] = (bf16_t)(o.z >> 16); base[6 * stride] = (bf16_t)(o.w & 0xffffu); base[7 * stride] = (bf16_t)(o.w >> 16);
}
struct EpiIn {
    static constexpr bool PERM = true, AFTER_DRAIN = false;
    bf16_t* proj; bf16_t* vta; bf16_t* vtb; bf16_t* kba; bf16_t* kbb; const float* rope;
    __device__ __forceinline__ void operator()(const f32x4 (&acc)[2][2][4][2], const pg8::Unit& u, int wr, int wc, int fr, int fq) const {
        const int row0 = u.pm * 256 + wr * 64 + fr;
#pragma unroll
        for (int bj = 0; bj < 2; ++bj) {
            const int c128 = u.pn * 256 + bj * 128, cb = c128 + wc * 32 + 8 * fq;
            if (c128 >= 3584) {
#pragma unroll
                for (int ai = 0; ai < 2; ++ai)
#pragma unroll
                    for (int m = 0; m < 4; ++m) { const int row = row0 + ai * 128 + m * 16; f32x4 a = acc[ai][bj][m][0], b = acc[ai][bj][m][1];
                        a.x = sigmoidf_(a.x); a.y = sigmoidf_(a.y); a.z = sigmoidf_(a.z); a.w = sigmoidf_(a.w); b.x = sigmoidf_(b.x); b.y = sigmoidf_(b.y); b.z = sigmoidf_(b.z); b.w = sigmoidf_(b.w);
                        __builtin_nontemporal_store(pack8(a, b), (u32x4*)(proj + (size_t)row * INW + cb)); }
            } else if (c128 >= 3072) {
#pragma unroll
                for (int ai = 0; ai < 2; ++ai)
#pragma unroll
                    for (int m = 0; m < 4; ++m) { const int row = row0 + ai * 128 + m * 16; __builtin_nontemporal_store(pack8(acc[ai][bj][m][0], acc[ai][bj][m][1]), (u32x4*)(proj + (size_t)row * INW + cb)); }
            } else if (c128 == 640) {
                const int kvh = (cb - 640) >> 6, d0 = (cb - 640) & 63;
#pragma unroll
                for (int ai = 0; ai < 2; ++ai)
#pragma unroll
                    for (int m = 0; m < 4; ++m) { const int row = row0 + ai * 128 + m * 16, bl = row >> 11, pos = row & 2047;
                        store8_vblk<64>(vta + (size_t)(bl * 2 + kvh) * 64 * SEQ, pos, d0, acc[ai][bj][m][0], acc[ai][bj][m][1]); }
            } else if (c128 >= 2304) {
                const int hb = (cb - 2304) >> 6, d0 = (cb - 2304) & 63, sh = 2 * (hb >> 2);
#pragma unroll
                for (int ai = 0; ai < 2; ++ai)
#pragma unroll
                    for (int m = 0; m < 4; ++m) { const int row = row0 + ai * 128 + m * 16, bl = row >> 11, pos = row & 2047;
                        const int pg = (pos & ((1 << sh) - 1)) * (SEQ >> sh) + (pos >> sh);
                        store8_vblk<64>(vtb + (size_t)(bl * 12 + hb) * 64 * SEQ, pg, d0, acc[ai][bj][m][0], acc[ai][bj][m][1]); }
            } else {
                const bool rp = ((wc & 1) == 0) && (fq < 2);
#pragma unroll
                for (int ai = 0; ai < 2; ++ai)
#pragma unroll
                    for (int m = 0; m < 4; ++m) { const int row = row0 + ai * 128 + m * 16; f32x4 a = acc[ai][bj][m][0], b = acc[ai][bj][m][1];
                        if (rp) { const int pos = row & 2047; const f32x4* t = (const f32x4*)(rope + (size_t)pos * 16 + 8 * fq); const f32x4 t0 = t[0], t1 = t[1];
                            f32x4 a2, b2;
                            a2.x = a.x * t0.x - a.y * t0.y; a2.y = a.y * t0.x + a.x * t0.y; a2.z = a.z * t0.z - a.w * t0.w; a2.w = a.w * t0.z + a.z * t0.w;
                            b2.x = b.x * t1.x - b.y * t1.y; b2.y = b.y * t1.x + b.x * t1.y; b2.z = b.z * t1.z - b.w * t1.w; b2.w = b.w * t1.z + b.z * t1.w;
                            a = a2; b = b2; }
                        if (c128 == 512) {
                            const int bl = row >> 11, pos = row & 2047, kvh = (cb - 512) >> 6, c8 = ((cb - 512) & 63) >> 3;
                            *(u32x4*)(kba + (size_t)(bl * 2 + kvh) * 64 * SEQ + kblk_off<64>(pos, c8)) = pack8(a, b);
                        } else if (c128 >= 1536) {
                            const int bl = row >> 11, pos = row & 2047, hb = (cb - 1536) >> 6, c8 = ((cb - 1536) & 63) >> 3, sh = 2 * (hb >> 2);
                            const int pg = (pos & ((1 << sh) - 1)) * (SEQ >> sh) + (pos >> sh);
                            *(u32x4*)(kbb + (size_t)(bl * 12 + hb) * 64 * SEQ + kblk_off<64>(pg, c8)) = pack8(a, b);
                        } else __builtin_nontemporal_store(pack8(a, b), (u32x4*)(proj + (size_t)row * INW + cb)); }
            }
        }
    }
};
struct EpiMemKV {
    static constexpr bool PERM = true, AFTER_DRAIN = false;
    bf16_t* mk; bf16_t* mvt;
    __device__ __forceinline__ void operator()(const f32x4 (&acc)[2][2][4][2], const pg8::Unit& u, int wr, int wc, int fr, int fq) const {
        const int row0 = u.pm * 256 + wr * 64 + fr;
#pragma unroll
        for (int bj = 0; bj < 2; ++bj) {
            const int c128 = u.pn * 256 + bj * 128, cb = c128 + wc * 32 + 8 * fq;
            if (c128 < 512) {
#pragma unroll
                for (int ai = 0; ai < 2; ++ai)
#pragma unroll
                    for (int m = 0; m < 4; ++m) { const int row = row0 + ai * 128 + m * 16, b = row >> 8, j = row & 255, hc = cb >> 7, c8 = (cb & 127) >> 3;
                        *(u32x4*)(mk + (size_t)(b * 4 + hc) * 128 * NMEM + kblk_off<128>(j, c8)) = pack8(acc[ai][bj][m][0], acc[ai][bj][m][1]); }
            } else {
                const int hc = (cb - 512) >> 7, d0 = (cb - 512) & 127;
#pragma unroll
                for (int ai = 0; ai < 2; ++ai)
#pragma unroll
                    for (int m = 0; m < 4; ++m) { const int row = row0 + ai * 128 + m * 16, b = row >> 8, j = row & 255;
                        store8_vblk<128>(mvt + (size_t)(b * 4 + hc) * 128 * NMEM, j, d0, acc[ai][bj][m][0], acc[ai][bj][m][1]); }
            }
        }
    }
};
struct EpiGate {
    static constexpr bool PERM = true, AFTER_DRAIN = false;
    const bf16_t* gate; bf16_t* mrg; int accum;
    __device__ __forceinline__ void operator()(const f32x4 (&acc)[2][2][4][2], const pg8::Unit& u, int wr, int wc, int fr, int fq) const {
        const int row0 = u.pm * 256 + wr * 64 + fr, cb0 = u.pn * 256 + wc * 32 + 8 * fq;
#pragma unroll
        for (int ai = 0; ai < 2; ++ai) {
            u32x4 g[4][2], o[4][2];
#pragma unroll
            for (int m = 0; m < 4; ++m)
#pragma unroll
                for (int bj = 0; bj < 2; ++bj) g[m][bj] = __builtin_nontemporal_load((const u32x4*)(gate + (size_t)(row0 + ai * 128 + m * 16) * INW + cb0 + bj * 128));
            if (accum) {
#pragma unroll
                for (int m = 0; m < 4; ++m)
#pragma unroll
                    for (int bj = 0; bj < 2; ++bj) o[m][bj] = *(const u32x4*)(mrg + (size_t)(row0 + ai * 128 + m * 16) * DM + cb0 + bj * 128);
            }
#pragma unroll
            for (int m = 0; m < 4; ++m)
#pragma unroll
                for (int bj = 0; bj < 2; ++bj) {
                    const u32x4 gg = g[m][bj];
                    f32x4 a = acc[ai][bj][m][0], b = acc[ai][bj][m][1];
                    a.x *= bf2f(gg.x & 0xffffu); a.y *= bf2f(gg.x >> 16); a.z *= bf2f(gg.y & 0xffffu); a.w *= bf2f(gg.y >> 16);
                    b.x *= bf2f(gg.z & 0xffffu); b.y *= bf2f(gg.z >> 16); b.z *= bf2f(gg.w & 0xffffu); b.w *= bf2f(gg.w >> 16);
                    if (accum) { const u32x4 oo = o[m][bj];
                        a.x += bf2f(oo.x & 0xffffu); a.y += bf2f(oo.x >> 16); a.z += bf2f(oo.y & 0xffffu); a.w += bf2f(oo.y >> 16);
                        b.x += bf2f(oo.z & 0xffffu); b.y += bf2f(oo.z >> 16); b.z += bf2f(oo.w & 0xffffu); b.w += bf2f(oo.w >> 16); }
                    *(u32x4*)(mrg + (size_t)(row0 + ai * 128 + m * 16) * DM + cb0 + bj * 128) = pack8(a, b);
                }
        }
    }
};
struct EpiY {
    static constexpr bool PERM = true, AFTER_DRAIN = false;
    bf16_t* Y;
    __device__ __forceinline__ void operator()(const f32x4 (&acc)[2][2][4][2], const pg8::Unit& u, int wr, int wc, int fr, int fq) const {
        const int row0 = u.pm * 256 + wr * 64 + fr;
#pragma unroll
        for (int ai = 0; ai < 2; ++ai)
#pragma unroll
            for (int m = 0; m < 4; ++m)
#pragma unroll
                for (int bj = 0; bj < 2; ++bj)
                    *(u32x4*)(Y + (size_t)(row0 + ai * 128 + m * 16) * DM + u.pn * 256 + bj * 128 + wc * 32 + 8 * fq) = pack8(acc[ai][bj][m][0], acc[ai][bj][m][1]);
    }
};
struct EpiSwiGLU {
    static constexpr bool PERM = true, AFTER_DRAIN = false;
    bf16_t* act;
    __device__ __forceinline__ void operator()(const f32x4 (&acc)[2][2][4][2], const pg8::Unit& u, int wr, int wc, int fr, int fq) const {
        const int row0 = u.pm * 256 + wr * 64 + fr;
#pragma unroll
        for (int ai = 0; ai < 2; ++ai)
#pragma unroll
            for (int m = 0; m < 4; ++m)
#pragma unroll
                for (int bj = 0; bj < 2; ++bj) { const int cb = u.pn * 256 + bj * 128 + wc * 32 + 8 * fq; const f32x4 g = acc[ai][bj][m][0], v = acc[ai][bj][m][1];
                    u32x2 o; o.x = pk2(g.x * sigmoidf_(g.x) * v.x, g.y * sigmoidf_(g.y) * v.y); o.y = pk2(g.z * sigmoidf_(g.z) * v.z, g.w * sigmoidf_(g.w) * v.w);
                    *(u32x2*)(act + (size_t)(row0 + ai * 128 + m * 16) * FFH + (cb >> 1)) = o; }
    }
};
#ifndef GATE_FAST
#define GATE_FAST true
#endif
template <class Epi, bool FAST = true>
__device__ __forceinline__ void run_gemm(LAS unsigned char* lds, const bf16_t* A, const bf16_t* Bt, int M, int N, int K, const Epi& E, int crot) {
    pg8::Gemm g; g.A = A; g.Bt = Bt; g.M = M; g.N = N; g.K = K;
#ifndef WGM_WIDE
#define WGM_WIDE 4
#endif
#ifndef WGM_NARROW
#define WGM_NARROW 8
#endif
    pg8::StaticOrder S; S.init(M, N, (int)gridDim.x, (int)((blockIdx.x + crot) % gridDim.x), N > 1024 ? WGM_WIDE : WGM_NARROW);
    pg8::gemm_phase<Epi, pg8::StaticOrder, FAST, FAST>(lds, g, S, E);
}

struct AttnTask {
    const bf16_t* q; long qstride;
    const bf16_t* kb; const bf16_t* vb;
    bf16_t* o; long ostride;
    float* lse; long lsestride;
    int m0, L, W;
    float m_init, l_init, scale2;
};
template <int D>
__device__ __forceinline__ void attn_load_k(bf16x8 (&kf)[D / 16], const AttnTask& t, int k0, int lane) {
    const bf16_t* kp = t.kb + ((size_t)(k0 >> 5) * (D / 16) * 64 + lane) * 8;
#pragma unroll
    for (int kk = 0; kk < D / 16; ++kk) kf[kk] = *(const bf16x8*)(kp + kk * 512);
}
template <int D>
__device__ __forceinline__ void attn_load_v(bf16x8 (&vf)[D / 32][2], const AttnTask& t, int k0, int lane) {
    const bf16_t* vp = t.vb + ((size_t)(k0 >> 5) * (D / 32) * 128 + lane) * 8;
#pragma unroll
    for (int db = 0; db < D / 32; ++db)
#pragma unroll
        for (int s = 0; s < 2; ++s) vf[db][s] = *(const bf16x8*)(vp + (db * 2 + s) * 512);
}
__device__ __forceinline__ float xhalf_max(float v) { const auto r = __builtin_amdgcn_permlane32_swap(__float_as_uint(v), __float_as_uint(v), false, false); return fmaxf(__uint_as_float(r[0]), __uint_as_float(r[1])); }
__device__ __forceinline__ float xhalf_sum(float v) { const auto r = __builtin_amdgcn_permlane32_swap(__float_as_uint(v), __float_as_uint(v), false, false); return __uint_as_float(r[0]) + __uint_as_float(r[1]); }
template <int D, bool MASK>
__device__ __forceinline__ void attn_tile(const bf16x8 (&qf)[D / 16], const bf16x8 (&kf)[D / 16], const bf16x8 (&vf)[D / 32][2], f32x16 (&o)[D / 32], float& mrun, float& lrun,
                                          const AttnTask& t, int k0, int mq, int qi, int h) {
    f32x16 sc;
#pragma unroll
    for (int i = 0; i < 16; ++i) sc[i] = 0.f;
#pragma unroll
    for (int kk = 0; kk < D / 16; ++kk) sc = __builtin_amdgcn_mfma_f32_32x32x16_bf16(kf[kk], qf[kk], sc, 0, 0, 0);
    if (MASK) {
        if (k0 == mq - t.W || k0 == mq + t.W) {
#pragma unroll
            for (int i = 0; i < 16; ++i) { const int dlt = k0 + 16 * (i >> 3) + 8 * h + (i & 7) - qi; sc[i] = (dlt <= t.W && dlt >= -t.W) ? sc[i] : -1e30f; }
        }
    }
    float mt = sc[0];
#pragma unroll
    for (int i = 1; i < 16; ++i) mt = fmaxf(mt, sc[i]);
    mt = xhalf_max(mt) * t.scale2;
    const float mn = fmaxf(mrun, mt), alpha = fexp2(mrun - mn);
    float ps = 0.f;
#pragma unroll
    for (int i = 0; i < 16; ++i) { sc[i] = fexp2(__builtin_fmaf(sc[i], t.scale2, -mn)); ps += sc[i]; }
    ps = xhalf_sum(ps);
    lrun = lrun * alpha + ps; mrun = mn;
#pragma unroll
    for (int db = 0; db < D / 32; ++db)
#pragma unroll
        for (int i = 0; i < 16; ++i) o[db][i] *= alpha;
    bf16x8 pf[2];
#pragma unroll
    for (int s = 0; s < 2; ++s) { u32x4 w; w.x = pk2(sc[8 * s + 0], sc[8 * s + 1]); w.y = pk2(sc[8 * s + 2], sc[8 * s + 3]); w.z = pk2(sc[8 * s + 4], sc[8 * s + 5]); w.w = pk2(sc[8 * s + 6], sc[8 * s + 7]);
        pf[s] = __builtin_bit_cast(bf16x8, w); }
#pragma unroll
    for (int db = 0; db < D / 32; ++db)
#pragma unroll
        for (int s = 0; s < 2; ++s) o[db] = __builtin_amdgcn_mfma_f32_32x32x16_bf16(vf[db][s], pf[s], o[db], 0, 0, 0);
}
template <int D, bool MASK, bool PFV, int NQ>
__device__ __forceinline__ void attn_wave(const AttnTask& t, LAS unsigned char* scr, int lane) {
    const int r = lane & 31, h = lane >> 5;
    bf16x8 qf[NQ][D / 16];
#pragma unroll
    for (int q = 0; q < NQ; ++q) { const bf16_t* qp = t.q + (long)(t.m0 + 32 * q + r) * t.qstride + 8 * h;
#pragma unroll
        for (int kk = 0; kk < D / 16; ++kk) qf[q][kk] = *(const bf16x8*)(qp + 16 * kk); }
    f32x16 o[NQ][D / 32];
    float mrun[NQ], lrun[NQ];
#pragma unroll
    for (int q = 0; q < NQ; ++q) { mrun[q] = t.m_init; lrun[q] = t.l_init;
#pragma unroll
        for (int db = 0; db < D / 32; ++db)
#pragma unroll
            for (int i = 0; i < 16; ++i) o[q][db][i] = 0.f; }
    int klo = 0, khi = t.L;
    if (MASK) { klo = t.m0 - t.W; if (klo < 0) klo = 0; khi = t.m0 + 32 * NQ + t.W; if (khi > t.L) khi = t.L; }
    bf16x8 ka[D / 16], kb[D / 16], va[D / 32][2], vb[D / 32][2];
    attn_load_k<D>(ka, t, klo, lane);
    attn_load_v<D>(va, t, klo, lane);
#define ATT_TILES(KF, VF, K0) do { _Pragma("unroll") for (int q = 0; q < NQ; ++q) { const int mq = t.m0 + 32 * q; \
        if (!MASK || NQ == 1 || ((K0) >= mq - t.W && (K0) <= mq + t.W)) attn_tile<D, MASK>(qf[q], KF, VF, o[q], mrun[q], lrun[q], t, (K0), mq, mq + r, h); } } while (0)
    for (int k0 = klo; k0 < khi; k0 += 64) {
        const int k1 = k0 + 32, k2 = (k0 + 64 < khi) ? k0 + 64 : klo;
        const bool has1 = k1 < khi;
        attn_load_k<D>(kb, t, has1 ? k1 : klo, lane);
        if (PFV) attn_load_v<D>(vb, t, has1 ? k1 : klo, lane);
        __builtin_amdgcn_sched_barrier(0);
        ATT_TILES(ka, va, k0);
        __builtin_amdgcn_sched_barrier(0);
        if (!has1) break;
        if (!PFV) attn_load_v<D>(vb, t, k1, lane);
        attn_load_k<D>(ka, t, k2, lane);
        if (PFV) attn_load_v<D>(va, t, k2, lane);
        __builtin_amdgcn_sched_barrier(0);
        ATT_TILES(kb, vb, k1);
        __builtin_amdgcn_sched_barrier(0);
        if (!PFV) attn_load_v<D>(va, t, k2, lane);
    }
#undef ATT_TILES
#pragma unroll
    for (int q = 0; q < NQ; ++q) {
        const int qi = t.m0 + 32 * q + r;
        const float inv = 1.f / lrun[q];
        constexpr int RS = 2 * D + 16;
#pragma unroll
        for (int db = 0; db < D / 32; ++db)
#pragma unroll
            for (int g = 0; g < 4; ++g) { u32x2 w; w.x = pk2(o[q][db][4 * g + 0] * inv, o[q][db][4 * g + 1] * inv); w.y = pk2(o[q][db][4 * g + 2] * inv, o[q][db][4 * g + 3] * inv);
                *(LAS u32x2*)(scr + r * RS + (32 * db + 8 * g + 4 * h) * 2) = w; }
        LDS_WAIT();
        constexpr int CPR = D / 8, RPI = 64 / CPR;
#pragma unroll
        for (int it = 0; it < 32 / RPI; ++it) { const int row = it * RPI + lane / CPR, ch = lane % CPR;
            const u32x4 v = *(const LAS u32x4*)(scr + row * RS + ch * 16);
            *(u32x4*)(t.o + (long)(t.m0 + 32 * q + row) * t.ostride + ch * 8) = v; }
        LDS_WAIT();
        if (t.lse != nullptr && h == 0) t.lse[(long)qi * t.lsestride] = (mrun[q] + __builtin_amdgcn_logf(lrun[q])) * LN2;
    }
}

__device__ __forceinline__ void attn_wave_mem_lds(const AttnTask& t, LAS unsigned char* lds, int lane) {
    constexpr int D = 128;
    const int r = lane & 31, h = lane >> 5;
    bf16x8 qf[D / 16];
    const bf16_t* qp = t.q + (long)(t.m0 + r) * t.qstride + 8 * h;
#pragma unroll
    for (int kk = 0; kk < D / 16; ++kk) qf[kk] = *(const bf16x8*)(qp + 16 * kk);
    f32x16 o[D / 32];
#pragma unroll
    for (int db = 0; db < D / 32; ++db)
#pragma unroll
        for (int i = 0; i < 16; ++i) o[db][i] = 0.f;
    float mrun = t.m_init, lrun = t.l_init;
    const int qi = t.m0 + r;
    for (int kt = 0; kt < NMEM / 32; ++kt) {
        bf16x8 kf[D / 16], vf[D / 32][2];
#pragma unroll
        for (int kk = 0; kk < D / 16; ++kk) kf[kk] = *(const LAS bf16x8*)(lds + ((kt * (D / 16) + kk) * 64 + lane) * 16);
#pragma unroll
        for (int db = 0; db < D / 32; ++db)
#pragma unroll
            for (int s = 0; s < 2; ++s) vf[db][s] = *(const LAS bf16x8*)(lds + 65536 + (((kt * (D / 32) + db) * 2 + s) * 64 + lane) * 16);
        attn_tile<D, false>(qf, kf, vf, o, mrun, lrun, t, kt * 32, t.m0, qi, h);
    }
    const float inv = 1.f / lrun;
    bf16_t* op = t.o + (long)qi * t.ostride + 4 * h;
#pragma unroll
    for (int db = 0; db < D / 32; ++db)
#pragma unroll
        for (int g = 0; g < 4; ++g) { u32x2 w; w.x = pk2(o[db][4 * g + 0] * inv, o[db][4 * g + 1] * inv); w.y = pk2(o[db][4 * g + 2] * inv, o[db][4 * g + 3] * inv);
            *(u32x2*)(op + 32 * db + 8 * g) = w; }
}

__device__ __forceinline__ void attn_wave_win_lds(const AttnTask& t, LAS unsigned char* lds, int kt0, int lane) {
    constexpr int D = 64;
    const int r = lane & 31, h = lane >> 5;
    bf16x8 qf[D / 16];
    const bf16_t* qp = t.q + (long)(t.m0 + r) * t.qstride + 8 * h;
#pragma unroll
    for (int kk = 0; kk < D / 16; ++kk) qf[kk] = *(const bf16x8*)(qp + 16 * kk);
    f32x16 o[D / 32];
#pragma unroll
    for (int db = 0; db < D / 32; ++db)
#pragma unroll
        for (int i = 0; i < 16; ++i) o[db][i] = 0.f;
    float mrun = t.m_init, lrun = t.l_init;
    const int qi = t.m0 + r;
    int kta = (t.m0 - t.W) >> 5, ktb = (t.m0 + t.W) >> 5;
    if (kta < 0) kta = 0;
    if (ktb > t.L / 32 - 1) ktb = t.L / 32 - 1;
    for (int kt = kta; kt <= ktb; ++kt) {
        const int slot = kt - kt0;
        bf16x8 kf[D / 16], vf[D / 32][2];
#pragma unroll
        for (int kk = 0; kk < D / 16; ++kk) kf[kk] = *(const LAS bf16x8*)(lds + ((slot * (D / 16) + kk) * 64 + lane) * 16);
#pragma unroll
        for (int db = 0; db < D / 32; ++db)
#pragma unroll
            for (int s = 0; s < 2; ++s) vf[db][s] = *(const LAS bf16x8*)(lds + 65536 + (((slot * (D / 32) + db) * 2 + s) * 64 + lane) * 16);
        attn_tile<D, true>(qf, kf, vf, o, mrun, lrun, t, kt * 32, t.m0, qi, h);
    }
    const float inv = 1.f / lrun;
    bf16_t* op = t.o + (long)qi * t.ostride + 4 * h;
#pragma unroll
    for (int db = 0; db < D / 32; ++db)
#pragma unroll
        for (int g = 0; g < 4; ++g) { u32x2 w; w.x = pk2(o[db][4 * g + 0] * inv, o[db][4 * g + 1] * inv); w.y = pk2(o[db][4 * g + 2] * inv, o[db][4 * g + 3] * inv);
            *(u32x2*)(op + 32 * db + 8 * g) = w; }
}

__device__ __forceinline__ void phase_attention(PP p, LAS unsigned char* lds, int chunk, int layer) {
    int tid_ = threadIdx.x; OPAQUE_V(tid_); const int tid = tid_, lane = tid & 63, wave = __builtin_amdgcn_readfirstlane(tid >> 6);
    const bf16_t* proj = (const bf16_t*)(p->ws + WS_PROJ);
    const bf16_t* vta = (const bf16_t*)(p->ws + WS_VTA);
    const bf16_t* vtb = (const bf16_t*)(p->ws + WS_VTB);
    const bf16_t* kba = (const bf16_t*)(p->ws + WS_KBA); const bf16_t* kbb = (const bf16_t*)(p->ws + WS_KBB);
    bf16_t* oa = (bf16_t*)(p->ws + WS_OA); bf16_t* ob = (bf16_t*)(p->ws + WS_OB); bf16_t* oc = (bf16_t*)(p->ws + WS_OC);
    bf16_t* og = (bf16_t*)(p->ws + WS_OG); float* lseb = (float*)(p->ws + WS_LSE);
    const bf16_t* memk = (const bf16_t*)(p->ws + WS_MEMK) + (size_t)layer * NBATCH * NMEM * 512;
    const bf16_t* memvt = (const bf16_t*)(p->ws + WS_MEMVT) + (size_t)layer * NBATCH * NMEM * 512;
    constexpr int NT_B = CB * 4 * 4, NT_A = CB * 8 * 8, NT_C = CB * 4 * 8;
    for (int task = blockIdx.x; task < NT_B + NT_A + NT_C; task += gridDim.x) {
        if (task < NT_B) {
            const int bl = (task & 63) >> 2, hh = task & 3, sp = task >> 6;
            for (int wt = wave; wt < 32; wt += NWAVES) {
                const int g = wt < 8 ? 0 : (wt < 16 ? 1 : 2), tq = wt < 16 ? (wt & 7) : (wt - 16), sh = 2 * g, dil = 1 << sh, L = SEQ >> sh, hb = 4 * g + hh;
                int c, m0;
                if (g == 0) { c = 0; m0 = sp * 512 + 64 * tq; } else if (g == 1) { c = tq >> 1; m0 = sp * 128 + 64 * (tq & 1); } else { c = tq; m0 = sp * 32; }
                AttnTask t;
                const size_t rowb = (size_t)bl * SEQ + c;
                t.q = proj + rowb * INW + 768 + hb * 64; t.qstride = (long)dil * INW;
                t.kb = kbb + (size_t)(bl * 12 + hb) * 64 * SEQ + (size_t)c * L * 64; t.vb = vtb + (size_t)(bl * 12 + hb) * 64 * SEQ + (size_t)c * L * 64;
                t.o = og + (size_t)g * MC * 256 + rowb * 256 + hh * 64; t.ostride = (long)dil * 256;
                t.lse = lseb + (size_t)g * MC * 4 + rowb * 4 + hh; t.lsestride = (long)dil * 4;
                t.m0 = m0; t.L = L; t.W = 64; t.m_init = -1e30f; t.l_init = 0.f; t.scale2 = 0.125f * LOG2E;
                if (g == 2) attn_wave<64, true, true, 1>(t, lds + wave * 8192, lane); else attn_wave<64, true, true, 2>(t, lds + wave * 8192, lane);
            }
            __syncthreads();
            {
                const size_t row = (size_t)bl * SEQ + sp * 512 + tid;
                const float l0 = lseb[row * 4 + hh], l1 = lseb[(size_t)MC * 4 + row * 4 + hh], l2 = lseb[(size_t)2 * MC * 4 + row * 4 + hh];
                const float mx = fmaxf(l0, fmaxf(l1, l2));
                float a0 = fexp2((l0 - mx) * LOG2E), a1 = fexp2((l1 - mx) * LOG2E), a2 = fexp2((l2 - mx) * LOG2E);
                const float is = 1.f / (a0 + a1 + a2); a0 *= is; a1 *= is; a2 *= is;
                const bf16_t* s0 = og + row * 256 + hh * 64; const bf16_t* s1 = s0 + (size_t)MC * 256; const bf16_t* s2 = s1 + (size_t)MC * 256;
                bf16_t* dp = ob + row * 256 + hh * 64;
#pragma unroll
                for (int j = 0; j < 8; ++j) { const u32x4 x0 = *(const u32x4*)(s0 + 8 * j), x1 = *(const u32x4*)(s1 + 8 * j), x2 = *(const u32x4*)(s2 + 8 * j);
                    u32x4 w;
                    w.x = pk2(a0 * bf2f(x0.x & 0xffffu) + a1 * bf2f(x1.x & 0xffffu) + a2 * bf2f(x2.x & 0xffffu), a0 * bf2f(x0.x >> 16) + a1 * bf2f(x1.x >> 16) + a2 * bf2f(x2.x >> 16));
                    w.y = pk2(a0 * bf2f(x0.y & 0xffffu) + a1 * bf2f(x1.y & 0xffffu) + a2 * bf2f(x2.y & 0xffffu), a0 * bf2f(x0.y >> 16) + a1 * bf2f(x1.y >> 16) + a2 * bf2f(x2.y >> 16));
                    w.z = pk2(a0 * bf2f(x0.z & 0xffffu) + a1 * bf2f(x1.z & 0xffffu) + a2 * bf2f(x2.z & 0xffffu), a0 * bf2f(x0.z >> 16) + a1 * bf2f(x1.z >> 16) + a2 * bf2f(x2.z >> 16));
                    w.w = pk2(a0 * bf2f(x0.w & 0xffffu) + a1 * bf2f(x1.w & 0xffffu) + a2 * bf2f(x2.w & 0xffffu), a0 * bf2f(x0.w >> 16) + a1 * bf2f(x1.w >> 16) + a2 * bf2f(x2.w >> 16));
                    *(u32x4*)(dp + 8 * j) = w; }
            }
            __syncthreads();
        } else
        if (task < NT_B + NT_A) {
            const int ta = task - NT_B, bk = ta & 31, inr = ta >> 5, bl = bk >> 1, ha = (bk & 1) * 4 + (inr >> 3), sp = inr & 7;
            AttnTask t;
            const size_t rowb = (size_t)bl * SEQ;
            t.q = proj + rowb * INW + ha * 64; t.qstride = INW;
            t.kb = kba + (size_t)(bl * 2 + (ha >> 2)) * 64 * SEQ; t.vb = vta + (size_t)(bl * 2 + (ha >> 2)) * 64 * SEQ;
            t.o = oa + rowb * 512 + ha * 64; t.ostride = 512; t.lse = nullptr; t.lsestride = 0;
            t.m0 = sp * 256 + 32 * wave; t.L = SEQ; t.W = 128; t.m_init = p->sink_a[layer * 8 + ha] * LOG2E; t.l_init = 1.f; t.scale2 = 0.125f * LOG2E;
            const int kt0 = 8 * sp - 4;
            {
                const char* ks = (const char*)t.kb + (long)kt0 * 4096; const char* vs = (const char*)t.vb + (long)kt0 * 4096;
                u32x4 tmp[16];
#pragma unroll
                for (int i = 0; i < 8; ++i) { const int c = tid + 512 * i, kt = kt0 + (c >> 8); const bool ok = kt >= 0 && kt < SEQ / 32;
                    tmp[i] = ok ? *(const u32x4*)(ks + (long)c * 16) : (u32x4){0u, 0u, 0u, 0u}; tmp[8 + i] = ok ? *(const u32x4*)(vs + (long)c * 16) : (u32x4){0u, 0u, 0u, 0u}; }
#pragma unroll
                for (int i = 0; i < 8; ++i) { *(LAS u32x4*)(lds + (tid + 512 * i) * 16) = tmp[i]; *(LAS u32x4*)(lds + 65536 + (tid + 512 * i) * 16) = tmp[8 + i]; }
            }
            __syncthreads();
            attn_wave_win_lds(t, lds, kt0, lane);
            __syncthreads();
        } else {
            const int tc = task - NT_B - NT_A, bl = (tc & 63) >> 2, hc = tc & 3, sp = tc >> 6, bg = chunk * CB + bl;
            AttnTask t;
            const size_t rowb = (size_t)bl * SEQ;
            t.q = proj + rowb * INW + 3072 + hc * 128; t.qstride = INW;
            t.kb = memk + (size_t)(bg * 4 + hc) * 128 * NMEM; t.vb = memvt + (size_t)(bg * 4 + hc) * 128 * NMEM;
            t.o = oc + rowb * 512 + hc * 128; t.ostride = 512; t.lse = nullptr; t.lsestride = 0;
            t.m0 = sp * 256 + 32 * wave; t.L = NMEM; t.W = 0; t.m_init = -1e30f; t.l_init = 0.f; t.scale2 = 0.08838834764831845f * LOG2E;
            {
                const u32x4* ks = (const u32x4*)t.kb; const u32x4* vs = (const u32x4*)t.vb;
                u32x4 tmp[16];
#pragma unroll
                for (int i = 0; i < 8; ++i) { tmp[i] = ks[tid + 512 * i]; tmp[8 + i] = vs[tid + 512 * i]; }
#pragma unroll
                for (int i = 0; i < 8; ++i) { *(LAS u32x4*)(lds + (tid + 512 * i) * 16) = tmp[i]; *(LAS u32x4*)(lds + 65536 + (tid + 512 * i) * 16) = tmp[8 + i]; }
            }
            __syncthreads();
            attn_wave_mem_lds(t, lds, lane);
            __syncthreads();
        }
    }
}

#define XB_TMO      128
#define XB_XCNT(j)  (256  + 64 * (j))
#define XB_XSUB(j)  (1280 + 64 * (j))
#define XB_XGEN(j)  (2304 + 64 * (j))
#define XB_TOP      3328
#define XB_TOPGEN   3392
#define XCD_BAR_WORDS 3456
#define XB_SPIN_CAP (1u << 18)

__device__ __forceinline__ unsigned xb_ld(unsigned* p)              { return __hip_atomic_load(p, __ATOMIC_RELAXED, __HIP_MEMORY_SCOPE_AGENT); }
__device__ __forceinline__ unsigned xb_add(unsigned* p, unsigned v) { return __hip_atomic_fetch_add(p, v, __ATOMIC_RELAXED, __HIP_MEMORY_SCOPE_AGENT); }
__device__ __forceinline__ unsigned xb_xcc_id() { return (unsigned)__builtin_amdgcn_s_getreg((3 << 11) | 20) & 0xFu; }
#define XB_SPIN(cond, bar) do { unsigned _sp = 0; while (cond) { __builtin_amdgcn_s_sleep(1); \
    if ((++_sp & 255u) == 0u) { if (xb_ld(&(bar)[XB_TMO])) break; if (_sp > XB_SPIN_CAP) { atomicAdd(&(bar)[XB_TMO], 1u); break; } } } } while (0)
struct XcdBarrier {
    unsigned* bar; unsigned x;
    volatile LAS unsigned* st;
};

__device__ __forceinline__ XcdBarrier xcd_barrier_post(unsigned* bar, volatile LAS unsigned* st) {
    XcdBarrier b; b.bar = bar; b.x = xb_xcc_id(); b.st = st;
    if (threadIdx.x == 0) (void)xb_add(&bar[XB_XCNT(b.x)], 1u);
    return b;
}
__device__ __forceinline__ void xcd_barrier_complete(unsigned* bar, unsigned x, unsigned& nloc, unsigned& nx) {
    const unsigned G = gridDim.x * gridDim.y * gridDim.z;
    unsigned sum, cnt, mine, sp = 0u;
    for (;;) {
        sum = 0u; cnt = 0u; mine = 0u;
#pragma unroll
        for (unsigned j = 0; j < 16; ++j) { const unsigned c = xb_ld(&bar[XB_XCNT(j)]); sum += c; cnt += (c > 0u) ? 1u : 0u; mine = (j == x) ? c : mine; }
        if (sum == G) break;
        __builtin_amdgcn_s_sleep(1);
        if ((++sp & 255u) == 0u) { if (xb_ld(&bar[XB_TMO])) break; if (sp > XB_SPIN_CAP) { atomicAdd(&bar[XB_TMO], 1u); break; } }
    }
    nloc = mine > 0u ? mine : 1u; nx = cnt > 0u ? cnt : 1u;
}

__device__ __forceinline__ void xcd_barrier(const XcdBarrier& b) {
    asm volatile("s_waitcnt vmcnt(0)" ::: "memory");
    __syncthreads();
    if (threadIdx.x == 0) {
        unsigned* bar = b.bar;
        __builtin_amdgcn_s_waitcnt(0);
        unsigned nloc = b.st[0], nx = b.st[1];
        if (nloc == 0u) { xcd_barrier_complete(bar, b.x, nloc, nx); b.st[0] = nloc; b.st[1] = nx; }
        const unsigned old = xb_add(&bar[XB_XSUB(b.x)], 1u);
        const unsigned gen = old / nloc;
        if (old + 1u == (gen + 1u) * nloc) {
            __builtin_amdgcn_fence(__ATOMIC_RELEASE, "agent");
            asm volatile("s_waitcnt vmcnt(0)" ::: "memory");
            const unsigned og = xb_add(&bar[XB_TOP], 1u);
            const unsigned tg = og / nx;
            if (og + 1u == (tg + 1u) * nx) xb_add(&bar[XB_TOPGEN], 1u);
            else XB_SPIN(xb_ld(&bar[XB_TOPGEN]) == tg, bar);
            __builtin_amdgcn_fence(__ATOMIC_ACQUIRE, "agent");
            xb_add(&bar[XB_XGEN(b.x)], 1u);
            asm volatile("s_waitcnt vmcnt(0)" ::: "memory");
        } else {
            XB_SPIN(xb_ld(&bar[XB_XGEN(b.x)]) == gen, bar);
            __builtin_amdgcn_fence(__ATOMIC_ACQUIRE, "agent");
            asm volatile("s_waitcnt vmcnt(0)" ::: "memory");
        }
    }
    __syncthreads();
}


constexpr int STEPS_PER_CHUNK = 1 + DEPTH * 8, N_STEPS = 2 + NCHUNK * STEPS_PER_CHUNK;
__device__ __forceinline__ void run_step(PP p, LAS unsigned char* lds, int s) {
    bf16_t* WT = (bf16_t*)(p->ws + WS_WT);
    if (s == 0) { phase_prologue_a(p, lds); return; }
    if (s == 1) {
        for (int l = 0; l < DEPTH; ++l) { EpiMemKV E; E.mk = (bf16_t*)(p->ws + WS_MEMK) + (size_t)l * NBATCH * NMEM * 512; E.mvt = (bf16_t*)(p->ws + WS_MEMVT) + (size_t)l * NBATCH * NMEM * 512;
            run_gemm(lds, (const bf16_t*)(p->ws + WS_MEMN) + (size_t)l * NBATCH * NMEM * DM, WT + (size_t)l * WL + WO_MKV, NBATCH * NMEM, 1024, DM, E, 64 * l); }
        return;
    }
    const int s2 = s - 2, chunk = s2 / STEPS_PER_CHUNK, r = s2 % STEPS_PER_CHUNK;
    if (r == 0) { phase_rows_first(p, chunk); return; }
    const int l = (r - 1) >> 3, ph = (r - 1) & 7;
    const bf16_t* wl = WT + (size_t)l * WL;
    bf16_t* H = (bf16_t*)(p->ws + WS_H); bf16_t* proj = (bf16_t*)(p->ws + WS_PROJ); bf16_t* mrg = (bf16_t*)(p->ws + WS_MRG);
    switch (ph) {
    case 0: { EpiIn E; E.proj = proj; E.vta = (bf16_t*)(p->ws + WS_VTA); E.vtb = (bf16_t*)(p->ws + WS_VTB); E.kba = (bf16_t*)(p->ws + WS_KBA); E.kbb = (bf16_t*)(p->ws + WS_KBB); E.rope = (const float*)(p->ws + WS_ROPE);
        run_gemm(lds, H, wl + WO_IN, MC, INW, DM, E, 0); } break;
    case 1: phase_attention(p, lds, chunk, l); break;
    case 2: {
        EpiGate E; E.mrg = mrg;
        E.gate = proj + 3584; E.accum = 0; run_gemm<EpiGate, GATE_FAST>(lds, (const bf16_t*)(p->ws + WS_OA), wl + WO_OA, MC, DM, 512, E, 0);
        E.gate = proj + 3584 + 1024; E.accum = 1; run_gemm<EpiGate, GATE_FAST>(lds, (const bf16_t*)(p->ws + WS_OB), wl + WO_OB, MC, DM, 256, E, 0);
        E.gate = proj + 3584 + 2048; E.accum = 1; run_gemm<EpiGate, GATE_FAST>(lds, (const bf16_t*)(p->ws + WS_OC), wl + WO_OC, MC, DM, 512, E, 0);
        } break;
    case 3: { EpiY E; E.Y = (bf16_t*)(p->ws + WS_Y); run_gemm(lds, mrg, wl + WO_OUT, MC, DM, DM, E, 0); } break;
    case 4: phase_rows_resid<0>(p, chunk, l == 0, p->g_mix_post + l * DM, nullptr, p->g_ffn_pre + l * DM, true); break;
    case 5: { EpiSwiGLU E; E.act = (bf16_t*)(p->ws + WS_ACT); run_gemm(lds, H, wl + WO_FIN, MC, 2 * FFH, DM, E, 0); } break;
    case 6: { EpiY E; E.Y = (bf16_t*)(p->ws + WS_Y2); run_gemm(lds, (const bf16_t*)(p->ws + WS_ACT), wl + WO_FOUT, MC, DM, FFH, E, 0); } break;
    default: phase_rows_resid<1>(p, chunk, l == 0, p->g_mix_post + l * DM, p->g_ffn_post + l * DM, p->g_mix_pre + (l < DEPTH - 1 ? l + 1 : l) * DM, l < DEPTH - 1); break;
    }
}

__global__ void __launch_bounds__(NTHREADS, 2) fwd_megakernel(Params p) {
    extern __shared__ __attribute__((aligned(16))) unsigned char lds_raw[];
    LAS unsigned char* lds = (LAS unsigned char*)lds_raw;
    cg::grid_group grid = cg::this_grid();
    PP pp = (PP)__builtin_amdgcn_kernarg_segment_ptr();
    const int s_hi = pp->s_hi;
    __shared__ uint4 xb_words;
    if (threadIdx.x == 0) xb_words = make_uint4(0u, 0u, 0u, 0u);
    __syncthreads();
    const XcdBarrier xbar = xcd_barrier_post((unsigned*)(pp->ws + WS_BAR), (volatile LAS unsigned*)&xb_words);
    const int s_lo = pp->s_lo;
    for (int s = s_lo; s < s_hi; ++s) {
        PP q = pp; OPAQUE_S(q);
        run_step(q, lds, s);
        if (s + 1 < s_hi) { if (s == s_lo) grid.sync(); else xcd_barrier(xbar); }
    }
}

extern "C" void kernel_launch(void* const* d_in, const int* in_sizes, int n_in, void* d_out, int out_size, void* d_ws, size_t ws_size, hipStream_t stream) {
    static int grid_blocks = 0;
    if (grid_blocks == 0) {
        if (n_in != 18 || out_size != NBATCH * SEQ * DM || ws_size < WS_END) { fprintf(stderr, "kernel_launch: unexpected shapes / workspace (n_in %d out %d ws %zu need %zu)\n", n_in, out_size, ws_size, (size_t)WS_END); grid_blocks = -1; return; }
        int dev = 0, cus = 0, per_cu = 0;
        hipGetDevice(&dev);
        hipDeviceGetAttribute(&cus, hipDeviceAttributeMultiprocessorCount, dev);
        if (hipFuncSetAttribute((const void*)fwd_megakernel, hipFuncAttributeMaxDynamicSharedMemorySize, LDS_BYTES) != hipSuccess) { fprintf(stderr, "kernel_launch: hipFuncSetAttribute failed\n"); grid_blocks = -1; return; }
        hipOccupancyMaxActiveBlocksPerMultiprocessor(&per_cu, (const void*)fwd_megakernel, NTHREADS, LDS_BYTES);
        if (per_cu < 1) { fprintf(stderr, "kernel_launch: occupancy query says %d blocks per CU\n", per_cu); per_cu = 1; }
        (void)hipGetLastError();
        grid_blocks = cus * 1;
    }
    if (grid_blocks < 0) return;
    if (hipMemsetAsync((char*)d_ws + WS_BAR, 0, 16384, stream) != hipSuccess) { fprintf(stderr, "kernel_launch: hipMemsetAsync failed\n"); return; }
    Params p{};
    p.x_prompt = (const float*)d_in[0]; p.x_sample = (const float*)d_in[1]; p.mem_prompt = (const float*)d_in[2]; p.mem_sample = (const float*)d_in[3];
    p.g_mix_pre = (const float*)d_in[4]; p.g_mix_post = (const float*)d_in[5]; p.g_mem = (const float*)d_in[6]; p.w_in = (const float*)d_in[7];
    p.sink_a = (const float*)d_in[8]; p.w_mem_kv = (const float*)d_in[9]; p.w_o_a = (const float*)d_in[10]; p.w_o_b = (const float*)d_in[11];
    p.w_o_c = (const float*)d_in[12]; p.w_out = (const float*)d_in[13]; p.g_ffn_pre = (const float*)d_in[14]; p.g_ffn_post = (const float*)d_in[15];
    p.w_ffn_in = (const float*)d_in[16]; p.w_ffn_out = (const float*)d_in[17];
    p.out = (float*)d_out; p.ws = (unsigned char*)d_ws;
    for (int j = 0; j < 8; ++j) p.inv_freq[j] = powf(500000.0f, -(float)(2 * j) / 16.0f);
#if MK_MULTI_LAUNCH
    for (int s = 0; s < N_STEPS; ++s) {
        p.s_lo = s; p.s_hi = s + 1;
        hipLaunchKernelGGL(fwd_megakernel, dim3(grid_blocks), dim3(NTHREADS), LDS_BYTES, stream, p);
    }
#else
    p.s_lo = 0; p.s_hi = N_STEPS;
    void* args[] = {&p};
    hipError_t e = hipLaunchCooperativeKernel((const void*)fwd_megakernel, dim3(grid_blocks), dim3(NTHREADS), args, LDS_BYTES, stream);
    if (e != hipSuccess) fprintf(stderr, "kernel_launch: cooperative launch failed: %s (grid %d)\n", hipGetErrorString(e), grid_blocks);
#endif
}
```
